# Optimizing an MI355X kernel written in HIP

```python
import math
import jax, jax.numpy as jnp
from jax import lax
import numpy as np

D_MODEL = 1024
BATCH = 2
SEQ = 8192
DEPTH = 4

N_MEM = 256
EPS = 1e-6

MLA_HEADS = 8
MLA_NOPE = 64
MLA_ROPE = 32
MLA_V = 64
MLA_Q_RANK = 256
MLA_KV_RANK = 128
ROPE_THETA = 10000.0
Q_BLOCK = 128

SSM_HEADS = 4
SSM_HEADDIM = 64
SSM_INNER = SSM_HEADS * SSM_HEADDIM
SSM_GROUPS = 2
SSM_STATE = 64
SSM_CONV = 4
SSM_CHUNK = 128
SSM_XBC = SSM_INNER + 2 * SSM_GROUPS * SSM_STATE

LRU_WIDTH = 256
LRU_BLOCKS = 4
LRU_BLOCK = LRU_WIDTH // LRU_BLOCKS
LRU_CONV = 4
LRU_C = 8.0

MEM_HEADS = 4
MEM_HEAD_DIM = D_MODEL // MEM_HEADS
D_FF = 4 * D_MODEL

MLA_OUT = MLA_HEADS * MLA_V
MIX_WIDTH = MLA_OUT + SSM_INNER + LRU_WIDTH
IN_SPLITS = (
    MLA_Q_RANK,
    MLA_KV_RANK,
    MLA_ROPE,
    SSM_INNER,
    SSM_INNER,
    SSM_GROUPS * SSM_STATE,
    SSM_GROUPS * SSM_STATE,
    SSM_HEADS,
    LRU_WIDTH,
    LRU_WIDTH,
)
D_IN_PROJ = sum(IN_SPLITS)

kernel_name = "hymba_mla_ssd_rglru_trunk"


def rms_norm(x, g):
    xf = x.astype(jnp.float32)
    y = xf * lax.rsqrt(jnp.mean(xf * xf, axis=-1, keepdims=True) + EPS)
    return (y * g.astype(jnp.float32)).astype(x.dtype)


def split_cols(u, sizes):
    offsets = []
    acc = 0
    for s in sizes[:-1]:
        acc += s
        offsets.append(acc)
    return jnp.split(u, offsets, axis=-1)


def causal_depthwise_conv(x, w, b):
    k_width = w.shape[0]
    s = x.shape[1]
    xp = jnp.pad(x, ((0, 0), (k_width - 1, 0), (0, 0)))
    y = b
    for k in range(k_width):
        y = y + xp[:, k:k + s, :] * w[k]
    return y


def rope_tables(positions):
    half = MLA_ROPE // 2
    inv_freq = ROPE_THETA ** (-jnp.arange(half, dtype=jnp.float32) * 2.0 / MLA_ROPE)
    ang = positions.astype(jnp.float32)[..., None] * inv_freq
    return jnp.cos(ang)[:, :, None, :], jnp.sin(ang)[:, :, None, :]


def apply_rope(x, cos, sin):
    xf = x.astype(jnp.float32)
    half = MLA_ROPE // 2
    x1, x2 = xf[..., :half], xf[..., half:]
    out = jnp.concatenate([x1 * cos - x2 * sin, x2 * cos + x1 * sin], axis=-1)
    return out.astype(x.dtype)


def causal_block_attention(q, k, v, scale):
    b, s, h, dk = q.shape
    dv = v.shape[-1]
    nb = s // Q_BLOCK
    qb = q.reshape(b, nb, Q_BLOCK, h, dk).transpose(1, 0, 2, 3, 4)
    kpos = jnp.arange(s)

    def one_block(args):
        qi, i = args
        sc = jnp.einsum('bqhd,bkhd->bhqk', qi, k).astype(jnp.float32) * scale
        qpos = i * Q_BLOCK + jnp.arange(Q_BLOCK)
        mask = kpos[None, :] <= qpos[:, None]
        sc = jnp.where(mask[None, None], sc, -jnp.inf)
        p = jax.nn.softmax(sc, axis=-1).astype(v.dtype)
        return jnp.einsum('bhqk,bkhd->bqhd', p, v)

    out = lax.map(one_block, (qb, jnp.arange(nb)))
    return out.transpose(1, 0, 2, 3, 4).reshape(b, s, h * dv)


def mla_group(c_q, c_kv, k_rope_raw, cos, sin, q_norm_g, kv_norm_g, w_uq, w_ukv):
    b, s, _ = c_q.shape
    q = (rms_norm(c_q, q_norm_g) @ w_uq).reshape(b, s, MLA_HEADS, MLA_NOPE + MLA_ROPE)
    q_nope, q_rope = q[..., :MLA_NOPE], q[..., MLA_NOPE:]
    q = jnp.concatenate([q_nope, apply_rope(q_rope, cos, sin)], axis=-1)
    kv = (rms_norm(c_kv, kv_norm_g) @ w_ukv).reshape(b, s, MLA_HEADS, MLA_NOPE + MLA_V)
    k_nope, v = kv[..., :MLA_NOPE], kv[..., MLA_NOPE:]
    k_rope = apply_rope(k_rope_raw[:, :, None, :], cos, sin)
    k = jnp.concatenate([k_nope, jnp.broadcast_to(k_rope, (b, s, MLA_HEADS, MLA_ROPE))], axis=-1)
    scale = 1.0 / math.sqrt(MLA_NOPE + MLA_ROPE)
    return causal_block_attention(q, k, v, scale)


def segsum(a):
    t = a.shape[-1]
    a_rep = jnp.broadcast_to(a[..., :, None], a.shape + (t,))
    strict = jnp.tril(jnp.ones((t, t), dtype=bool), -1)
    cs = jnp.cumsum(jnp.where(strict, a_rep, 0.0), axis=-2)
    incl = jnp.tril(jnp.ones((t, t), dtype=bool), 0)
    return jnp.where(incl, cs, -jnp.inf)


def ssd_chunked(x, dt, a_neg, bm, cm):
    b, s, h, p = x.shape
    n = bm.shape[-1]
    nc = s // SSM_CHUNK
    xdt = (x.astype(jnp.float32) * dt[..., None]).reshape(b, nc, SSM_CHUNK, h, p)
    bc = bm.astype(jnp.float32).reshape(b, nc, SSM_CHUNK, h, n)
    cc = cm.astype(jnp.float32).reshape(b, nc, SSM_CHUNK, h, n)
    a = (dt * a_neg).reshape(b, nc, SSM_CHUNK, h).transpose(0, 3, 1, 2)
    a_cum = jnp.cumsum(a, axis=-1)
    lmat = jnp.exp(segsum(a))
    scores = jnp.einsum('bclhn,bcshn->bhcls', cc, bc) * lmat
    y_diag = jnp.einsum('bhcls,bcshp->bclhp', scores, xdt)
    decay_states = jnp.exp(a_cum[..., -1:] - a_cum)
    states = jnp.einsum('bclhn,bhcl,bclhp->bchpn', bc, decay_states, xdt)
    chunk_tot = jnp.pad(a_cum[..., -1], ((0, 0), (0, 0), (1, 0)))
    decay_chunk = jnp.exp(segsum(chunk_tot))
    states = jnp.concatenate([jnp.zeros_like(states[:, :1]), states], axis=1)
    states = jnp.einsum('bhzc,bchpn->bzhpn', decay_chunk, states)[:, :-1]
    y_off = jnp.einsum('bclhn,bchpn,bhcl->bclhp', cc, states, jnp.exp(a_cum))
    return (y_diag + y_off).reshape(b, s, h, p)


def mamba2_group(z, xs, bs, cs, dt_raw, conv_w, conv_b, dt_bias, a_log, d_skip, norm_g):
    b, s, _ = xs.shape
    xbc = jax.nn.silu(causal_depthwise_conv(jnp.concatenate([xs, bs, cs], axis=-1), conv_w, conv_b))
    xs, bs, cs = split_cols(xbc, (SSM_INNER, SSM_GROUPS * SSM_STATE, SSM_GROUPS * SSM_STATE))
    dt = jax.nn.softplus(dt_raw.astype(jnp.float32) + dt_bias.astype(jnp.float32))
    a_neg = -jnp.exp(a_log.astype(jnp.float32))
    xh = xs.reshape(b, s, SSM_HEADS, SSM_HEADDIM)
    rep = SSM_HEADS // SSM_GROUPS
    bm = jnp.repeat(bs.reshape(b, s, SSM_GROUPS, SSM_STATE), rep, axis=2)
    cm = jnp.repeat(cs.reshape(b, s, SSM_GROUPS, SSM_STATE), rep, axis=2)
    y = ssd_chunked(xh, dt, a_neg, bm, cm) + d_skip.astype(jnp.float32)[:, None] * xh.astype(jnp.float32)
    y = y.reshape(b, s, SSM_INNER) * jax.nn.silu(z.astype(jnp.float32))
    yg = y.reshape(b, s, SSM_GROUPS, SSM_INNER // SSM_GROUPS)
    yg = yg * lax.rsqrt(jnp.mean(yg * yg, axis=-1, keepdims=True) + EPS)
    return (yg.reshape(b, s, SSM_INNER) * norm_g.astype(jnp.float32)).astype(xs.dtype)


def lru_combine(c1, c2):
    a1, b1 = c1
    a2, b2 = c2
    return a1 * a2, a2 * b1 + b2


def rglru_group(xr, gate, conv_w, conv_b, w_a, b_a, w_i, b_i, lam):
    b, s, _ = xr.shape
    xr = causal_depthwise_conv(xr, conv_w, conv_b)
    xb = xr.reshape(b, s, LRU_BLOCKS, LRU_BLOCK)
    r = jax.nn.sigmoid(jnp.einsum('bsnd,nde->bsne', xb, w_a) + b_a).reshape(b, s, LRU_WIDTH)
    i = jax.nn.sigmoid(jnp.einsum('bsnd,nde->bsne', xb, w_i) + b_i).reshape(b, s, LRU_WIDTH)
    log_a = -LRU_C * r.astype(jnp.float32) * jax.nn.softplus(-lam.astype(jnp.float32))
    a = jnp.exp(log_a)
    u = jnp.sqrt(-jnp.expm1(2.0 * log_a)) * (i * xr).astype(jnp.float32)
    _, h = lax.associative_scan(lru_combine, (a, u), axis=1)
    return (h * jax.nn.gelu(gate.astype(jnp.float32), approximate=True)).astype(xr.dtype)


def memory_cross_attention(h, m, w_mq, w_mk, w_mv, w_mo):
    b, s, _ = h.shape
    q = (h @ w_mq).reshape(b, s, MEM_HEADS, MEM_HEAD_DIM)
    k = (m @ w_mk).reshape(b, N_MEM, MEM_HEADS, MEM_HEAD_DIM)
    v = (m @ w_mv).reshape(b, N_MEM, MEM_HEADS, MEM_HEAD_DIM)
    sc = jnp.einsum('bshd,bmhd->bhsm', q, k).astype(jnp.float32) / math.sqrt(MEM_HEAD_DIM)
    p = jax.nn.softmax(sc, axis=-1).astype(v.dtype)
    o = jnp.einsum('bhsm,bmhd->bshd', p, v).reshape(b, s, D_MODEL)
    return o @ w_mo


def setup_inputs(seed: int = 0) -> dict:
    key = jax.random.key(seed)
    ks = iter(jax.random.split(key, 64))
    L = DEPTH

    def nrm(shape, scale):
        return jax.random.normal(next(ks), shape, jnp.float32) * scale

    def gain(shape):
        return 1.0 + nrm(shape, 0.02)

    x = nrm((BATCH, SEQ, D_MODEL), 1.0)
    mem = nrm((BATCH, N_MEM, D_MODEL), 1.0)
    offset = jax.random.randint(next(ks), (BATCH, 1), 0, 1024, dtype=jnp.int32)
    positions = offset + jnp.arange(SEQ, dtype=jnp.int32)[None, :]

    dt0 = jnp.exp(jax.random.uniform(next(ks), (L, SSM_HEADS), jnp.float32, math.log(1e-3), math.log(1e-1)))
    ssm_dt_bias = dt0 + jnp.log(-jnp.expm1(-dt0))
    ssm_a_log = jnp.log(jax.random.uniform(next(ks), (L, SSM_HEADS), jnp.float32, 1.0, 16.0))
    a_c = jax.random.uniform(next(ks), (L, LRU_WIDTH), jnp.float32, 0.9, 0.999)
    sig = a_c ** (1.0 / LRU_C)
    lru_lambda = jnp.log(sig) - jnp.log1p(-sig)

    return {
        "x": x,
        "mem": mem,
        "positions": positions,
        "mix_norm_g": gain((L, D_MODEL)),
        "w_in": nrm((L, D_MODEL, D_IN_PROJ), D_MODEL ** -0.5),
        "mla_q_norm_g": gain((L, MLA_Q_RANK)),
        "mla_kv_norm_g": gain((L, MLA_KV_RANK)),
        "mla_w_uq": nrm((L, MLA_Q_RANK, MLA_HEADS * (MLA_NOPE + MLA_ROPE)), MLA_Q_RANK ** -0.5),
        "mla_w_ukv": nrm((L, MLA_KV_RANK, MLA_HEADS * (MLA_NOPE + MLA_V)), MLA_KV_RANK ** -0.5),
        "mla_out_g": gain((L, MLA_OUT)),
        "ssm_conv_w": nrm((L, SSM_CONV, SSM_XBC), SSM_CONV ** -0.5),
        "ssm_conv_b": nrm((L, SSM_XBC), 0.01),
        "ssm_dt_bias": ssm_dt_bias,
        "ssm_a_log": ssm_a_log,
        "ssm_d": gain((L, SSM_HEADS)),
        "ssm_norm_g": gain((L, SSM_INNER)),
        "lru_conv_w": nrm((L, LRU_CONV, LRU_WIDTH), LRU_CONV ** -0.5),
        "lru_conv_b": nrm((L, LRU_WIDTH), 0.01),
        "lru_w_a": nrm((L, LRU_BLOCKS, LRU_BLOCK, LRU_BLOCK), LRU_BLOCK ** -0.5),
        "lru_b_a": nrm((L, LRU_BLOCKS, LRU_BLOCK), 0.01),
        "lru_w_i": nrm((L, LRU_BLOCKS, LRU_BLOCK, LRU_BLOCK), LRU_BLOCK ** -0.5),
        "lru_b_i": nrm((L, LRU_BLOCKS, LRU_BLOCK), 0.01),
        "lru_lambda": lru_lambda,
        "lru_out_g": gain((L, LRU_WIDTH)),
        "w_out": nrm((L, MIX_WIDTH, D_MODEL), MIX_WIDTH ** -0.5),
        "xattn_norm_g": gain((L, D_MODEL)),
        "mem_norm_g": gain((L, D_MODEL)),
        "w_mq": nrm((L, D_MODEL, D_MODEL), D_MODEL ** -0.5),
        "w_mk": nrm((L, D_MODEL, D_MODEL), D_MODEL ** -0.5),
        "w_mv": nrm((L, D_MODEL, D_MODEL), D_MODEL ** -0.5),
        "w_mo": nrm((L, D_MODEL, D_MODEL), D_MODEL ** -0.5),
        "mlp_norm_g": gain((L, D_MODEL)),
        "w_mlp1": nrm((L, D_MODEL, D_FF), D_MODEL ** -0.5),
        "w_mlp2": nrm((L, D_FF, D_MODEL), D_FF ** -0.5),
        "final_norm_g": gain((D_MODEL,)),
    }


def reference(x, mem, positions, mix_norm_g, w_in, mla_q_norm_g, mla_kv_norm_g, mla_w_uq, mla_w_ukv,
              mla_out_g, ssm_conv_w, ssm_conv_b, ssm_dt_bias, ssm_a_log, ssm_d, ssm_norm_g,
              lru_conv_w, lru_conv_b, lru_w_a, lru_b_a, lru_w_i, lru_b_i, lru_lambda, lru_out_g,
              w_out, xattn_norm_g, mem_norm_g, w_mq, w_mk, w_mv, w_mo, mlp_norm_g, w_mlp1, w_mlp2,
              final_norm_g):
    cos, sin = rope_tables(positions)
    for l in range(DEPTH):
        h = rms_norm(x, mix_norm_g[l])
        u = h @ w_in[l]
        c_q, c_kv, k_rope, z, xs, bs, cs, dt_raw, xr, gate = split_cols(u, IN_SPLITS)
        y_mla = mla_group(c_q, c_kv, k_rope, cos, sin, mla_q_norm_g[l], mla_kv_norm_g[l],
                          mla_w_uq[l], mla_w_ukv[l])
        y_ssm = mamba2_group(z, xs, bs, cs, dt_raw, ssm_conv_w[l], ssm_conv_b[l], ssm_dt_bias[l],
                             ssm_a_log[l], ssm_d[l], ssm_norm_g[l])
        y_lru = rglru_group(xr, gate, lru_conv_w[l], lru_conv_b[l], lru_w_a[l], lru_b_a[l],
                            lru_w_i[l], lru_b_i[l], lru_lambda[l])
        y_mix = jnp.concatenate([rms_norm(y_mla, mla_out_g[l]), y_ssm, rms_norm(y_lru, lru_out_g[l])], axis=-1)
        x = x + y_mix @ w_out[l]
        x = x + memory_cross_attention(rms_norm(x, xattn_norm_g[l]), rms_norm(mem, mem_norm_g[l]),
                                       w_mq[l], w_mk[l], w_mv[l], w_mo[l])
        hm = rms_norm(x, mlp_norm_g[l]) @ w_mlp1[l]
        x = x + jnp.square(jax.nn.relu(hm)) @ w_mlp2[l]
    return rms_norm(x, final_norm_g)
```

```cpp
#include <hip/hip_runtime.h>
#include <hip/hip_cooperative_groups.h>
#include <stdint.h>
#include <stdio.h>
namespace cg = cooperative_groups;

#ifndef MK_MULTI
#define MK_MULTI 0
#endif

#define DI __device__ __forceinline__
#define LAS __attribute__((address_space(3)))
typedef unsigned short bf16_t;
typedef short bf16x8 __attribute__((ext_vector_type(8)));
typedef short s16x4 __attribute__((ext_vector_type(4)));
typedef float f32x16 __attribute__((ext_vector_type(16)));
typedef float f32x4 __attribute__((ext_vector_type(4)));
typedef unsigned u32x4 __attribute__((ext_vector_type(4)));
typedef unsigned u32x2 __attribute__((ext_vector_type(2)));
#define MFMA(a, b, c) __builtin_amdgcn_mfma_f32_32x32x16_bf16((a), (b), (c), 0, 0, 0)

constexpr int T = 16384, SEQ = 8192, DM = 1024, NL = 4;
constexpr int NIN = 1792;
constexpr float EPS = 1e-6f;
constexpr float LOG2E = 1.4426950408889634f;
constexpr int VB_LDS = 78848;
constexpr int XB_LDS_OFF = 2 * VB_LDS;
constexpr int LDS_BYTES = XB_LDS_OFF + 16;
constexpr int NPHASE = 2 + 9 * NL;

constexpr int UC_CQ = 0, UC_CKV = 256, UC_KR = 384, UC_DT = 416, UC_Z = 512, UC_XS = 768, UC_BS = 1024, UC_CS = 1152, UC_XR = 1280, UC_GATE = 1536;

constexpr size_t WO_IN = 0;
constexpr size_t WO_UQ = WO_IN + (size_t)NIN * 1024;
constexpr size_t WO_UKV = WO_UQ + 768 * 256;
constexpr size_t WO_OUT = WO_UKV + 1024 * 128;
constexpr size_t WO_MQ = WO_OUT + 1048576;
constexpr size_t WO_MK = WO_MQ + 1048576;
constexpr size_t WO_MV = WO_MK + 1048576;
constexpr size_t WO_MO = WO_MV + 1048576;
constexpr size_t WO_1 = WO_MO + 1048576;
constexpr size_t WO_2 = WO_1 + 4194304;
constexpr size_t WO_A = WO_2 + 4194304;
constexpr size_t WO_I = WO_A + 16384;
constexpr size_t WB_ELEMS = WO_I + 16384;

constexpr size_t al256(size_t x) { return (x + 255) & ~(size_t)255; }
constexpr size_t WS_CTL = 0;
constexpr size_t WS_WB0 = 65536;
constexpr size_t WS_WB1 = WS_WB0 + al256(WB_ELEMS * 2);
constexpr size_t WS_XB = WS_WB1 + al256(WB_ELEMS * 2);
constexpr size_t WS_MEMB = WS_XB + (size_t)T * 1024 * 2;
constexpr size_t WS_COS = WS_MEMB + 512 * 1024 * 2;
constexpr size_t WS_SIN = WS_COS + (size_t)T * 16 * 4;
constexpr size_t WS_KMEM = WS_SIN + (size_t)T * 16 * 4;
constexpr size_t WS_VMEM = WS_KMEM + 512 * 1024 * 2;
constexpr size_t WS_WQKT = WS_VMEM + 512 * 1024 * 2;
constexpr size_t WS_VWOT = WS_WQKT + 2 * 1048576 * 2;
constexpr size_t WS_DTRAW = WS_VWOT + 2 * 1048576 * 2;
constexpr size_t WS_ACUM = WS_DTRAW + (size_t)T * 16;
constexpr size_t WS_ATOT = WS_ACUM + (size_t)T * 16;
constexpr size_t WS_HEND = WS_ATOT + 4096;
constexpr size_t WS_AEND = WS_HEND + 131072;
constexpr size_t WS_HIN = WS_AEND + 131072;
constexpr size_t WS_PART = WS_HIN + 131072;
constexpr size_t WS_PQ = WS_PART + (size_t)(T + 512) * 64;
constexpr size_t WS_PKV = WS_PQ + (size_t)T * 16;
constexpr size_t WS_ARENA = WS_PKV + (size_t)T * 8;
constexpr size_t AR_U = WS_ARENA;
constexpr size_t AR_Q = AR_U + (size_t)T * NIN * 2;
constexpr size_t AR_K = AR_Q + (size_t)16 * 8192 * 96 * 2;
constexpr size_t AR_V = AR_K + (size_t)16 * 8192 * 96 * 2;
constexpr size_t AR_YMLA = AR_V + (size_t)16 * 8192 * 64 * 2;
constexpr size_t AR_YLOC = AR_YMLA + (size_t)T * 512 * 2;
constexpr size_t AR_STATES = AR_YLOC + (size_t)T * 256 * 2;
constexpr size_t AR_SIN = AR_STATES + (size_t)2 * 64 * 4 * 4096 * 4;
constexpr size_t AR_CC = AR_SIN + (size_t)2 * 64 * 4 * 4096 * 2;
constexpr size_t AR_HLOC = AR_CC + (size_t)T * 128 * 2;
constexpr size_t AR_ACP = AR_HLOC + (size_t)T * 256 * 2;
constexpr size_t WS_END = AR_ACP + (size_t)T * 256 * 2;
constexpr size_t AR_YMIX = AR_Q;
constexpr size_t AR_P = AR_U;
constexpr size_t AR_H = WS_ARENA;
static_assert(AR_H + (size_t)T * 4096 * 2 <= WS_END, "H overlay");
static_assert(AR_YMIX + (size_t)T * 1024 * 2 <= AR_V, "ymix overlay");

#define XB_TMO      128
#define XB_XCNT(j)  (256  + 64 * (j))
#define XB_XSUB(j)  (1280 + 64 * (j))
#define XB_XGEN(j)  (2304 + 64 * (j))
#define XB_TOP      3328
#define XB_TOPGEN   3392
#define XCD_BAR_WORDS 3456
#define XB_SPIN_CAP (1u << 20)
constexpr int CW_QUEUE = 4096;

struct Params {
    const float* in[35];
    float* out;
    unsigned char* ws;
};

struct Ctx { const float* const* in; float* out; unsigned char* ws; };
DI int VBID() { int z_; asm volatile("s_mov_b32 %0, 0" : "=s"(z_)); return (int)blockIdx.x * 2 + (int)(threadIdx.x >> 8) + z_; }
DI int VGRID() { return (int)gridDim.x * 2; }

typedef __bf16 bf16x2_t __attribute__((ext_vector_type(2)));
DI unsigned pk2(float lo, float hi) { const bf16x2_t v = {(__bf16)lo, (__bf16)hi}; return __builtin_bit_cast(unsigned, v); }
DI float bflo(unsigned u) { return __uint_as_float(u << 16); }
DI float bfhi(unsigned u) { return __uint_as_float(u & 0xffff0000u); }
DI float sigmoidf_(float x) { return __builtin_amdgcn_rcpf(1.0f + __expf(-x)); }
DI float softplus_fast(float x) { const float y = __expf(x); const float ser = y * (1.0f - y * (0.5f - y * (0.33333334f - 0.25f * y))); const float lg = __logf(1.0f + y); return x > 15.f ? x : (y < 0.03f ? ser : lg); }
DI float neg_expm1_fast(float x) { const float ser = -x * (1.0f + x * (0.5f + x * (0.16666667f + x * (0.041666668f + x * 0.008333334f)))); const float ex = 1.0f - __expf(x); return x > -0.1f ? ser : ex; }
DI float siluf_(float x) { return x * sigmoidf_(x); }
DI float softplusf_(float x) { return x > 20.f ? x : log1pf(__expf(x)); }
DI float gelu_tanh_(float x) { const float y = 0.7978845608028654f * (x + 0.044715f * x * x * x); const float t = 1.0f - 2.0f / (__expf(2.0f * y) + 1.0f); return 0.5f * x * (1.0f + t); }
DI int crow(int r, int hi) { return (r & 3) + 8 * (r >> 2) + 4 * hi; }
typedef short v4i16_t __attribute__((ext_vector_type(4)));
DI s16x4 tr_read(const char* p) { return __builtin_bit_cast(s16x4, __builtin_amdgcn_ds_read_tr16_b64_v4i16((LAS v4i16_t*)(uintptr_t)(unsigned)(uintptr_t)p)); }
DI bf16x8 cat8(s16x4 lo, s16x4 hi) { return (bf16x8){lo[0], lo[1], lo[2], lo[3], hi[0], hi[1], hi[2], hi[3]}; }

DI void store_pair16(bf16_t* blk, int hi, int k, u32x2 a, u32x2 b) {
    const auto r0 = __builtin_amdgcn_permlane32_swap(a[0], b[0], false, false);
    const auto r1 = __builtin_amdgcn_permlane32_swap(a[1], b[1], false, false);
    *(u32x4*)(blk + 8 * k + 8 * hi) = (u32x4){r0[0], r1[0], r0[1], r1[1]};
}

DI unsigned xb_ld(unsigned* p) { return __hip_atomic_load(p, __ATOMIC_RELAXED, __HIP_MEMORY_SCOPE_AGENT); }
DI unsigned xb_add(unsigned* p, unsigned v) { return __hip_atomic_fetch_add(p, v, __ATOMIC_RELAXED, __HIP_MEMORY_SCOPE_AGENT); }
DI unsigned xb_xcc_id() { return (unsigned)__builtin_amdgcn_s_getreg((3 << 11) | 20) & 0xFu; }
#define XB_SPIN(cond, bar) do { unsigned _sp = 0; while (cond) { __builtin_amdgcn_s_sleep(1); \
    if ((++_sp & 255u) == 0u) { if (xb_ld(&(bar)[XB_TMO])) break; if (_sp > XB_SPIN_CAP) { atomicAdd(&(bar)[XB_TMO], 1u); break; } } } } while (0)
struct XcdBarrier { unsigned* bar; unsigned x; volatile unsigned* st; };
DI XcdBarrier xcd_barrier_post(unsigned* bar, volatile unsigned* st) {
    XcdBarrier b; b.bar = bar; b.x = xb_xcc_id(); b.st = st;
    if (threadIdx.x == 0) (void)xb_add(&bar[XB_XCNT(b.x)], 1u);
    return b;
}
DI void xcd_barrier_complete(unsigned* bar, unsigned x, unsigned& nloc, unsigned& nx) {
    const unsigned G = gridDim.x;
    unsigned sum, cnt, mine, sp = 0u;
    for (;;) {
        sum = 0u; cnt = 0u; mine = 0u;
#pragma unroll
        for (unsigned j = 0; j < 16; ++j) { const unsigned c = xb_ld(&bar[XB_XCNT(j)]); sum += c; cnt += (c > 0u) ? 1u : 0u; mine = (j == x) ? c : mine; }
        if (sum == G) break;
        __builtin_amdgcn_s_sleep(1);
        if ((++sp & 255u) == 0u) { if (xb_ld(&bar[XB_TMO])) break; if (sp > XB_SPIN_CAP) { atomicAdd(&bar[XB_TMO], 1u); break; } }
    }
    nloc = mine > 0u ? mine : 1u; nx = cnt > 0u ? cnt : 1u;
}
DI void xcd_barrier(unsigned* bar_in) {
    extern __shared__ __attribute__((aligned(16))) char dyn_lds_[];
    XcdBarrier b; b.bar = bar_in; b.st = (volatile unsigned*)(dyn_lds_ + XB_LDS_OFF); b.x = xb_xcc_id();
    asm volatile("s_waitcnt vmcnt(0)" ::: "memory");
    __syncthreads();
    if (threadIdx.x == 0) {
        int z_; asm volatile("s_mov_b32 %0, 0" : "=s"(z_));
        unsigned* bar = b.bar + z_;
        __builtin_amdgcn_s_waitcnt(0);
        unsigned nloc = b.st[0], nx = b.st[1];
        if (nloc == 0u) { xcd_barrier_complete(bar, b.x, nloc, nx); b.st[0] = nloc; b.st[1] = nx; }
        const unsigned old = xb_add(&bar[XB_XSUB(b.x)], 1u);
        const unsigned gen = old / nloc;
        if (old + 1u == (gen + 1u) * nloc) {
            __builtin_amdgcn_fence(__ATOMIC_RELEASE, "agent");
            asm volatile("s_waitcnt vmcnt(0)" ::: "memory");
            const unsigned og = xb_add(&bar[XB_TOP], 1u);
            const unsigned tg = og / nx;
            if (og + 1u == (tg + 1u) * nx) xb_add(&bar[XB_TOPGEN], 1u);
            else XB_SPIN(xb_ld(&bar[XB_TOPGEN]) == tg, bar);
            __builtin_amdgcn_fence(__ATOMIC_ACQUIRE, "agent");
            xb_add(&bar[XB_XGEN(b.x)], 1u);
            asm volatile("s_waitcnt vmcnt(0)" ::: "memory");
        } else {
            XB_SPIN(xb_ld(&bar[XB_XGEN(b.x)]) == gen, bar);
            __builtin_amdgcn_fence(__ATOMIC_ACQUIRE, "agent");
            asm volatile("s_waitcnt vmcnt(0)" ::: "memory");
        }
    }
    __syncthreads();
}

template <int WAVES_M, int WAVES_N, int MB, int NB, int NORM_A  , class Epi>
DI void gemm_tile(const bf16_t* __restrict__ A, int lda, const bf16_t* __restrict__ Bt, int ldb, int K, int m0, int n0, char* smem, const Epi& epi, const float* part = nullptr) {
    constexpr int BM = WAVES_M * MB * 32, BN = WAVES_N * NB * 32, LA = BM / 32, LB = BN / 32, RS = 144;
    char* As = smem; char* Bs = smem + BM * RS; float* rsc = (float*)(smem + (BM + BN) * RS);
    int tid_ = threadIdx.x & 255; asm volatile("" : "+v"(tid_));
    const int tid = tid_, lane = tid & 63, wid = tid >> 6, r32 = lane & 31, hi = lane >> 5;
    const int wm = wid / WAVES_N, wn = wid % WAVES_N;
    const int lrow = tid >> 3, lkc = tid & 7;
    const bf16_t* Ap = A + (size_t)(m0 + lrow) * lda + lkc * 8;
    const bf16_t* Bp = Bt + (size_t)(n0 + lrow) * ldb + lkc * 8;
    u32x4 ra[LA], rb[LB]; float ss[LA];
    f32x16 acc[NB][MB];
#pragma unroll
    for (int i = 0; i < LA; ++i) ss[i] = 0.f;
#pragma unroll
    for (int nb = 0; nb < NB; ++nb)
#pragma unroll
        for (int mb = 0; mb < MB; ++mb)
#pragma unroll
            for (int r = 0; r < 16; ++r) acc[nb][mb][r] = 0.f;
#pragma unroll
    for (int i = 0; i < LA; ++i) ra[i] = *(const u32x4*)(Ap + (size_t)i * 32 * lda);
#pragma unroll
    for (int i = 0; i < LB; ++i) rb[i] = *(const u32x4*)(Bp + (size_t)i * 32 * ldb);
    const int nk = K >> 6;
    for (int kt = 0; kt < nk; ++kt) {
        __syncthreads();
#pragma unroll
        for (int i = 0; i < LA; ++i) *(u32x4*)(As + (lrow + 32 * i) * RS + lkc * 16) = ra[i];
#pragma unroll
        for (int i = 0; i < LB; ++i) *(u32x4*)(Bs + (lrow + 32 * i) * RS + lkc * 16) = rb[i];
        if (NORM_A == 1) {
#pragma unroll
            for (int i = 0; i < LA; ++i)
#pragma unroll
                for (int j = 0; j < 4; ++j) { const float a = bflo(ra[i][j]), b = bfhi(ra[i][j]); ss[i] += a * a + b * b; }
        }
        __syncthreads();
        if (kt + 1 < nk) {
            Ap += 64; Bp += 64;
#pragma unroll
            for (int i = 0; i < LA; ++i) ra[i] = *(const u32x4*)(Ap + (size_t)i * 32 * lda);
#pragma unroll
            for (int i = 0; i < LB; ++i) rb[i] = *(const u32x4*)(Bp + (size_t)i * 32 * ldb);
        }
#pragma unroll
        for (int s = 0; s < 4; ++s) {
            bf16x8 af[MB], bfr[NB];
#pragma unroll
            for (int mb = 0; mb < MB; ++mb) af[mb] = *(const bf16x8*)(As + (wm * MB * 32 + mb * 32 + r32) * RS + s * 32 + hi * 16);
#pragma unroll
            for (int nb = 0; nb < NB; ++nb) bfr[nb] = *(const bf16x8*)(Bs + (wn * NB * 32 + nb * 32 + r32) * RS + s * 32 + hi * 16);
#pragma unroll
            for (int nb = 0; nb < NB; ++nb)
#pragma unroll
                for (int mb = 0; mb < MB; ++mb) acc[nb][mb] = MFMA(bfr[nb], af[mb], acc[nb][mb]);
        }
    }
    if (NORM_A == 1) {
#pragma unroll
        for (int i = 0; i < LA; ++i) {
            float s = ss[i]; s += __shfl_xor(s, 1); s += __shfl_xor(s, 2); s += __shfl_xor(s, 4);
            if (lkc == 0) rsc[lrow + 32 * i] = rsqrtf(s / (float)K + EPS);
        }
        __syncthreads();
    }
    if (NORM_A == 2) {
        if (tid < BM) { const float* pp = part + (size_t)(m0 + tid) * 16; const f32x4 a = *(const f32x4*)pp, b = *(const f32x4*)(pp + 4), c = *(const f32x4*)(pp + 8), d = *(const f32x4*)(pp + 12);
            rsc[tid] = rsqrtf((((a[0] + a[1]) + (a[2] + a[3])) + ((b[0] + b[1]) + (b[2] + b[3])) + ((c[0] + c[1]) + (c[2] + c[3])) + ((d[0] + d[1]) + (d[2] + d[3]))) * (1.0f / 1024.0f) + EPS); }
        __syncthreads();
    }
    epi.template run<NB, MB>(acc, m0 + wm * MB * 32, n0 + wn * NB * 32, r32, hi, rsc + wm * MB * 32);
}

DI void glds16(const void* g, unsigned lds_addr) {
    unsigned sv;
    asm volatile("s_mov_b32 %0, m0\n\ts_mov_b32 m0, %2\n\ts_nop 0\n\tglobal_load_lds_dwordx4 %1, off\n\ts_mov_b32 m0, %0" : "=&s"(sv) : "v"(g), "s"(lds_addr) : "memory");
}
template <class E, class = void> struct IsStaged { static constexpr bool v = false; };
template <class E> struct IsStaged<E, decltype((void)E::STAGED)> { static constexpr bool v = E::STAGED; };
struct Tile256 { const bf16_t* A; const bf16_t* Bt; const float* part; int lda, ldb, K, m0, n0, npart, tag; float invk; };
template <class Epi, class TileFn>
DI void gemm256_stream(const TileFn& tf, int it0, int step, int ntiles, char* smem, const Epi& epi) {
    constexpr int MB = 4, NB = 2, BM = 256, STG = 65536, NSEG = 8;
    int tid_ = threadIdx.x; asm volatile("" : "+v"(tid_));
    const int tid = tid_, lane = tid & 63, wid = tid >> 6, r32 = lane & 31, hi = lane >> 5;
    const int wm = wid >> 2, wn = wid & 3;
    const int lr = lane >> 3, cc = lane & 7;
    const unsigned lds0 = (unsigned)(uintptr_t)smem;
    float* rsc = (float*)(smem + 2 * STG);
    int aoff[MB], boff[NB], asw[MB], bsw[NB];
#pragma unroll
    for (int mb = 0; mb < MB; ++mb) { const int r = wm * 128 + mb * 32 + r32; aoff[mb] = r * 128; asw[mb] = (r >> 1) & 7; }
#pragma unroll
    for (int nb = 0; nb < NB; ++nb) { const int r = wn * 64 + nb * 32 + r32; boff[nb] = (BM + r) * 128; bsw[nb] = (r >> 1) & 7; }
#define SRC_OF(T_, j_) ((j_) < 4 ? (T_).A + (size_t)((T_).m0 + 8 * (wid + 8 * (j_)) + lr) * (T_).lda + ((cc ^ (((8 * (wid + 8 * (j_)) + lr) >> 1) & 7)) * 8) \
                                 : (T_).Bt + (size_t)((T_).n0 + 8 * (wid + 8 * (j_)) + lr - BM) * (T_).ldb + ((cc ^ (((8 * (wid + 8 * (j_)) + lr - BM) >> 1) & 7)) * 8))
    bool primed = false;
    for (int it = it0; it < ntiles; it += step) {
        const Tile256 t = tf(it);
        const int nk = t.K >> 6;
        const bf16_t* src[NSEG];
#pragma unroll
        for (int j = 0; j < NSEG; ++j) src[j] = SRC_OF(t, j);
        f32x16 acc[NB][MB];
#pragma unroll
        for (int nb = 0; nb < NB; ++nb)
#pragma unroll
            for (int mb = 0; mb < MB; ++mb)
#pragma unroll
                for (int r = 0; r < 16; ++r) acc[nb][mb][r] = 0.f;
        if (!primed) {
            __syncthreads();
#pragma unroll
            for (int j = 0; j < NSEG; ++j) glds16(src[j], (unsigned)__builtin_amdgcn_readfirstlane((int)(lds0 + (wid + 8 * j) * 1024)));
        }
        for (int kt = 0; kt < nk; ++kt) {
            asm volatile("s_waitcnt vmcnt(0)\n\ts_barrier" ::: "memory");
            if (kt + 1 < nk) {
#pragma unroll
                for (int j = 0; j < NSEG; ++j) glds16(src[j] + (size_t)(kt + 1) * 64, (unsigned)__builtin_amdgcn_readfirstlane((int)(lds0 + ((kt + 1) & 1) * STG + (wid + 8 * j) * 1024)));
            } else if (it + step < ntiles) {
                const Tile256 tn = tf(it + step);
#pragma unroll
                for (int j = 0; j < NSEG; ++j) glds16(SRC_OF(tn, j), (unsigned)__builtin_amdgcn_readfirstlane((int)(lds0 + (wid + 8 * j) * 1024)));
                primed = true;
            }
            const char* st = smem + (kt & 1) * STG;
#pragma unroll
            for (int s = 0; s < 4; ++s) {
                bf16x8 af[MB], bfr[NB];
#pragma unroll
                for (int mb = 0; mb < MB; ++mb) af[mb] = *(const bf16x8*)(st + aoff[mb] + (((2 * s + hi) ^ asw[mb]) * 16));
#pragma unroll
                for (int nb = 0; nb < NB; ++nb) bfr[nb] = *(const bf16x8*)(st + boff[nb] + (((2 * s + hi) ^ bsw[nb]) * 16));
#pragma unroll
                for (int nb = 0; nb < NB; ++nb)
#pragma unroll
                    for (int mb = 0; mb < MB; ++mb) acc[nb][mb] = MFMA(bfr[nb], af[mb], acc[nb][mb]);
            }
        }
        if (t.part) {
            if (tid < BM) { const float* pp = t.part + (size_t)(t.m0 + tid) * t.npart; float sq = 0.f;
                for (int i = 0; i < t.npart; i += 2) sq += pp[i] + pp[i + 1];
                rsc[tid] = rsqrtf(sq * t.invk + EPS); }
            __syncthreads();
        }
        if constexpr (IsStaged<Epi>::v) epi.template run_staged<NB, MB>(acc, t.m0, t.n0, wm, wn, r32, hi, lane, wid, smem + STG);
        else epi.template run<NB, MB>(acc, t.m0 + wm * 128, t.n0 + wn * 64, r32, hi, rsc + wm * 128, t.tag);
        if (t.part) __syncthreads();
    }
#undef SRC_OF
}

struct EpiP1 {
    bf16_t* U; float* dtraw; float* pq; float* pkv;
    template <int NB, int MB> DI void run(f32x16 (&acc)[NB][MB], int mb0, int nb0, int r32, int hi, const float* rs, int tag = 0) const {
#pragma unroll
        for (int mb = 0; mb < MB; ++mb) { const int row = mb0 + mb * 32 + r32; const float sc = rs[mb * 32 + r32]; float ssq = 0.f;
#pragma unroll
            for (int nb = 0; nb < NB; ++nb) { const int cb = nb0 + nb * 32; u32x2 w[4];
#pragma unroll
                for (int g = 0; g < 4; ++g) {
                    const float v0 = acc[nb][mb][4 * g] * sc, v1 = acc[nb][mb][4 * g + 1] * sc, v2 = acc[nb][mb][4 * g + 2] * sc, v3 = acc[nb][mb][4 * g + 3] * sc;
                    w[g] = (u32x2){pk2(v0, v1), pk2(v2, v3)}; ssq += (v0 * v0 + v1 * v1) + (v2 * v2 + v3 * v3);
                    if (cb + 8 * g + 4 * hi == UC_DT) *(f32x4*)(dtraw + (size_t)row * 4) = (f32x4){v0, v1, v2, v3}; }
                bf16_t* blk = U + (size_t)row * NIN + cb;
                store_pair16(blk, hi, 0, w[0], w[1]); store_pair16(blk, hi, 2, w[2], w[3]); }
            if (nb0 < UC_KR) { ssq += __shfl_xor(ssq, 32);
                if (hi == 0) { if (nb0 < UC_CKV) pq[(size_t)row * 4 + (nb0 >> 6)] = ssq; else pkv[(size_t)row * 2 + ((nb0 - UC_CKV) >> 6)] = ssq; } } }
    }
};
struct EpiP1KV {
    EpiP1 p1; bf16_t* kmem; bf16_t* vmem;
    template <int NB, int MB> DI void run(f32x16 (&acc)[NB][MB], int mb0, int nb0, int r32, int hi, const float* rs, int tag = 0) const {
        if (mb0 < T) { p1.template run<NB, MB>(acc, mb0, nb0, r32, hi, rs); return; }
        bf16_t* O = (nb0 >> 10) ? vmem : kmem;
#pragma unroll
        for (int mb = 0; mb < MB; ++mb) { const int row = mb0 - T + mb * 32 + r32; const float sc = rs[mb * 32 + r32];
#pragma unroll
            for (int nb = 0; nb < NB; ++nb) { u32x2 w[4];
#pragma unroll
                for (int g = 0; g < 4; ++g) w[g] = (u32x2){pk2(acc[nb][mb][4 * g] * sc, acc[nb][mb][4 * g + 1] * sc), pk2(acc[nb][mb][4 * g + 2] * sc, acc[nb][mb][4 * g + 3] * sc)};
                bf16_t* blk = O + (size_t)row * 1024 + (nb0 & 1023) + nb * 32;
                store_pair16(blk, hi, 0, w[0], w[1]); store_pair16(blk, hi, 2, w[2], w[3]); } }
    }
};
template <bool USE_RS> struct EpiPlain {
    bf16_t* O; int ld; int row_off, col_off; float scale;
    template <int NB, int MB> DI void run(f32x16 (&acc)[NB][MB], int mb0, int nb0, int r32, int hi, const float* rs, int tag = 0) const {
#pragma unroll
        for (int mb = 0; mb < MB; ++mb) { const int row = mb0 + mb * 32 + r32 + row_off; const float sc = USE_RS ? rs[mb * 32 + r32] * scale : scale;
#pragma unroll
            for (int nb = 0; nb < NB; ++nb)
#pragma unroll
                for (int g = 0; g < 4; ++g) { const int col = nb0 + nb * 32 + 8 * g + 4 * hi + col_off;
                    *(u32x2*)(O + (size_t)row * ld + col) = (u32x2){pk2(acc[nb][mb][4 * g] * sc, acc[nb][mb][4 * g + 1] * sc), pk2(acc[nb][mb][4 * g + 2] * sc, acc[nb][mb][4 * g + 3] * sc)}; } }
    }
};
struct EpiRelu2 {
    bf16_t* H;
    template <int NB, int MB> DI void run(f32x16 (&acc)[NB][MB], int mb0, int nb0, int r32, int hi, const float* rs, int tag = 0) const {
#pragma unroll
        for (int mb = 0; mb < MB; ++mb) { const int row = mb0 + mb * 32 + r32; const float sc = rs[mb * 32 + r32];
#pragma unroll
            for (int nb = 0; nb < NB; ++nb) { u32x2 w[4];
#pragma unroll
                for (int g = 0; g < 4; ++g) { float v[4];
#pragma unroll
                    for (int j = 0; j < 4; ++j) { const float t = fmaxf(acc[nb][mb][4 * g + j] * sc, 0.f); v[j] = t * t; }
                    w[g] = (u32x2){pk2(v[0], v[1]), pk2(v[2], v[3])}; }
                bf16_t* blk = H + (size_t)row * 4096 + nb0 + nb * 32;
                store_pair16(blk, hi, 0, w[0], w[1]); store_pair16(blk, hi, 2, w[2], w[3]); } }
    }
};
struct EpiResid {
    static constexpr bool STAGED = true;
    const float* res; float* out; bf16_t* xb; float* part;
    template <int NB, int MB> DI void run_staged(f32x16 (&acc)[NB][MB], int m0, int n0, int wm, int wn, int r32, int hi, int lane, int wid, char* stage) const {
        asm volatile("s_waitcnt lgkmcnt(0)\n\ts_barrier" ::: "memory");
#pragma unroll 1
        for (int p = 0; p < 4; ++p) {
            if (wn == p) {
#pragma unroll
                for (int mb = 0; mb < MB; ++mb) { const int r = wm * 128 + mb * 32 + r32;
#pragma unroll
                    for (int nb = 0; nb < NB; ++nb)
#pragma unroll
                        for (int g = 0; g < 4; ++g) { const int c = nb * 8 + 2 * g + hi;
                            *(f32x4*)(stage + r * 256 + ((c ^ (r & 15)) * 16)) = (f32x4){acc[nb][mb][4 * g], acc[nb][mb][4 * g + 1], acc[nb][mb][4 * g + 2], acc[nb][mb][4 * g + 3]}; } }
            }
            asm volatile("s_waitcnt lgkmcnt(0)\n\ts_barrier" ::: "memory");
            const int c = lane & 15;
#pragma unroll 2
            for (int q = 0; q < 8; ++q) { const int r = wid * 32 + q * 4 + (lane >> 4); const size_t o = (size_t)(m0 + r) * DM + n0 + 64 * p + 4 * c;
                f32x4 v = *(const f32x4*)(stage + r * 256 + ((c ^ (r & 15)) * 16));
                const f32x4 rr = *(const f32x4*)(res + o);
                v[0] += rr[0]; v[1] += rr[1]; v[2] += rr[2]; v[3] += rr[3];
                *(f32x4*)(out + o) = v; *(u32x2*)(xb + o) = (u32x2){pk2(v[0], v[1]), pk2(v[2], v[3])};
                float ssq = (v[0] * v[0] + v[1] * v[1]) + (v[2] * v[2] + v[3] * v[3]);
                ssq += __shfl_xor(ssq, 1); ssq += __shfl_xor(ssq, 2); ssq += __shfl_xor(ssq, 4); ssq += __shfl_xor(ssq, 8);
                if (c == 0) part[(size_t)(m0 + r) * 16 + (n0 >> 6) + p] = ssq; }
            asm volatile("s_waitcnt lgkmcnt(0)\n\ts_barrier" ::: "memory");
        }
    }
    template <int NB, int MB> DI void run(f32x16 (&acc)[NB][MB], int mb0, int nb0, int r32, int hi, const float*, int tag = 0) const {
#pragma unroll
        for (int mb = 0; mb < MB; ++mb) { const int row = mb0 + mb * 32 + r32; float ssq = 0.f;
#pragma unroll
            for (int nb = 0; nb < NB; ++nb)
                { u32x2 w[4];
#pragma unroll
                for (int g = 0; g < 4; ++g) { const int col = nb0 + nb * 32 + 8 * g + 4 * hi; const size_t o = (size_t)row * DM + col;
                    f32x4 v = *(const f32x4*)(res + o);
                    v[0] += acc[nb][mb][4 * g]; v[1] += acc[nb][mb][4 * g + 1]; v[2] += acc[nb][mb][4 * g + 2]; v[3] += acc[nb][mb][4 * g + 3];
                    *(f32x4*)(out + o) = v; ssq += (v[0] * v[0] + v[1] * v[1]) + (v[2] * v[2] + v[3] * v[3]);
                    w[g] = (u32x2){pk2(v[0], v[1]), pk2(v[2], v[3])}; }
                bf16_t* blk = xb + (size_t)row * DM + nb0 + nb * 32;
                store_pair16(blk, hi, 0, w[0], w[1]); store_pair16(blk, hi, 2, w[2], w[3]); }
            ssq += __shfl_xor(ssq, 32);
            if (hi == 0) part[(size_t)row * 16 + (nb0 >> 6)] = ssq; }
    }
};
struct EpiSoftmax {
    bf16_t* P; float* xch;
    template <int NB, int MB> DI void run(f32x16 (&acc)[NB][MB], int mb0, int nb0, int r32, int hi, const float* rs, int tag = 0) const {
        const int row = mb0 + r32; const float sc = rs[r32]; const int wm = (mb0 >> 5) & 1, wn = (nb0 >> 7) & 1;
        float m = -3.0e38f;
#pragma unroll
        for (int nb = 0; nb < NB; ++nb)
#pragma unroll
            for (int r = 0; r < 16; ++r) { acc[nb][0][r] *= sc; m = fmaxf(m, acc[nb][0][r]); }
        m = fmaxf(m, __shfl_xor(m, 32));
        if (hi == 0) xch[(wm * 2 + wn) * 32 + r32] = m;
        __syncthreads();
        m = fmaxf(m, xch[(wm * 2 + (wn ^ 1)) * 32 + r32]);
        float s = 0.f;
#pragma unroll
        for (int nb = 0; nb < NB; ++nb)
#pragma unroll
            for (int r = 0; r < 16; ++r) { const float p = __builtin_amdgcn_exp2f(acc[nb][0][r] - m); acc[nb][0][r] = p; s += p; }
        s += __shfl_xor(s, 32);
        if (hi == 0) xch[128 + (wm * 2 + wn) * 32 + r32] = s;
        __syncthreads();
        s += xch[128 + (wm * 2 + (wn ^ 1)) * 32 + r32];
        const float inv = 1.0f / s;
#pragma unroll
        for (int nb = 0; nb < NB; ++nb)
#pragma unroll
            for (int g = 0; g < 4; ++g) { const int col = nb0 + nb * 32 + 8 * g + 4 * hi;
                *(u32x2*)(P + (size_t)row * DM + col) = (u32x2){pk2(acc[nb][0][4 * g] * inv, acc[nb][0][4 * g + 1] * inv), pk2(acc[nb][0][4 * g + 2] * inv, acc[nb][0][4 * g + 3] * inv)}; }
    }
};
struct EpiSoftmax256 {
    bf16_t* P; float* xch;
    template <int NB, int MB> DI void run(f32x16 (&acc)[NB][MB], int mb0, int nb0, int r32, int hi, const float* rs, int tag = 0) const {
        const int wn = (nb0 >> 6) & 3, lr0 = (mb0 & 255) + r32;
#pragma unroll
        for (int mb = 0; mb < MB; ++mb) { const float sc = rs[mb * 32 + r32]; float m = -3.0e38f;
#pragma unroll
            for (int nb = 0; nb < NB; ++nb)
#pragma unroll
                for (int r = 0; r < 16; ++r) { acc[nb][mb][r] *= sc; m = fmaxf(m, acc[nb][mb][r]); }
            m = fmaxf(m, __shfl_xor(m, 32));
            if (hi == 0) xch[(lr0 + mb * 32) * 4 + wn] = m; }
        __syncthreads();
#pragma unroll
        for (int mb = 0; mb < MB; ++mb) { const f32x4 mm = *(const f32x4*)(xch + (lr0 + mb * 32) * 4); const float m = fmaxf(fmaxf(mm[0], mm[1]), fmaxf(mm[2], mm[3])); float sm = 0.f;
#pragma unroll
            for (int nb = 0; nb < NB; ++nb)
#pragma unroll
                for (int r = 0; r < 16; ++r) { const float p = __builtin_amdgcn_exp2f(acc[nb][mb][r] - m); acc[nb][mb][r] = p; sm += p; }
            sm += __shfl_xor(sm, 32);
            if (hi == 0) xch[1024 + (lr0 + mb * 32) * 4 + wn] = sm; }
        __syncthreads();
#pragma unroll
        for (int mb = 0; mb < MB; ++mb) { const f32x4 sv = *(const f32x4*)(xch + 1024 + (lr0 + mb * 32) * 4); const float inv = __builtin_amdgcn_rcpf((sv[0] + sv[1]) + (sv[2] + sv[3]));
            const int row = mb0 + mb * 32 + r32;
#pragma unroll
            for (int nb = 0; nb < NB; ++nb) { u32x2 w[4];
#pragma unroll
                for (int g = 0; g < 4; ++g) w[g] = (u32x2){pk2(acc[nb][mb][4 * g] * inv, acc[nb][mb][4 * g + 1] * inv), pk2(acc[nb][mb][4 * g + 2] * inv, acc[nb][mb][4 * g + 3] * inv)};
                bf16_t* blk = P + (size_t)row * DM + nb0 + nb * 32;
                store_pair16(blk, hi, 0, w[0], w[1]); store_pair16(blk, hi, 2, w[2], w[3]); } }
    }
};
constexpr float QSCALE = 0.10206207261596575f * LOG2E;
struct EpiQ {
    bf16_t* Q; const float* cs; const float* sn;
    template <int NB, int MB> DI void run(f32x16 (&acc)[NB][MB], int mb0, int nb0, int r32, int hi, const float* rs, int tag = 0) const {
#pragma unroll
        for (int mb = 0; mb < MB; ++mb) { const int row = mb0 + mb * 32 + r32; const float sc = rs[mb * 32 + r32] * QSCALE; const int b = row >> 13, s = row & 8191;
#pragma unroll
            for (int nb = 0; nb < NB; ++nb) { const int cb = nb0 + nb * 32; const int h = cb / 96, d0 = cb - h * 96;
                float v[16];
#pragma unroll
                for (int r = 0; r < 16; ++r) v[r] = acc[nb][mb][r] * sc;
                if (d0 == 64) {
#pragma unroll
                    for (int g = 0; g < 2; ++g) { const f32x4 c = *(const f32x4*)(cs + (size_t)row * 16 + 8 * g + 4 * hi), sv = *(const f32x4*)(sn + (size_t)row * 16 + 8 * g + 4 * hi);
#pragma unroll
                        for (int j = 0; j < 4; ++j) { const float x1 = v[4 * g + j], x2 = v[4 * (g + 2) + j]; v[4 * g + j] = x1 * c[j] - x2 * sv[j]; v[4 * (g + 2) + j] = x2 * c[j] + x1 * sv[j]; } }
                }
                bf16_t* qp = Q + ((size_t)(b * 8 + h) * SEQ + s) * 96 + d0 + 4 * hi;
#pragma unroll
                for (int g = 0; g < 4; ++g) *(u32x2*)(qp + 8 * g) = (u32x2){pk2(v[4 * g], v[4 * g + 1]), pk2(v[4 * g + 2], v[4 * g + 3])}; } }
    }
};
struct EpiKV {
    bf16_t* Kimg; bf16_t* Vimg; const bf16_t* U; const float* cs; const float* sn;
    template <int NB, int MB> DI void run(f32x16 (&acc)[NB][MB], int mb0, int nb0, int r32, int hi, const float* rs, int tag = 0) const {
        const int h = nb0 >> 7, isv = (nb0 >> 6) & 1;
#pragma unroll
        for (int mb = 0; mb < MB; ++mb) { const int row = mb0 + mb * 32 + r32; const float sc = rs[mb * 32 + r32]; const int b = row >> 13, s = row & 8191, tile = s >> 6, rin = s & 63;
            const size_t tb = (size_t)(b * 8 + h) * 128 + tile;
#pragma unroll
            for (int nb = 0; nb < NB; ++nb)
#pragma unroll
                for (int g = 0; g < 4; ++g) { const u32x2 w = (u32x2){pk2(acc[nb][mb][4 * g] * sc, acc[nb][mb][4 * g + 1] * sc), pk2(acc[nb][mb][4 * g + 2] * sc, acc[nb][mb][4 * g + 3] * sc)};
                    if (!isv) *(u32x2*)(Kimg + (tb * 12 + nb * 4 + g) * 512 + rin * 8 + 4 * hi) = w;
                    else *(u32x2*)(Vimg + (tb * 2 + nb) * 2048 + rin * 32 + 8 * g + 4 * hi) = w; }
            if (!isv) {
                const u32x4 a = *(const u32x4*)(U + (size_t)row * NIN + UC_KR + 8 * hi), bq = *(const u32x4*)(U + (size_t)row * NIN + UC_KR + 16 + 8 * hi);
                unsigned w1[4], w2[4];
#pragma unroll
                for (int p = 0; p < 2; ++p) {
                    const f32x4 c = *(const f32x4*)(cs + (size_t)row * 16 + 8 * hi + 4 * p), sv = *(const f32x4*)(sn + (size_t)row * 16 + 8 * hi + 4 * p);
                    const float x1a = bflo(a[2 * p]), x1b = bfhi(a[2 * p]), x1c = bflo(a[2 * p + 1]), x1d = bfhi(a[2 * p + 1]);
                    const float x2a = bflo(bq[2 * p]), x2b = bfhi(bq[2 * p]), x2c = bflo(bq[2 * p + 1]), x2d = bfhi(bq[2 * p + 1]);
                    w1[2 * p] = pk2(x1a * c[0] - x2a * sv[0], x1b * c[1] - x2b * sv[1]); w1[2 * p + 1] = pk2(x1c * c[2] - x2c * sv[2], x1d * c[3] - x2d * sv[3]);
                    w2[2 * p] = pk2(x2a * c[0] + x1a * sv[0], x2b * c[1] + x1b * sv[1]); w2[2 * p + 1] = pk2(x2c * c[2] + x1c * sv[2], x2d * c[3] + x1d * sv[3]);
                }
                *(u32x4*)(Kimg + (tb * 12 + 8 + hi) * 512 + rin * 8) = (u32x4){w1[0], w1[1], w1[2], w1[3]};
                *(u32x4*)(Kimg + (tb * 12 + 10 + hi) * 512 + rin * 8) = (u32x4){w2[0], w2[1], w2[2], w2[3]};
            } }
    }
};

struct EpiStage1 {
    EpiKV kv; EpiQ q; bf16_t* wqkt; bf16_t* vwot;
    template <int NB, int MB> DI void run(f32x16 (&acc)[NB][MB], int mb0, int nb0, int r32, int hi, const float* rs, int tag = 0) const {
        const int kind = tag & 3, b = (tag >> 2) & 1, h = (tag >> 3) & 3;
        if (kind == 0) kv.template run<NB, MB>(acc, mb0, nb0, r32, hi, rs);
        else if (kind == 1) q.template run<NB, MB>(acc, mb0, nb0, r32, hi, rs);
        else if (kind == 2) { EpiPlain<false> e{wqkt + (size_t)b * 1048576, 1024, h * 256 - b * 256, 0, 0.0625f * LOG2E}; e.template run<NB, MB>(acc, mb0, nb0, r32, hi, rs); }
        else { EpiPlain<false> e{vwot + (size_t)b * 1048576, 1024, 0, h * 256, 1.0f}; e.template run<NB, MB>(acc, mb0, nb0, r32, hi, rs); }
    }
};

DI void convT_tiles(const float* __restrict__ src, int srcld, int K, int N, bf16_t* __restrict__ dst, int dstld, const float* __restrict__ gain, float* tl, int& base) {
    int tid_ = threadIdx.x & 255; asm volatile("" : "+v"(tid_));
    const int G = VGRID(), tid = tid_; const int tn = (N + 63) >> 6, tiles = (K >> 6) * tn;
    int start = (VBID() - base) % G; if (start < 0) start += G;
    const int niter = (tiles + G - 1) / G;
    for (int itr = 0; itr < niter; ++itr) {
        const int t = start + itr * G; const bool valid = t < tiles;
        const int k0 = valid ? (t / tn) * 64 : 0, n0 = valid ? (t % tn) * 64 : 0;
        __syncthreads();
        if (valid) {
#pragma unroll
        for (int i = 0; i < 4; ++i) { const int k = (tid >> 4) + 16 * i, nn = (tid & 15) * 4; const float g = gain ? gain[k0 + k] : 1.0f;
            f32x4 v = (f32x4){0.f, 0.f, 0.f, 0.f};
            if (n0 + nn + 3 < N) v = *(const f32x4*)(src + (size_t)(k0 + k) * srcld + n0 + nn);
            tl[k * 65 + nn] = v[0] * g; tl[k * 65 + nn + 1] = v[1] * g; tl[k * 65 + nn + 2] = v[2] * g; tl[k * 65 + nn + 3] = v[3] * g; }
        }
        __syncthreads();
        const int n = tid >> 2, ks = (tid & 3) * 16;
        if (valid && n0 + n < N) { unsigned w[8];
#pragma unroll
            for (int q = 0; q < 8; ++q) w[q] = pk2(tl[(ks + 2 * q) * 65 + n], tl[(ks + 2 * q + 1) * 65 + n]);
            bf16_t* d = dst + (size_t)(n0 + n) * dstld + k0 + ks;
            *(u32x4*)d = (u32x4){w[0], w[1], w[2], w[3]}; *(u32x4*)(d + 8) = (u32x4){w[4], w[5], w[6], w[7]}; }
    }
    base = (base + tiles) % G;
}
DI void convert_layer_weights(const Ctx& P, int l, float* tl) {
    bf16_t* W = (bf16_t*)(P.ws + ((l & 1) ? WS_WB1 : WS_WB0));
    int base = 0;
    const float* w_in = P.in[4] + (size_t)l * 1024 * 1700; const float* g_mix = P.in[3] + l * 1024;
    const int seg_src[10] = {0, 256, 384, 1184, 416, 672, 928, 1056, 1188, 1444};
    const int seg_w[10] = {256, 128, 32, 4, 256, 256, 128, 128, 256, 256};
    const int seg_dst[10] = {UC_CQ, UC_CKV, UC_KR, UC_DT, UC_Z, UC_XS, UC_BS, UC_CS, UC_XR, UC_GATE};
#pragma unroll
    for (int s = 0; s < 10; ++s) convT_tiles(w_in + seg_src[s], 1700, 1024, seg_w[s], W + WO_IN + (size_t)seg_dst[s] * 1024, 1024, g_mix, tl, base);
    {
        const size_t n = (size_t)92 * 1024 / 8; u32x4* z = (u32x4*)(W + WO_IN + (size_t)420 * 1024);
        int t_ = threadIdx.x & 255; asm volatile("" : "+v"(t_));
        for (size_t i = (size_t)VBID() * 256 + t_; i < n; i += (size_t)VGRID() * 256) z[i] = (u32x4){0u, 0u, 0u, 0u};
    }
    convT_tiles(P.in[7] + (size_t)l * 256 * 768, 768, 256, 768, W + WO_UQ, 256, P.in[5] + l * 256, tl, base);
    convT_tiles(P.in[8] + (size_t)l * 128 * 1024, 1024, 128, 1024, W + WO_UKV, 128, P.in[6] + l * 128, tl, base);
    convT_tiles(P.in[24] + (size_t)l * 1048576, 1024, 512, 1024, W + WO_OUT, 1024, P.in[9] + l * 512, tl, base);
    convT_tiles(P.in[24] + (size_t)l * 1048576 + (size_t)512 * 1024, 1024, 256, 1024, W + WO_OUT + 512, 1024, P.in[15] + l * 256, tl, base);
    convT_tiles(P.in[24] + (size_t)l * 1048576 + (size_t)768 * 1024, 1024, 256, 1024, W + WO_OUT + 768, 1024, P.in[23] + l * 256, tl, base);
    convT_tiles(P.in[28] + (size_t)l * 1048576, 1024, 1024, 1024, W + WO_MK, 1024, P.in[26] + l * 1024, tl, base);
    convT_tiles(P.in[29] + (size_t)l * 1048576, 1024, 1024, 1024, W + WO_MV, 1024, P.in[26] + l * 1024, tl, base);
    convT_tiles(P.in[30] + (size_t)l * 1048576, 1024, 1024, 1024, W + WO_MO, 1024, nullptr, tl, base);
    convT_tiles(P.in[32] + (size_t)l * 4194304, 4096, 1024, 4096, W + WO_1, 1024, P.in[31] + l * 1024, tl, base);
    convT_tiles(P.in[33] + (size_t)l * 4194304, 1024, 4096, 1024, W + WO_2, 4096, nullptr, tl, base);
    for (int n = 0; n < 4; ++n) {
        convT_tiles(P.in[18] + (size_t)(l * 4 + n) * 4096, 64, 64, 64, W + WO_A + n * 4096, 64, nullptr, tl, base);
        convT_tiles(P.in[20] + (size_t)(l * 4 + n) * 4096, 64, 64, 64, W + WO_I + n * 4096, 64, nullptr, tl, base);
    }
    {
        const float* src = P.in[27] + (size_t)l * 1048576; const float* g = P.in[25] + l * 1024; bf16_t* d = W + WO_MQ;
        int t_ = threadIdx.x & 255; asm volatile("" : "+v"(t_));
        for (size_t i = (size_t)VBID() * 256 + t_; i < 131072; i += (size_t)VGRID() * 256) {
            const float gg = g[i >> 7]; const f32x4 a = *(const f32x4*)(src + i * 8), b = *(const f32x4*)(src + i * 8 + 4);
            *(u32x4*)(d + i * 8) = (u32x4){pk2(a[0] * gg, a[1] * gg), pk2(a[2] * gg, a[3] * gg), pk2(b[0] * gg, b[1] * gg), pk2(b[2] * gg, b[3] * gg)}; }
    }
}
DI void phase_prologue(const Ctx& P, char* smem) {
    convert_layer_weights(P, 0, (float*)smem);
    int t_ = threadIdx.x & 255; asm volatile("" : "+v"(t_));
    const size_t gt = (size_t)VBID() * 256 + t_, gs = (size_t)VGRID() * 256;
    {   const float* x = P.in[0]; bf16_t* xb = (bf16_t*)(P.ws + WS_XB); float* part = (float*)(P.ws + WS_PART);
        const int lane = t_ & 63, wid = t_ >> 6;
        for (int row = VBID() * 4 + wid; row < T; row += VGRID() * 4) { float ss = 0.f;
#pragma unroll
            for (int i = 0; i < 4; ++i) { const size_t o = (size_t)row * DM + i * 256 + lane * 4; const f32x4 a = *(const f32x4*)(x + o);
                ss += (a[0] * a[0] + a[1] * a[1]) + (a[2] * a[2] + a[3] * a[3]); *(u32x2*)(xb + o) = (u32x2){pk2(a[0], a[1]), pk2(a[2], a[3])}; }
#pragma unroll
            for (int d = 1; d < 64; d <<= 1) ss += __shfl_xor(ss, d);
            if (lane < 16) part[(size_t)row * 16 + lane] = lane == 0 ? ss : 0.f; } }
    {   const float* x = P.in[1]; bf16_t* xb = (bf16_t*)(P.ws + WS_MEMB); float* part = (float*)(P.ws + WS_PART) + (size_t)T * 16;
        const int lane = t_ & 63, wid = t_ >> 6;
        for (int row = VBID() * 4 + wid; row < 512; row += VGRID() * 4) { float ss = 0.f;
#pragma unroll
            for (int i = 0; i < 4; ++i) { const size_t o = (size_t)row * DM + i * 256 + lane * 4; const f32x4 a = *(const f32x4*)(x + o);
                ss += (a[0] * a[0] + a[1] * a[1]) + (a[2] * a[2] + a[3] * a[3]); *(u32x2*)(xb + o) = (u32x2){pk2(a[0], a[1]), pk2(a[2], a[3])}; }
#pragma unroll
            for (int d = 1; d < 64; d <<= 1) ss += __shfl_xor(ss, d);
            if (lane < 16) part[(size_t)row * 16 + lane] = lane == 0 ? ss : 0.f; } }
    {   const int* pos = (const int*)P.in[2]; float* cs = (float*)(P.ws + WS_COS); float* sn = (float*)(P.ws + WS_SIN);
        for (size_t i = gt; i < (size_t)T * 16; i += gs) { const int tok = (int)(i >> 4), f = (int)(i & 15);
            const float inv = powf(10000.0f, -(float)f * (2.0f / 32.0f)); const float ang = (float)pos[tok] * inv;
            double a = (double)ang; a -= 6.283185307179586 * rint(a * 0.15915494309189535);
            const float ar = (float)a; cs[i] = __cosf(ar); sn[i] = __sinf(ar); } }
}

DI void attn_item(const bf16_t* __restrict__ Q, const bf16_t* __restrict__ Kimg, const bf16_t* __restrict__ Vimg, bf16_t* __restrict__ Y, int bh, int qblk, int NTC, char* smem, int vb) {
    int tid_ = threadIdx.x & 255; asm volatile("" : "+v"(tid_));
    const int tid = tid_, lane = tid & 63, wid = tid >> 6, r32 = lane & 31, hi = lane >> 5;
    char* Kb = smem; char* Vb = smem + 36864; float* wsf = (float*)(smem + 61440 + vb * 17408) + wid * 64; bf16_t* stg = (bf16_t*)(smem + 61440 + vb * 17408 + 1024) + wid * 2048;
    const int gw = vb * 4 + wid;
    const int q0 = qblk * 128, NT = 2 * (qblk + 1);
    const int qrow = q0 + wid * 32 + r32;
    bf16x8 qr[6];
    { const bf16_t* qp = Q + ((size_t)bh * SEQ + qrow) * 96 + 8 * hi;
#pragma unroll
      for (int d0 = 0; d0 < 6; ++d0) qr[d0] = *(const bf16x8*)(qp + 16 * d0); }
    const bf16_t* kg = Kimg + (size_t)bh * 128 * 6144 + gw * 512 + lane * 8;
    const bf16_t* vg = Vimg + (size_t)bh * 128 * 4096 + gw * 512 + lane * 8;
    const unsigned ldsK = (unsigned)(uintptr_t)Kb + gw * 1024, ldsV = (unsigned)(uintptr_t)Vb + gw * 1024;
#define ATT_ISSUE(tt, st_) do { \
        glds16(kg + (size_t)(tt) * 6144, (unsigned)__builtin_amdgcn_readfirstlane((int)(ldsK + (st_) * 12288))); \
        if (gw < 4) glds16(kg + (size_t)(tt) * 6144 + 4096, (unsigned)__builtin_amdgcn_readfirstlane((int)(ldsK + (st_) * 12288 + 8192))); \
        glds16(vg + (size_t)(tt) * 4096, (unsigned)__builtin_amdgcn_readfirstlane((int)(ldsV + (st_) * 8192))); } while (0)
    __syncthreads();
    ATT_ISSUE(0, 0); ATT_ISSUE(1, 1);
    int sc = 0, s1 = 1, sn = 2;
    f32x16 o0, o1;
#pragma unroll
    for (int r = 0; r < 16; ++r) { o0[r] = 0.f; o1[r] = 0.f; }
    float lsum = 0.f;
    f32x16 negm;
#pragma unroll
    for (int r = 0; r < 16; ++r) negm[r] = 0.f;
    const char* vrd0 = Vb + ((lane >> 4) & 1) * 32 + (lane & 3) * 8 + (4 * hi + ((lane & 15) >> 2)) * 64;
#define ATT_QK(S0_, S1_, stg_) do { const char* kb_ = Kb + (stg_) * 12288 + r32 * 16; \
        { const bf16x8 k0 = *(const bf16x8*)(kb_ + hi * 1024), k1 = *(const bf16x8*)(kb_ + hi * 1024 + 512); S0_ = MFMA(k0, qr[0], negm); S1_ = MFMA(k1, qr[0], negm); } \
        _Pragma("unroll") for (int d0 = 1; d0 < 6; ++d0) { const bf16x8 k0 = *(const bf16x8*)(kb_ + (2 * d0 + hi) * 1024), k1 = *(const bf16x8*)(kb_ + (2 * d0 + hi) * 1024 + 512); \
            S0_ = MFMA(k0, qr[d0], S0_); S1_ = MFMA(k1, qr[d0], S1_); } } while (0)
#define MX3_(a, b, c) __builtin_fmaxf(__builtin_fmaxf((a), (b)), (c))
#define ATT_STEP(A0, A1, B0, B1, tt_) do { const int t = (tt_); \
        if (t + 1 < NTC) asm volatile("s_waitcnt vmcnt(0)\n\ts_barrier" ::: "memory");       \
        if (t + 2 < NTC) ATT_ISSUE(t + 2, sn); \
        const bool actN = (t + 1 < NT) && !(t + 1 == NT - 1 && wid < 2);                       \
        if (actN) ATT_QK(B0, B1, s1); \
        const bool actT = (t < NT) && !(t == NT - 1 && wid < 2); \
        if (actT) { \
            if (t >= NT - 2) { const int kbase = t * 64 + 4 * hi; \
                _Pragma("unroll") for (int r = 0; r < 16; ++r) { const int kv = kbase + (r & 3) + 8 * (r >> 2); if (kv > qrow) A0[r] = -INFINITY; if (kv + 32 > qrow) A1[r] = -INFINITY; } } \
            float ra_ = MX3_(A0[0], A0[1], A1[0]), rb_ = MX3_(A0[2], A0[3], A1[1]); ra_ = MX3_(ra_, A1[2], A1[3]); \
            _Pragma("unroll") for (int r = 4; r < 16; r += 4) { ra_ = MX3_(ra_, A0[r], A0[r + 1]); rb_ = MX3_(rb_, A0[r + 2], A0[r + 3]); ra_ = MX3_(ra_, A1[r], A1[r + 1]); rb_ = MX3_(rb_, A1[r + 2], A1[r + 3]); } \
            float rm = fmaxf(ra_, rb_); rm = fmaxf(rm, __shfl_xor(rm, 32));                    \
            const bool first = (t == 0);                                                       \
            if (first || __any(rm > 8.0f)) { \
                const float dl = first ? rm : fmaxf(rm, 0.f); const float f = __builtin_amdgcn_exp2f(-dl); lsum *= f; \
                if (hi == 0) wsf[r32] = f; \
                asm volatile("s_waitcnt lgkmcnt(0)" ::: "memory"); \
                _Pragma("unroll") for (int g = 0; g < 4; ++g) { const f32x4 fv = *(const f32x4*)(wsf + 8 * g + 4 * hi); \
                    _Pragma("unroll") for (int j = 0; j < 4; ++j) { o0[4 * g + j] *= fv[j]; o1[4 * g + j] *= fv[j]; } } \
                const float nm = negm[0] - dl; \
                _Pragma("unroll") for (int r = 0; r < 16; ++r) { A0[r] -= dl; A1[r] -= dl; negm[r] = nm; } \
                if (actN) { _Pragma("unroll") for (int r = 0; r < 16; ++r) { B0[r] -= dl; B1[r] -= dl; } }     \
            } \
            float ps = 0.f; \
            _Pragma("unroll") for (int r = 0; r < 16; ++r) { A0[r] = __builtin_amdgcn_exp2f(A0[r]); A1[r] = __builtin_amdgcn_exp2f(A1[r]); ps += A0[r] + A1[r]; } \
            lsum += ps; \
            bf16x8 pw[4]; \
            { u32x4 w; \
              w = (u32x4){pk2(A0[0], A0[1]), pk2(A0[2], A0[3]), pk2(A0[4], A0[5]), pk2(A0[6], A0[7])}; pw[0] = __builtin_bit_cast(bf16x8, w); \
              w = (u32x4){pk2(A0[8], A0[9]), pk2(A0[10], A0[11]), pk2(A0[12], A0[13]), pk2(A0[14], A0[15])}; pw[1] = __builtin_bit_cast(bf16x8, w); \
              w = (u32x4){pk2(A1[0], A1[1]), pk2(A1[2], A1[3]), pk2(A1[4], A1[5]), pk2(A1[6], A1[7])}; pw[2] = __builtin_bit_cast(bf16x8, w); \
              w = (u32x4){pk2(A1[8], A1[9]), pk2(A1[10], A1[11]), pk2(A1[12], A1[13]), pk2(A1[14], A1[15])}; pw[3] = __builtin_bit_cast(bf16x8, w); } \
            const char* vp = vrd0 + sc * 8192; \
            _Pragma("unroll") for (int s = 0; s < 4; ++s) { \
                const bf16x8 v0 = cat8(tr_read(vp + s * 1024), tr_read(vp + s * 1024 + 512)); \
                const bf16x8 v1 = cat8(tr_read(vp + 4096 + s * 1024), tr_read(vp + 4096 + s * 1024 + 512)); \
                o0 = MFMA(pw[s], v0, o0); o1 = MFMA(pw[s], v1, o1); } \
        } \
        { const int o_ = sc; sc = s1; s1 = sn; sn = o_; } } while (0)
    f32x16 sa0, sa1, sb0, sb1;
    asm volatile("s_waitcnt vmcnt(0)\n\ts_barrier" ::: "memory");
    ATT_QK(sa0, sa1, 0);
    for (int t2 = 0; t2 < NTC; t2 += 2) {
        ATT_STEP(sa0, sa1, sb0, sb1, t2);
        ATT_STEP(sb0, sb1, sa0, sa1, t2 + 1);
    }
#undef ATT_STEP
#undef ATT_QK
#undef MX3_
#undef ATT_ISSUE
    lsum += __shfl_xor(lsum, 32);
    if (hi == 0) wsf[32 + r32] = lsum;
    asm volatile("s_waitcnt lgkmcnt(0)" ::: "memory");
#pragma unroll
    for (int g = 0; g < 4; ++g) { const f32x4 lv = *(const f32x4*)(wsf + 32 + 8 * g + 4 * hi);
#pragma unroll
        for (int j = 0; j < 4; ++j) { const float inv = 1.0f / lv[j]; const int orow = 8 * g + 4 * hi + j;
            stg[orow * 64 + r32] = (bf16_t)(pk2(o0[4 * g + j] * inv, 0.f) & 0xffffu); stg[orow * 64 + 32 + r32] = (bf16_t)(pk2(o1[4 * g + j] * inv, 0.f) & 0xffffu); } }
    asm volatile("s_waitcnt lgkmcnt(0)" ::: "memory");
    const int b = bh >> 3, h = bh & 7;
    bf16_t* yp = Y + ((size_t)b * SEQ + q0 + wid * 32) * 512 + h * 64;
#pragma unroll
    for (int i = 0; i < 4; ++i) { const int row = i * 8 + (lane >> 3), ch = lane & 7; *(u32x4*)(yp + (size_t)row * 512 + ch * 8) = *(const u32x4*)(stg + row * 64 + ch * 8); }
}

template <int CW, int N8, bool ACT> DI void conv_row(const bf16_t* __restrict__ U, int tok, int tin, int col, const float* __restrict__ cw, const float* __restrict__ cb, int ch, float (&o)[8 * N8]) {
#pragma unroll
    for (int q = 0; q < N8; ++q) {
        float a[8];
        const f32x4 b0 = *(const f32x4*)(cb + ch + 8 * q), b1 = *(const f32x4*)(cb + ch + 8 * q + 4);
#pragma unroll
        for (int j = 0; j < 4; ++j) { a[j] = b0[j]; a[4 + j] = b1[j]; }
#pragma unroll
        for (int k = 0; k < 4; ++k) {
            if (tin - 3 + k >= 0) {
                const u32x4 u = *(const u32x4*)(U + (size_t)(tok - 3 + k) * NIN + col + 8 * q);
                const f32x4 w0 = *(const f32x4*)(cw + (size_t)k * CW + ch + 8 * q), w1 = *(const f32x4*)(cw + (size_t)k * CW + ch + 8 * q + 4);
                a[0] += w0[0] * bflo(u[0]); a[1] += w0[1] * bfhi(u[0]); a[2] += w0[2] * bflo(u[1]); a[3] += w0[3] * bfhi(u[1]);
                a[4] += w1[0] * bflo(u[2]); a[5] += w1[1] * bfhi(u[2]); a[6] += w1[2] * bflo(u[3]); a[7] += w1[3] * bfhi(u[3]);
            }
        }
#pragma unroll
        for (int j = 0; j < 8; ++j) o[8 * q + j] = ACT ? siluf_(a[j]) : a[j];
    }
}
DI void ssd_local_item(const Ctx& P, int l, int item, char* smem) {
    int tid_ = threadIdx.x & 255; asm volatile("" : "+v"(tid_));
    const int tid = tid_, lane = tid & 63, wid = tid >> 6, r32 = lane & 31, hi = lane >> 5;
    const int h = item & 3, c = (item >> 2) & 63, b = item >> 8, g = h >> 1;
    const int tok0 = b * SEQ + c * 128, tin0 = c * 128;
    const bf16_t* U = (const bf16_t*)(P.ws + AR_U);
    const float* cw = P.in[10] + (size_t)l * 4 * 512; const float* cb = P.in[11] + l * 512;
    char* Btr = smem; char* Xtr = smem + 16384; float* acs = (float*)(smem + 32768); float* dts = acs + 128; float* wts = dts + 128; float* tot = wts + 128;
    __syncthreads();
    if (tid < 128) {
        const float dtr = ((const float*)(P.ws + WS_DTRAW))[(size_t)(tok0 + tid) * 4 + h];
        const float dt = softplusf_(dtr + P.in[12][l * 4 + h]);
        float v = -__expf(P.in[13][l * 4 + h]) * dt;
#pragma unroll
        for (int d = 1; d < 64; d <<= 1) { const float u = __shfl_up(v, d); if (lane >= d) v += u; }
        dts[tid] = dt; acs[tid] = v;
        if (tid == 63) tot[0] = v;
    }
    __syncthreads();
    if (tid >= 64 && tid < 128) acs[tid] += tot[0];
    __syncthreads();
    if (tid < 128) {
        const float ac = acs[tid], ae = acs[127];
        wts[tid] = __expf(ae - ac);
        ((float*)(P.ws + WS_ACUM))[(size_t)(tok0 + tid) * 4 + h] = ac;
        if (tid == 127) ((float*)(P.ws + WS_ATOT))[(b * 4 + h) * 64 + c] = ae;
    }
    {
        const int row = tid >> 1, half = tid & 1; float o[32];
        conv_row<512, 4, true>(U, tok0 + row, tin0 + row, UC_BS + g * 64 + half * 32, cw, cb, 256 + g * 64 + half * 32, o);
#pragma unroll
        for (int q = 0; q < 4; ++q) *(u32x4*)(Btr + half * 8192 + row * 64 + q * 16) = (u32x4){pk2(o[8 * q], o[8 * q + 1]), pk2(o[8 * q + 2], o[8 * q + 3]), pk2(o[8 * q + 4], o[8 * q + 5]), pk2(o[8 * q + 6], o[8 * q + 7])};
        conv_row<512, 4, true>(U, tok0 + row, tin0 + row, UC_XS + h * 64 + half * 32, cw, cb, h * 64 + half * 32, o);
        const float dt = dts[row];
#pragma unroll
        for (int q = 0; q < 4; ++q) *(u32x4*)(Xtr + half * 8192 + row * 64 + q * 16) = (u32x4){pk2(o[8 * q] * dt, o[8 * q + 1] * dt), pk2(o[8 * q + 2] * dt, o[8 * q + 3] * dt), pk2(o[8 * q + 4] * dt, o[8 * q + 5] * dt), pk2(o[8 * q + 6] * dt, o[8 * q + 7] * dt)};
    }
    bf16x8 cf[4];
    {
        const int row = wid * 32 + r32;
#pragma unroll
        for (int d0 = 0; d0 < 4; ++d0) { float o[8];
            conv_row<512, 1, true>(U, tok0 + row, tin0 + row, UC_CS + g * 64 + 16 * d0 + 8 * hi, cw, cb, 384 + g * 64 + 16 * d0 + 8 * hi, o);
            const u32x4 w = (u32x4){pk2(o[0], o[1]), pk2(o[2], o[3]), pk2(o[4], o[5]), pk2(o[6], o[7])};
            cf[d0] = __builtin_bit_cast(bf16x8, w);
            if ((h & 1) == 0) *(u32x4*)((bf16_t*)(P.ws + AR_CC) + (size_t)(tok0 + row) * 128 + g * 64 + 16 * d0 + 8 * hi) = w; }
    }
    __syncthreads();
    f32x16 y0, y1;
#pragma unroll
    for (int r = 0; r < 16; ++r) { y0[r] = 0.f; y1[r] = 0.f; }
    const int lrow = wid * 32 + r32; const float acl = acs[lrow];
    const char* xrd = Xtr + ((lane >> 4) & 1) * 32 + (lane & 3) * 8 + (4 * hi + ((lane & 15) >> 2)) * 64;
    for (int sb = 0; sb <= wid; ++sb) {
        f32x16 gt;
#pragma unroll
        for (int r = 0; r < 16; ++r) gt[r] = 0.f;
#pragma unroll
        for (int d0 = 0; d0 < 4; ++d0) { const bf16x8 bfg = *(const bf16x8*)(Btr + (d0 >> 1) * 8192 + (sb * 32 + r32) * 64 + (d0 & 1) * 32 + hi * 16); gt = MFMA(bfg, cf[d0], gt); }
#pragma unroll
        for (int q = 0; q < 4; ++q) { const f32x4 av = *(const f32x4*)(acs + sb * 32 + 8 * q + 4 * hi);
#pragma unroll
            for (int j = 0; j < 4; ++j) { const int s = sb * 32 + 8 * q + 4 * hi + j; gt[4 * q + j] = (s <= lrow) ? gt[4 * q + j] * __expf(acl - av[j]) : 0.f; } }
        u32x4 w0 = (u32x4){pk2(gt[0], gt[1]), pk2(gt[2], gt[3]), pk2(gt[4], gt[5]), pk2(gt[6], gt[7])};
        u32x4 w1 = (u32x4){pk2(gt[8], gt[9]), pk2(gt[10], gt[11]), pk2(gt[12], gt[13]), pk2(gt[14], gt[15])};
        const bf16x8 p0 = __builtin_bit_cast(bf16x8, w0), p1 = __builtin_bit_cast(bf16x8, w1);
        const char* xp = xrd + sb * 2048;
        { const bf16x8 xa = cat8(tr_read(xp), tr_read(xp + 512)); y0 = MFMA(xa, p0, y0); }
        { const bf16x8 xa = cat8(tr_read(xp + 1024), tr_read(xp + 1024 + 512)); y0 = MFMA(xa, p1, y0); }
        { const bf16x8 xa = cat8(tr_read(xp + 8192), tr_read(xp + 8192 + 512)); y1 = MFMA(xa, p0, y1); }
        { const bf16x8 xa = cat8(tr_read(xp + 8192 + 1024), tr_read(xp + 8192 + 1024 + 512)); y1 = MFMA(xa, p1, y1); }
    }
    {
        const float dsk = P.in[14][l * 4 + h], idt = 1.0f / dts[lrow];
        bf16_t* yl = (bf16_t*)(P.ws + AR_YLOC) + (size_t)(tok0 + lrow) * 256 + h * 64;
#pragma unroll
        for (int pb = 0; pb < 2; ++pb)
#pragma unroll
            for (int q = 0; q < 4; ++q) { const u32x2 xv = *(const u32x2*)(Xtr + pb * 8192 + lrow * 64 + (8 * q + 4 * hi) * 2);
                const float f = dsk * idt; const f32x16& yy = pb ? y1 : y0;
                const float v0 = yy[4 * q] + f * bflo(xv[0]), v1 = yy[4 * q + 1] + f * bfhi(xv[0]), v2 = yy[4 * q + 2] + f * bflo(xv[1]), v3 = yy[4 * q + 3] + f * bfhi(xv[1]);
                *(u32x2*)(yl + pb * 32 + 8 * q + 4 * hi) = (u32x2){pk2(v0, v1), pk2(v2, v3)}; }
    }
    {
        const int pbk = wid >> 1, nbk = wid & 1;
        f32x16 st;
#pragma unroll
        for (int r = 0; r < 16; ++r) st[r] = 0.f;
        const int trow = 4 * hi + ((lane & 15) >> 2), tcol = ((lane >> 4) & 1) * 32 + (lane & 3) * 8;
#pragma unroll
        for (int ks = 0; ks < 8; ++ks) {
            const s16x4 xl = tr_read(Xtr + pbk * 8192 + (16 * ks + trow) * 64 + tcol), xh = tr_read(Xtr + pbk * 8192 + (16 * ks + 8 + trow) * 64 + tcol);
            const s16x4 bl = tr_read(Btr + nbk * 8192 + (16 * ks + trow) * 64 + tcol), bh2 = tr_read(Btr + nbk * 8192 + (16 * ks + 8 + trow) * 64 + tcol);
            const f32x4 wl = *(const f32x4*)(wts + 16 * ks + 4 * hi), wh = *(const f32x4*)(wts + 16 * ks + 8 + 4 * hi);
            float xf[8];
#pragma unroll
            for (int j = 0; j < 4; ++j) { xf[j] = __uint_as_float(((unsigned)(unsigned short)xl[j]) << 16) * wl[j]; xf[4 + j] = __uint_as_float(((unsigned)(unsigned short)xh[j]) << 16) * wh[j]; }
            const u32x4 xw = (u32x4){pk2(xf[0], xf[1]), pk2(xf[2], xf[3]), pk2(xf[4], xf[5]), pk2(xf[6], xf[7])};
            st = MFMA(__builtin_bit_cast(bf16x8, xw), cat8(bl, bh2), st);
        }
        float* sp = (float*)(P.ws + AR_STATES) + ((size_t)((b * 64 + c) * 4 + h) * 64 + pbk * 32) * 64 + nbk * 32 + r32;
#pragma unroll
        for (int r = 0; r < 16; ++r) sp[(size_t)crow(r, hi) * 64] = st[r];
    }
}

DI void lru_local_item(const Ctx& P, int l, int item, char* smem) {
    int tid_ = threadIdx.x & 255; asm volatile("" : "+v"(tid_));
    const int tid = tid_, lane = tid & 63, wid = tid >> 6, r32 = lane & 31, hi = lane >> 5;
    const int nb = item & 3, c = (item >> 2) & 63, b = item >> 8;
    const int tok0 = b * SEQ + c * 128, tin0 = c * 128;
    const bf16_t* U = (const bf16_t*)(P.ws + AR_U);
    const bf16_t* W = (const bf16_t*)(P.ws + ((l & 1) ? WS_WB1 : WS_WB0));
    float* xc = (float*)smem;
    float* totA = (float*)(smem + 34816); float* totH = totA + 256;
    __syncthreads();
    {
        const int row = tid >> 1, half = tid & 1; float o[32];
        conv_row<256, 4, false>(U, tok0 + row, tin0 + row, UC_XR + nb * 64 + half * 32, P.in[16] + (size_t)l * 4 * 256, P.in[17] + l * 256, nb * 64 + half * 32, o);
#pragma unroll
        for (int q = 0; q < 8; ++q) *(f32x4*)(xc + row * 68 + half * 32 + 4 * q) = (f32x4){o[4 * q], o[4 * q + 1], o[4 * q + 2], o[4 * q + 3]};
    }
    __syncthreads();
    const int row = wid * 32 + r32;
    bf16x8 xf[4];
#pragma unroll
    for (int d0 = 0; d0 < 4; ++d0) {
        const f32x4 a = *(const f32x4*)(xc + row * 68 + 16 * d0 + 8 * hi), bq = *(const f32x4*)(xc + row * 68 + 16 * d0 + 8 * hi + 4);
        const u32x4 xw = (u32x4){pk2(a[0], a[1]), pk2(a[2], a[3]), pk2(bq[0], bq[1]), pk2(bq[2], bq[3])};
        xf[d0] = __builtin_bit_cast(bf16x8, xw);
    }
    float Av[32], Hv[32];
    const float* ba = P.in[19] + l * 256 + nb * 64; const float* bi = P.in[21] + l * 256 + nb * 64; const float* lam = P.in[22] + l * 256 + nb * 64;
#pragma unroll
    for (int e = 0; e < 2; ++e) {
        f32x16 ar, ai;
#pragma unroll
        for (int r = 0; r < 16; ++r) { ar[r] = 0.f; ai[r] = 0.f; }
#pragma unroll
        for (int d0 = 0; d0 < 4; ++d0) {
            const bf16x8 wa = *(const bf16x8*)(W + WO_A + nb * 4096 + (e * 32 + r32) * 64 + 16 * d0 + 8 * hi);
            const bf16x8 wi = *(const bf16x8*)(W + WO_I + nb * 4096 + (e * 32 + r32) * 64 + 16 * d0 + 8 * hi);
            ar = MFMA(wa, xf[d0], ar); ai = MFMA(wi, xf[d0], ai);
        }
#pragma unroll
        for (int q = 0; q < 4; ++q) { const int ch = e * 32 + 8 * q + 4 * hi;
            const f32x4 bav = *(const f32x4*)(ba + ch), biv = *(const f32x4*)(bi + ch), lv = *(const f32x4*)(lam + ch), xv = *(const f32x4*)(xc + row * 68 + ch);
#pragma unroll
            for (int j = 0; j < 4; ++j) {
                const float rg = sigmoidf_(ar[4 * q + j] + bav[j]), ig = sigmoidf_(ai[4 * q + j] + biv[j]);
                const float la = -8.0f * rg * softplus_fast(-lv[j]);
                Av[e * 16 + 4 * q + j] = __expf(la);
                Hv[e * 16 + 4 * q + j] = __builtin_amdgcn_sqrtf(neg_expm1_fast(2.0f * la)) * (ig * xv[j]);
            } }
        asm volatile("" ::: "memory");
    }
#pragma unroll
    for (int d = 1; d < 32; d <<= 1) {
#pragma unroll
        for (int i = 0; i < 32; ++i) { const float ap = __shfl_up(Av[i], d, 32), hp = __shfl_up(Hv[i], d, 32); if (r32 >= d) { Hv[i] = Av[i] * hp + Hv[i]; Av[i] = Av[i] * ap; }
            if ((i & 7) == 7) __builtin_amdgcn_sched_barrier(0); }
    }
    if (r32 == 31) {
#pragma unroll
        for (int e = 0; e < 2; ++e)
#pragma unroll
            for (int q = 0; q < 4; ++q)
#pragma unroll
                for (int j = 0; j < 4; ++j) { const int ch = e * 32 + 8 * q + 4 * hi + j; totA[wid * 64 + ch] = Av[e * 16 + 4 * q + j]; totH[wid * 64 + ch] = Hv[e * 16 + 4 * q + j]; }
    }
    __syncthreads();
    float* carA = totH + 256 + wid * 64; float* carH = carA + 256;
    { float Ac = 1.f, Hc = 0.f;
      for (int w = 0; w < wid; ++w) { const float a2 = totA[w * 64 + lane], h2 = totH[w * 64 + lane]; Hc = a2 * Hc + h2; Ac = Ac * a2; }
      carA[lane] = Ac; carH[lane] = Hc; }
    asm volatile("s_waitcnt lgkmcnt(0)" ::: "memory");
    {
        bf16_t* hl = (bf16_t*)(P.ws + AR_HLOC) + (size_t)(tok0 + row) * 256 + nb * 64; bf16_t* ac = (bf16_t*)(P.ws + AR_ACP) + (size_t)(tok0 + row) * 256 + nb * 64;
#pragma unroll
        for (int e = 0; e < 2; ++e)
#pragma unroll
            for (int q = 0; q < 4; ++q) { const int ch = e * 32 + 8 * q + 4 * hi; float av[4], hv[4];
                const f32x4 ca = *(const f32x4*)(carA + ch), chv = *(const f32x4*)(carH + ch);
#pragma unroll
                for (int j = 0; j < 4; ++j) { const int i = e * 16 + 4 * q + j; hv[j] = Av[i] * chv[j] + Hv[i]; av[j] = Av[i] * ca[j]; }
                *(u32x2*)(hl + ch) = (u32x2){pk2(hv[0], hv[1]), pk2(hv[2], hv[3])};
                *(u32x2*)(ac + ch) = (u32x2){pk2(av[0], av[1]), pk2(av[2], av[3])};
                if (wid == 3 && r32 == 31) { float* he = (float*)(P.ws + WS_HEND) + (size_t)(b * 64 + c) * 256 + nb * 64 + ch; float* ae = (float*)(P.ws + WS_AEND) + (size_t)(b * 64 + c) * 256 + nb * 64 + ch;
                    *(f32x4*)he = (f32x4){hv[0], hv[1], hv[2], hv[3]}; *(f32x4*)ae = (f32x4){av[0], av[1], av[2], av[3]}; } }
    }
}

DI void carries(const Ctx& P, int bid) {
    int tid_ = threadIdx.x & 255; asm volatile("" : "+v"(tid_));
    const int tid = tid_;
    if (bid < 128) {
        const int idx = bid * 256 + tid;
        const int b = idx >> 14, h = (idx >> 12) & 3, e = idx & 4095;
        const float* st = (const float*)(P.ws + AR_STATES) + ((size_t)(b * 64) * 4 + h) * 4096 + e;
        bf16_t* so = (bf16_t*)(P.ws + AR_SIN) + ((size_t)(b * 64) * 4 + h) * 4096 + e;
        const float* at = (const float*)(P.ws + WS_ATOT) + (b * 4 + h) * 64;
        float S = 0.f;
        for (int c0 = 0; c0 < 64; c0 += 8) {
            float v[8], a[8];
#pragma unroll
            for (int j = 0; j < 8; ++j) { v[j] = st[(size_t)(c0 + j) * 16384]; a[j] = __expf(at[c0 + j]); }
#pragma unroll
            for (int j = 0; j < 8; ++j) { so[(size_t)(c0 + j) * 16384] = (bf16_t)(pk2(S, 0.f) & 0xffffu); S = a[j] * S + v[j]; }
        }
    } else if (bid < 130) {
        const int idx = (bid - 128) * 256 + tid;
        const int b = idx >> 8, ch = idx & 255;
        const float* he = (const float*)(P.ws + WS_HEND) + (size_t)b * 64 * 256 + ch; const float* ae = (const float*)(P.ws + WS_AEND) + (size_t)b * 64 * 256 + ch;
        float* hin = (float*)(P.ws + WS_HIN) + (size_t)b * 64 * 256 + ch;
        float Hc = 0.f;
        for (int c = 0; c < 64; ++c) { hin[c * 256] = Hc; Hc = ae[c * 256] * Hc + he[c * 256]; }
    }
}

DI void ssd_z_item(const Ctx& P, int item) {
    int tid_ = threadIdx.x & 255; asm volatile("" : "+v"(tid_));
    const int tid = tid_, lane = tid & 63, wid = tid >> 6, r32 = lane & 31, hi = lane >> 5;
    const int g = item & 1, c = (item >> 1) & 63, b = item >> 7;
    const int tok = b * SEQ + c * 128 + wid * 32 + r32;
    const bf16_t* Cc = (const bf16_t*)(P.ws + AR_CC) + (size_t)tok * 128 + g * 64 + 8 * hi;
    bf16x8 cf[4];
#pragma unroll
    for (int d0 = 0; d0 < 4; ++d0) cf[d0] = *(const bf16x8*)(Cc + 16 * d0);
    f32x16 acc[2][2];
#pragma unroll
    for (int hh = 0; hh < 2; ++hh)
#pragma unroll
        for (int pb = 0; pb < 2; ++pb) {
#pragma unroll
            for (int r = 0; r < 16; ++r) acc[hh][pb][r] = 0.f;
            const bf16_t* sp = (const bf16_t*)(P.ws + AR_SIN) + ((size_t)((b * 64 + c) * 4 + 2 * g + hh) * 64 + pb * 32 + r32) * 64 + 8 * hi;
#pragma unroll
            for (int d0 = 0; d0 < 4; ++d0) { const bf16x8 sf = *(const bf16x8*)(sp + 16 * d0); acc[hh][pb] = MFMA(sf, cf[d0], acc[hh][pb]); }
        }
    const f32x4 acv = *(const f32x4*)((const float*)(P.ws + WS_ACUM) + (size_t)tok * 4);
    const bf16_t* yl = (const bf16_t*)(P.ws + AR_YLOC) + (size_t)tok * 256 + g * 128;
    const bf16_t* zp = (const bf16_t*)(P.ws + AR_U) + (size_t)tok * NIN + UC_Z + g * 128;
    float ss = 0.f;
#pragma unroll
    for (int hh = 0; hh < 2; ++hh) { const float ea = __expf(acv[2 * g + hh]);
#pragma unroll
        for (int pb = 0; pb < 2; ++pb)
#pragma unroll
            for (int q = 0; q < 4; ++q) { const int col = hh * 64 + pb * 32 + 8 * q + 4 * hi;
                const u32x2 yv = *(const u32x2*)(yl + col), zv = *(const u32x2*)(zp + col);
                const float yy[4] = {bflo(yv[0]), bfhi(yv[0]), bflo(yv[1]), bfhi(yv[1])}, zz[4] = {bflo(zv[0]), bfhi(zv[0]), bflo(zv[1]), bfhi(zv[1])};
#pragma unroll
                for (int j = 0; j < 4; ++j) { const float v = (acc[hh][pb][4 * q + j] * ea + yy[j]) * siluf_(zz[j]); acc[hh][pb][4 * q + j] = v; ss += v * v; } } }
    ss += __shfl_xor(ss, 32);
    const float rs = rsqrtf(ss * (1.0f / 128.0f) + EPS);
    bf16_t* ym = (bf16_t*)(P.ws + AR_YMIX) + (size_t)tok * 1024 + 512 + g * 128;
#pragma unroll
    for (int hh = 0; hh < 2; ++hh)
#pragma unroll
        for (int pb = 0; pb < 2; ++pb)
#pragma unroll
            for (int q = 0; q < 4; ++q) { const int col = hh * 64 + pb * 32 + 8 * q + 4 * hi;
                *(u32x2*)(ym + col) = (u32x2){pk2(acc[hh][pb][4 * q] * rs, acc[hh][pb][4 * q + 1] * rs), pk2(acc[hh][pb][4 * q + 2] * rs, acc[hh][pb][4 * q + 3] * rs)}; }
}
DI void rowfin_item(const Ctx& P, int item) {
    int tid_ = threadIdx.x & 255; asm volatile("" : "+v"(tid_));
    const int lane = tid_ & 63, wid = tid_ >> 6;
#pragma unroll
    for (int u = 0; u < 4; ++u) {
    const int tok = item * 16 + wid * 4 + u;
    bf16_t* ym = (bf16_t*)(P.ws + AR_YMIX) + (size_t)tok * 1024;
    {
        const u32x4 v = *(const u32x4*)((const bf16_t*)(P.ws + AR_YMLA) + (size_t)tok * 512 + lane * 8);
        float f[8] = {bflo(v[0]), bfhi(v[0]), bflo(v[1]), bfhi(v[1]), bflo(v[2]), bfhi(v[2]), bflo(v[3]), bfhi(v[3])};
        float ss = 0.f;
#pragma unroll
        for (int j = 0; j < 8; ++j) ss += f[j] * f[j];
#pragma unroll
        for (int d = 1; d < 64; d <<= 1) ss += __shfl_xor(ss, d);
        const float rs = rsqrtf(ss * (1.0f / 512.0f) + EPS);
        *(u32x4*)(ym + lane * 8) = (u32x4){pk2(f[0] * rs, f[1] * rs), pk2(f[2] * rs, f[3] * rs), pk2(f[4] * rs, f[5] * rs), pk2(f[6] * rs, f[7] * rs)};
    }
    {
        const int b = tok >> 13, c = (tok & 8191) >> 7, ch = lane * 4;
        const u32x2 hv = *(const u32x2*)((const bf16_t*)(P.ws + AR_HLOC) + (size_t)tok * 256 + ch), av = *(const u32x2*)((const bf16_t*)(P.ws + AR_ACP) + (size_t)tok * 256 + ch);
        const u32x2 gv = *(const u32x2*)((const bf16_t*)(P.ws + AR_U) + (size_t)tok * NIN + UC_GATE + ch);
        const f32x4 hin = *(const f32x4*)((const float*)(P.ws + WS_HIN) + (size_t)(b * 64 + c) * 256 + ch);
        const float hl[4] = {bflo(hv[0]), bfhi(hv[0]), bflo(hv[1]), bfhi(hv[1])}, aa[4] = {bflo(av[0]), bfhi(av[0]), bflo(av[1]), bfhi(av[1])}, gg[4] = {bflo(gv[0]), bfhi(gv[0]), bflo(gv[1]), bfhi(gv[1])};
        float y[4], ss = 0.f;
#pragma unroll
        for (int j = 0; j < 4; ++j) { y[j] = (hl[j] + aa[j] * hin[j]) * gelu_tanh_(gg[j]); ss += y[j] * y[j]; }
#pragma unroll
        for (int d = 1; d < 64; d <<= 1) ss += __shfl_xor(ss, d);
        const float rs = rsqrtf(ss * (1.0f / 256.0f) + EPS);
        *(u32x2*)(ym + 768 + ch) = (u32x2){pk2(y[0] * rs, y[1] * rs), pk2(y[2] * rs, y[3] * rs)};
    }
    }
}

DI void run_phase(const Params& PP, int ph, char* smem, unsigned* sh_item, int rep = 0) {
    int z_; asm volatile("s_mov_b32 %0, 0" : "=s"(z_));
    Ctx P; P.in = PP.in + z_; P.out = PP.out + z_; P.ws = PP.ws + z_;
    const int vb = __builtin_amdgcn_readfirstlane((int)(threadIdx.x >> 8));
    const int bid = (int)blockIdx.x * 2 + vb + z_;
    const int G = (int)gridDim.x * 2;
    const int pb = (int)blockIdx.x + z_, PG = (int)gridDim.x;
    char* const smem_full = smem; smem = smem + vb * VB_LDS;
    unsigned char* ws = P.ws;
    bf16_t* XB = (bf16_t*)(ws + WS_XB);
#if !defined(ONLY) || ONLY == 9
    if (ph == 0) { phase_prologue(P, smem); return; }
#endif
    if (ph == NPHASE - 1) {
        int t_ = threadIdx.x & 255; asm volatile("" : "+v"(t_));
        const int lane = t_ & 63, wid = t_ >> 6; const float* g = P.in[34];
        for (int row = bid * 4 + wid; row < T; row += G * 4) {
            float* xr = P.out + (size_t)row * DM; f32x4 v[4]; float ss = 0.f;
#pragma unroll
            for (int i = 0; i < 4; ++i) { v[i] = *(const f32x4*)(xr + i * 256 + lane * 4); ss += v[i][0] * v[i][0] + v[i][1] * v[i][1] + v[i][2] * v[i][2] + v[i][3] * v[i][3]; }
#pragma unroll
            for (int d = 1; d < 64; d <<= 1) ss += __shfl_xor(ss, d);
            const float rs = rsqrtf(ss * (1.0f / 1024.0f) + EPS);
#pragma unroll
            for (int i = 0; i < 4; ++i) { const f32x4 gv = *(const f32x4*)(g + i * 256 + lane * 4); *(f32x4*)(xr + i * 256 + lane * 4) = (f32x4){v[i][0] * rs * gv[0], v[i][1] * rs * gv[1], v[i][2] * rs * gv[2], v[i][3] * rs * gv[3]}; }
        }
        return;
    }
    const int l = (ph - 1) / 9, st = (ph - 1) % 9;
    const bf16_t* W = (const bf16_t*)(ws + ((l & 1) ? WS_WB1 : WS_WB0));
    switch (st) {
#if !defined(ONLY) || ONLY == 0
    case 0: {
        { EpiP1KV e{EpiP1{(bf16_t*)(ws + AR_U), (float*)(ws + WS_DTRAW), (float*)(ws + WS_PQ), (float*)(ws + WS_PKV)}, (bf16_t*)(ws + WS_KMEM), (bf16_t*)(ws + WS_VMEM)};
          const bf16_t* Wi = W + WO_IN; const bf16_t* Wk = W + WO_MK; const bf16_t* Am = (const bf16_t*)(ws + WS_MEMB) - (size_t)T * 1024; const float* part = (const float*)(ws + WS_PART);
          auto tf = [=](int it) { const int xcd = it & 7, idx = it >> 3;
                                  if (idx < 56) return Tile256{XB, Wi, part, 1024, 1024, 1024, (xcd * 8 + idx / 7) * 256, (idx % 7) * 256, 16, 0, 1.0f / 1024.0f};
                                  const int j = xcd * 2 + (idx - 56); return Tile256{Am, Wk, part, 1024, 1024, 1024, T + ((j >> 2) & 1) * 256, (j >> 3) * 1024 + (j & 3) * 256, 16, 0, 1.0f / 1024.0f}; };
          gemm256_stream(tf, pb, PG, 464, smem_full, e); }
    } break;
#endif
#if !defined(ONLY) || ONLY == 1
    case 1: {
        {
            const int tv = (pb >> 1) * 2 + vb, tvn = (PG >> 1) * 2;
            for (int k = tv; k < 512; k += tvn) { if (pb & 1) lru_local_item(P, l, k, smem); else ssd_local_item(P, l, k, smem); }
        }
        __syncthreads();
        { EpiStage1 e{EpiKV{(bf16_t*)(ws + AR_K), (bf16_t*)(ws + AR_V), (const bf16_t*)(ws + AR_U), (const float*)(ws + WS_COS), (const float*)(ws + WS_SIN)},
                      EpiQ{(bf16_t*)(ws + AR_Q), (const float*)(ws + WS_COS), (const float*)(ws + WS_SIN)}, (bf16_t*)(ws + WS_WQKT), (bf16_t*)(ws + WS_VWOT)};
          const bf16_t* Uq = (const bf16_t*)(ws + AR_U) + UC_CQ; const bf16_t* Ukv = (const bf16_t*)(ws + AR_U) + UC_CKV; const bf16_t* Wq = W + WO_UQ; const bf16_t* Wkv = W + WO_UKV;
          const bf16_t* Km = (const bf16_t*)(ws + WS_KMEM); const bf16_t* Vm = (const bf16_t*)(ws + WS_VMEM); const bf16_t* Wmq = W + WO_MQ; const bf16_t* Wmo = W + WO_MO;
          const float* pq = (const float*)(ws + WS_PQ); const float* pkv = (const float*)(ws + WS_PKV);
          auto tf = [=](int it) {
              if (it < 256) return Tile256{Ukv, Wkv, pkv, NIN, 128, 128, (it >> 2) * 256, (it & 3) * 256, 2, 0, 1.0f / 128.0f};
              if (it < 448) { const int j = it - 256; return Tile256{Uq, Wq, pq, NIN, 256, 256, (j / 3) * 256, (j % 3) * 256, 4, 1, 1.0f / 256.0f}; }
              if (it < 480) { const int j = it - 448, b = j >> 4, h = (j >> 2) & 3, nt = j & 3; return Tile256{Km + h * 256, Wmq + h * 256, nullptr, 1024, 1024, 256, b * 256, nt * 256, 0, 2 | (b << 2) | (h << 3), 0.f}; }
              const int j = it - 480, b = j >> 4, h = (j >> 2) & 3, mt = j & 3; return Tile256{Wmo + h * 256, Vm + (size_t)b * 256 * 1024 + h * 256, nullptr, 1024, 1024, 256, mt * 256, 0, 0, 3 | (b << 2) | (h << 3), 0.f}; };
          gemm256_stream(tf, pb, PG, 512, smem_full, e); }
    } break;
#endif
#if !defined(ONLY) || ONLY == 2
    case 2: {
        carries(P, bid);
        unsigned* ctr = (unsigned*)ws + CW_QUEUE + (l * 8 + (pb & 7)) * 64 + rep * 16;
        for (;;) {
            __syncthreads();
            if (threadIdx.x == 0) *sh_item = atomicAdd(ctr, 1u);
            __syncthreads();
            const unsigned j2 = *sh_item;
            if (j2 >= 64u) break;
            const int pi = 31 - (int)(j2 & 31u), qb = 2 * pi + 1 - vb;
            attn_item((const bf16_t*)(ws + AR_Q), (const bf16_t*)(ws + AR_K), (const bf16_t*)(ws + AR_V), (bf16_t*)(ws + AR_YMLA), (pb & 7) * 2 + (int)(j2 >> 5), qb, 2 * (2 * pi + 2), smem_full, vb);
        }
    } break;
#endif
#if !defined(ONLY) || ONLY == 3
    case 3: {
        for (int it = bid; it < 256 + 1024; it += G) { if (it < 256) ssd_z_item(P, it); else rowfin_item(P, it - 256); }
    } break;
#endif
#if !defined(ONLY) || ONLY == 4
    case 4: {
        EpiResid e{l == 0 ? P.in[0] : P.out, P.out, XB, (float*)(ws + WS_PART)};
        { const bf16_t* Ay = (const bf16_t*)(ws + AR_YMIX); const bf16_t* Wo = W + WO_OUT;
          auto tf = [=](int it) { const int xcd = it & 7, idx = it >> 3, mt = xcd * 8 + (idx >> 2), nt = idx & 3; return Tile256{Ay, Wo, nullptr, 1024, 1024, 1024, mt * 256, nt * 256, 0, 0, 0.f}; };
          gemm256_stream(tf, pb, PG, 256, smem_full, e); }
    } break;
#endif
#if !defined(ONLY) || ONLY == 5
    case 5: {
        { EpiSoftmax256 e{(bf16_t*)(ws + AR_P), (float*)(smem_full + 2 * 65536 + 1024)}; const bf16_t* Wq = (const bf16_t*)(ws + WS_WQKT); const float* part = (const float*)(ws + WS_PART);
          auto tf = [=](int it) { const int xcd = it & 7, idx = it >> 3, mt = xcd * 8 + (idx >> 2), hh = idx & 3; return Tile256{XB, Wq + (size_t)(mt >> 5) * 1048576, part, 1024, 1024, 1024, mt * 256, hh * 256, 16, 0, 1.0f / 1024.0f}; };
          gemm256_stream(tf, pb, PG, 256, smem_full, e); }
    } break;
#endif
#if !defined(ONLY) || ONLY == 6
    case 6: {
        EpiResid e{P.out, P.out, XB, (float*)(ws + WS_PART)};
        { const bf16_t* Ap = (const bf16_t*)(ws + AR_P); const bf16_t* Vw = (const bf16_t*)(ws + WS_VWOT);
          auto tf = [=](int it) { const int xcd = it & 7, idx = it >> 3, mt = xcd * 8 + (idx >> 2), nt = idx & 3; return Tile256{Ap, Vw + (size_t)(mt >> 5) * 1048576, nullptr, 1024, 1024, 1024, mt * 256, nt * 256, 0, 0, 0.f}; };
          gemm256_stream(tf, pb, PG, 256, smem_full, e); }
    } break;
#endif
#if !defined(ONLY) || ONLY == 7
    case 7: {
        EpiRelu2 e{(bf16_t*)(ws + AR_H)};
        { const bf16_t* W1 = W + WO_1; const float* part = (const float*)(ws + WS_PART);
          auto tf = [=](int it) { const int rnd = it >> 8, w = it & 255, xcd = w & 7, idx = w >> 3, mt = rnd * 16 + (xcd >> 1) * 4 + (idx >> 3), nt = (xcd & 1) * 8 + (idx & 7); return Tile256{XB, W1, part, 1024, 1024, 1024, mt * 256, nt * 256, 16, 0, 1.0f / 1024.0f}; };
          gemm256_stream(tf, pb, PG, 1024, smem_full, e); }
    } break;
#endif
#if !defined(ONLY) || ONLY == 8
    case 8: {
        EpiResid e{P.out, P.out, XB, (float*)(ws + WS_PART)};
        { const bf16_t* Ah = (const bf16_t*)(ws + AR_H); const bf16_t* W2 = W + WO_2;
          auto tf = [=](int it) { const int xcd = it & 7, idx = it >> 3, mt = xcd * 8 + (idx >> 2), nt = idx & 3; return Tile256{Ah, W2, nullptr, 4096, 4096, 4096, mt * 256, nt * 256, 0, 0, 0.f}; };
          gemm256_stream(tf, pb, PG, 256, smem_full, e); }
        if (l + 1 < NL) { __syncthreads(); convert_layer_weights(P, l + 1, (float*)smem); }
    } break;
#endif
    }
}

__global__ void __launch_bounds__(512, 2) hymba_mega(Params P, int ph_lo, int ph_hi, int coop) {
    extern __shared__ __attribute__((aligned(16))) char smem[];
    __shared__ unsigned sh_item;
    if (coop) {
        if (threadIdx.x == 0) *(uint4*)(smem + XB_LDS_OFF) = make_uint4(0u, 0u, 0u, 0u);
        __syncthreads();
        (void)xcd_barrier_post((unsigned*)P.ws, (volatile unsigned*)(smem + XB_LDS_OFF));
    }
    for (int ph = ph_lo; ph < ph_hi; ++ph) {
        run_phase(P, ph, smem, &sh_item);
#ifdef REP_ST
        if (ph >= 1 && ph < NPHASE - 1 && (ph - 1) % 9 == REP_ST) { xcd_barrier((unsigned*)P.ws); run_phase(P, ph, smem, &sh_item, 1); }
#endif
        if (coop && ph + 1 < ph_hi) {
            if (ph == ph_lo) cg::this_grid().sync();
            else { xcd_barrier((unsigned*)P.ws);
#ifdef DBL_BAR
                xcd_barrier((unsigned*)P.ws); xcd_barrier((unsigned*)P.ws);
#endif
            }
        }
    }
}

extern "C" void kernel_launch(void* const* d_in, const int* in_sizes, int n_in, void* d_out, int out_size, void* d_ws, size_t ws_size, hipStream_t stream) {
    static int grid = 0;
    if (grid == 0) {
        if (n_in != 35 || out_size != T * DM || ws_size < WS_END) { fprintf(stderr, "kernel_launch: unexpected shapes (n_in %d out %d ws %zu need %zu)\n", n_in, out_size, ws_size, (size_t)WS_END); grid = -1; return; }
        int dev = 0, cus = 0, per_cu = 0;
        hipGetDevice(&dev); hipDeviceGetAttribute(&cus, hipDeviceAttributeMultiprocessorCount, dev);
        if (hipFuncSetAttribute((const void*)hymba_mega, hipFuncAttributeMaxDynamicSharedMemorySize, LDS_BYTES) != hipSuccess) { fprintf(stderr, "kernel_launch: hipFuncSetAttribute failed\n"); grid = -1; return; }
        (void)hipOccupancyMaxActiveBlocksPerMultiprocessor(&per_cu, (const void*)hymba_mega, 512, LDS_BYTES);
        if (per_cu < 1) { fprintf(stderr, "kernel_launch: occupancy query failed\n"); grid = -1; return; }
        if (per_cu > 1) per_cu = 1;
        grid = cus * per_cu;
    }
    if (grid < 0) return;
    hipMemsetAsync((char*)d_ws + WS_CTL, 0, 65536, stream);
    Params p{};
    for (int i = 0; i < 35; ++i) p.in[i] = (const float*)d_in[i];
    p.out = (float*)d_out; p.ws = (unsigned char*)d_ws;
#if MK_MULTI
    for (int ph = 0; ph < NPHASE; ++ph) hipLaunchKernelGGL(hymba_mega, dim3(grid), dim3(512), LDS_BYTES, stream, p, ph, ph + 1, 0);
#else
    int lo = 0, hi = NPHASE, coop = 1;
    void* args[] = {&p, &lo, &hi, &coop};
    hipError_t e = hipLaunchCooperativeKernel((const void*)hymba_mega, dim3(grid), dim3(512), args, LDS_BYTES, stream);
    if (e != hipSuccess) fprintf(stderr, "cooperative launch failed: %s (grid %d)\n", hipGetErrorString(e), grid);
#endif
}
```

```cpp
#include <hip/hip_runtime.h>
#include <hip/hip_cooperative_groups.h>
#include <stdint.h>
#include <stdio.h>
namespace cg = cooperative_groups;

#ifndef MK_MULTI
#define MK_MULTI 0
#endif

#define DI __device__ __forceinline__
#define LAS __attribute__((address_space(3)))
typedef unsigned short bf16_t;
typedef short bf16x8 __attribute__((ext_vector_type(8)));
typedef short s16x4 __attribute__((ext_vector_type(4)));
typedef float f32x16 __attribute__((ext_vector_type(16)));
typedef float f32x4 __attribute__((ext_vector_type(4)));
typedef unsigned u32x4 __attribute__((ext_vector_type(4)));
typedef unsigned u32x2 __attribute__((ext_vector_type(2)));
#define MFMA(a, b, c) __builtin_amdgcn_mfma_f32_32x32x16_bf16((a), (b), (c), 0, 0, 0)

constexpr int T = 16384, SEQ = 8192, DM = 1024, NL = 4;
constexpr int NIN = 1792;
constexpr float EPS = 1e-6f;
constexpr float LOG2E = 1.4426950408889634f;
constexpr int VB_LDS = 78848;
constexpr int XB_LDS_OFF = 2 * VB_LDS;
constexpr int LDS_BYTES = XB_LDS_OFF + 16;
constexpr int NPHASE = 2 + 9 * NL;

constexpr int UC_CQ = 0, UC_CKV = 256, UC_KR = 384, UC_DT = 416, UC_Z = 512, UC_XS = 768, UC_BS = 1024, UC_CS = 1152, UC_XR = 1280, UC_GATE = 1536;

constexpr size_t WO_IN = 0;
constexpr size_t WO_UQ = WO_IN + (size_t)NIN * 1024;
constexpr size_t WO_UKV = WO_UQ + 768 * 256;
constexpr size_t WO_OUT = WO_UKV + 1024 * 128;
constexpr size_t WO_MQ = WO_OUT + 1048576;
constexpr size_t WO_MK = WO_MQ + 1048576;
constexpr size_t WO_MV = WO_MK + 1048576;
constexpr size_t WO_MO = WO_MV + 1048576;
constexpr size_t WO_1 = WO_MO + 1048576;
constexpr size_t WO_2 = WO_1 + 4194304;
constexpr size_t WO_A = WO_2 + 4194304;
constexpr size_t WO_I = WO_A + 16384;
constexpr size_t WB_ELEMS = WO_I + 16384;

constexpr size_t al256(size_t x) { return (x + 255) & ~(size_t)255; }
constexpr size_t WS_CTL = 0;
constexpr size_t WS_WB0 = 65536;
constexpr size_t WS_WB1 = WS_WB0 + al256(WB_ELEMS * 2);
constexpr size_t WS_XB = WS_WB1 + al256(WB_ELEMS * 2);
constexpr size_t WS_MEMB = WS_XB + (size_t)T * 1024 * 2;
constexpr size_t WS_COS = WS_MEMB + 512 * 1024 * 2;
constexpr size_t WS_SIN = WS_COS + (size_t)T * 16 * 4;
constexpr size_t WS_KMEM = WS_SIN + (size_t)T * 16 * 4;
constexpr size_t WS_VMEM = WS_KMEM + 512 * 1024 * 2;
constexpr size_t WS_WQKT = WS_VMEM + 512 * 1024 * 2;
constexpr size_t WS_VWOT = WS_WQKT + 2 * 1048576 * 2;
constexpr size_t WS_DTRAW = WS_VWOT + 2 * 1048576 * 2;
constexpr size_t WS_ACUM = WS_DTRAW + (size_t)T * 16;
constexpr size_t WS_ATOT = WS_ACUM + (size_t)T * 16;
constexpr size_t WS_HEND = WS_ATOT + 4096;
constexpr size_t WS_AEND = WS_HEND + 131072;
constexpr size_t WS_HIN = WS_AEND + 131072;
constexpr size_t WS_PART = WS_HIN + 131072;
constexpr size_t WS_PQ = WS_PART + (size_t)(T + 512) * 64;
constexpr size_t WS_PKV = WS_PQ + (size_t)T * 16;
constexpr size_t WS_ARENA = WS_PKV + (size_t)T * 8;
constexpr size_t AR_U = WS_ARENA;
constexpr size_t AR_Q = AR_U + (size_t)T * NIN * 2;
constexpr size_t AR_K = AR_Q + (size_t)16 * 8192 * 96 * 2;
constexpr size_t AR_V = AR_K + (size_t)16 * 8192 * 96 * 2;
constexpr size_t AR_YMLA = AR_V + (size_t)16 * 8192 * 64 * 2;
constexpr size_t AR_YLOC = AR_YMLA + (size_t)T * 512 * 2;
constexpr size_t AR_STATES = AR_YLOC + (size_t)T * 256 * 2;
constexpr size_t AR_SIN = AR_STATES + (size_t)2 * 64 * 4 * 4096 * 4;
constexpr size_t AR_CC = AR_SIN + (size_t)2 * 64 * 4 * 4096 * 2;
constexpr size_t AR_HLOC = AR_CC + (size_t)T * 128 * 2;
constexpr size_t AR_ACP = AR_HLOC + (size_t)T * 256 * 2;
constexpr size_t WS_END = AR_ACP + (size_t)T * 256 * 2;
constexpr size_t AR_YMIX = AR_Q;
constexpr size_t AR_P = AR_U;
constexpr size_t AR_H = WS_ARENA;
static_assert(AR_H + (size_t)T * 4096 * 2 <= WS_END, "H overlay");
static_assert(AR_YMIX + (size_t)T * 1024 * 2 <= AR_V, "ymix overlay");

#define XB_TMO      128
#define XB_XCNT(j)  (256  + 64 * (j))
#define XB_XSUB(j)  (1280 + 64 * (j))
#define XB_XGEN(j)  (2304 + 64 * (j))
#define XB_TOP      3328
#define XB_TOPGEN   3392
#define XCD_BAR_WORDS 3456
#define XB_SPIN_CAP (1u << 20)
constexpr int CW_QUEUE = 4096;

struct Params {
    const float* in[35];
    float* out;
    unsigned char* ws;
};

struct Ctx { const float* const* in; float* out; unsigned char* ws; };
DI int VBID() { int z_; asm volatile("s_mov_b32 %0, 0" : "=s"(z_)); return (int)blockIdx.x * 2 + (int)(threadIdx.x >> 8) + z_; }
DI int VGRID() { return (int)gridDim.x * 2; }

typedef __bf16 bf16x2_t __attribute__((ext_vector_type(2)));
DI unsigned pk2(float lo, float hi) { const bf16x2_t v = {(__bf16)lo, (__bf16)hi}; return __builtin_bit_cast(unsigned, v); }
DI float bflo(unsigned u) { return __uint_as_float(u << 16); }
DI float bfhi(unsigned u) { return __uint_as_float(u & 0xffff0000u); }
DI float sigmoidf_(float x) { return __builtin_amdgcn_rcpf(1.0f + __expf(-x)); }
DI float softplus_fast(float x) { const float y = __expf(x); const float ser = y * (1.0f - y * (0.5f - y * (0.33333334f - 0.25f * y))); const float lg = __logf(1.0f + y); return x > 15.f ? x : (y < 0.03f ? ser : lg); }
DI float neg_expm1_fast(float x) { const float ser = -x * (1.0f + x * (0.5f + x * (0.16666667f + x * (0.041666668f + x * 0.008333334f)))); const float ex = 1.0f - __expf(x); return x > -0.1f ? ser : ex; }
DI float siluf_(float x) { return x * sigmoidf_(x); }
DI float softplusf_(float x) { return x > 20.f ? x : log1pf(__expf(x)); }
DI float gelu_tanh_(float x) { const float y = 0.7978845608028654f * (x + 0.044715f * x * x * x); const float t = 1.0f - 2.0f / (__expf(2.0f * y) + 1.0f); return 0.5f * x * (1.0f + t); }
DI int crow(int r, int hi) { return (r & 3) + 8 * (r >> 2) + 4 * hi; }
typedef short v4i16_t __attribute__((ext_vector_type(4)));
DI s16x4 tr_read(const char* p) { return __builtin_bit_cast(s16x4, __builtin_amdgcn_ds_read_tr16_b64_v4i16((LAS v4i16_t*)(uintptr_t)(unsigned)(uintptr_t)p)); }
DI bf16x8 cat8(s16x4 lo, s16x4 hi) { return (bf16x8){lo[0], lo[1], lo[2], lo[3], hi[0], hi[1], hi[2], hi[3]}; }

DI void store_pair16(bf16_t* blk, int hi, int k, u32x2 a, u32x2 b) {
    const auto r0 = __builtin_amdgcn_permlane32_swap(a[0], b[0], false, false);
    const auto r1 = __builtin_amdgcn_permlane32_swap(a[1], b[1], false, false);
    *(u32x4*)(blk + 8 * k + 8 * hi) = (u32x4){r0[0], r1[0], r0[1], r1[1]};
}

DI unsigned xb_ld(unsigned* p) { return __hip_atomic_load(p, __ATOMIC_RELAXED, __HIP_MEMORY_SCOPE_AGENT); }
DI unsigned xb_add(unsigned* p, unsigned v) { return __hip_atomic_fetch_add(p, v, __ATOMIC_RELAXED, __HIP_MEMORY_SCOPE_AGENT); }
DI unsigned xb_xcc_id() { return (unsigned)__builtin_amdgcn_s_getreg((3 << 11) | 20) & 0xFu; }
#define XB_SPIN(cond, bar) do { unsigned _sp = 0; while (cond) { __builtin_amdgcn_s_sleep(1); \
    if ((++_sp & 255u) == 0u) { if (xb_ld(&(bar)[XB_TMO])) break; if (_sp > XB_SPIN_CAP) { atomicAdd(&(bar)[XB_TMO], 1u); break; } } } } while (0)
struct XcdBarrier { unsigned* bar; unsigned x; volatile unsigned* st; };
DI XcdBarrier xcd_barrier_post(unsigned* bar, volatile unsigned* st) {
    XcdBarrier b; b.bar = bar; b.x = xb_xcc_id(); b.st = st;
    if (threadIdx.x == 0) (void)xb_add(&bar[XB_XCNT(b.x)], 1u);
    return b;
}
DI void xcd_barrier_complete(unsigned* bar, unsigned x, unsigned& nloc, unsigned& nx) {
    const unsigned G = gridDim.x;
    unsigned sum, cnt, mine, sp = 0u;
    for (;;) {
        sum = 0u; cnt = 0u; mine = 0u;
#pragma unroll
        for (unsigned j = 0; j < 16; ++j) { const unsigned c = xb_ld(&bar[XB_XCNT(j)]); sum += c; cnt += (c > 0u) ? 1u : 0u; mine = (j == x) ? c : mine; }
        if (sum == G) break;
        __builtin_amdgcn_s_sleep(1);
        if ((++sp & 255u) == 0u) { if (xb_ld(&bar[XB_TMO])) break; if (sp > XB_SPIN_CAP) { atomicAdd(&bar[XB_TMO], 1u); break; } }
    }
    nloc = mine > 0u ? mine : 1u; nx = cnt > 0u ? cnt : 1u;
}
DI void xcd_barrier(unsigned* bar_in) {
    extern __shared__ __attribute__((aligned(16))) char dyn_lds_[];
    XcdBarrier b; b.bar = bar_in; b.st = (volatile unsigned*)(dyn_lds_ + XB_LDS_OFF); b.x = xb_xcc_id();
    asm volatile("s_waitcnt vmcnt(0)" ::: "memory");
    __syncthreads();
    if (threadIdx.x == 0) {
        int z_; asm volatile("s_mov_b32 %0, 0" : "=s"(z_));
        unsigned* bar = b.bar + z_;
        __builtin_amdgcn_s_waitcnt(0);
        unsigned nloc = b.st[0], nx = b.st[1];
        if (nloc == 0u) { xcd_barrier_complete(bar, b.x, nloc, nx); b.st[0] = nloc; b.st[1] = nx; }
        const unsigned old = xb_add(&bar[XB_XSUB(b.x)], 1u);
        const unsigned gen = old / nloc;
        if (old + 1u == (gen + 1u) * nloc) {
            __builtin_amdgcn_fence(__ATOMIC_RELEASE, "agent");
            asm volatile("s_waitcnt vmcnt(0)" ::: "memory");
            const unsigned og = xb_add(&bar[XB_TOP], 1u);
            const unsigned tg = og / nx;
            if (og + 1u == (tg + 1u) * nx) xb_add(&bar[XB_TOPGEN], 1u);
            else XB_SPIN(xb_ld(&bar[XB_TOPGEN]) == tg, bar);
            __builtin_amdgcn_fence(__ATOMIC_ACQUIRE, "agent");
            xb_add(&bar[XB_XGEN(b.x)], 1u);
            asm volatile("s_waitcnt vmcnt(0)" ::: "memory");
        } else {
            XB_SPIN(xb_ld(&bar[XB_XGEN(b.x)]) == gen, bar);
            __builtin_amdgcn_fence(__ATOMIC_ACQUIRE, "agent");
            asm volatile("s_waitcnt vmcnt(0)" ::: "memory");
        }
    }
    __syncthreads();
}

template <int WAVES_M, int WAVES_N, int MB, int NB, int NORM_A  , class Epi>
DI void gemm_tile(const bf16_t* __restrict__ A, int lda, const bf16_t* __restrict__ Bt, int ldb, int K, int m0, int n0, char* smem, const Epi& epi, const float* part = nullptr) {
    constexpr int BM = WAVES_M * MB * 32, BN = WAVES_N * NB * 32, LA = BM / 32, LB = BN / 32, RS = 144;
    char* As = smem; char* Bs = smem + BM * RS; float* rsc = (float*)(smem + (BM + BN) * RS);
    int tid_ = threadIdx.x & 255; asm volatile("" : "+v"(tid_));
    const int tid = tid_, lane = tid & 63, wid = tid >> 6, r32 = lane & 31, hi = lane >> 5;
    const int wm = wid / WAVES_N, wn = wid % WAVES_N;
    const int lrow = tid >> 3, lkc = tid & 7;
    const bf16_t* Ap = A + (size_t)(m0 + lrow) * lda + lkc * 8;
    const bf16_t* Bp = Bt + (size_t)(n0 + lrow) * ldb + lkc * 8;
    u32x4 ra[LA], rb[LB]; float ss[LA];
    f32x16 acc[NB][MB];
#pragma unroll
    for (int i = 0; i < LA; ++i) ss[i] = 0.f;
#pragma unroll
    for (int nb = 0; nb < NB; ++nb)
#pragma unroll
        for (int mb = 0; mb < MB; ++mb)
#pragma unroll
            for (int r = 0; r < 16; ++r) acc[nb][mb][r] = 0.f;
#pragma unroll
    for (int i = 0; i < LA; ++i) ra[i] = *(const u32x4*)(Ap + (size_t)i * 32 * lda);
#pragma unroll
    for (int i = 0; i < LB; ++i) rb[i] = *(const u32x4*)(Bp + (size_t)i * 32 * ldb);
    const int nk = K >> 6;
    for (int kt = 0; kt < nk; ++kt) {
        __syncthreads();
#pragma unroll
        for (int i = 0; i < LA; ++i) *(u32x4*)(As + (lrow + 32 * i) * RS + lkc * 16) = ra[i];
#pragma unroll
        for (int i = 0; i < LB; ++i) *(u32x4*)(Bs + (lrow + 32 * i) * RS + lkc * 16) = rb[i];
        if (NORM_A == 1) {
#pragma unroll
            for (int i = 0; i < LA; ++i)
#pragma unroll
                for (int j = 0; j < 4; ++j) { const float a = bflo(ra[i][j]), b = bfhi(ra[i][j]); ss[i] += a * a + b * b; }
        }
        __syncthreads();
        if (kt + 1 < nk) {
            Ap += 64; Bp += 64;
#pragma unroll
            for (int i = 0; i < LA; ++i) ra[i] = *(const u32x4*)(Ap + (size_t)i * 32 * lda);
#pragma unroll
            for (int i = 0; i < LB; ++i) rb[i] = *(const u32x4*)(Bp + (size_t)i * 32 * ldb);
        }
#pragma unroll
        for (int s = 0; s < 4; ++s) {
            bf16x8 af[MB], bfr[NB];
#pragma unroll
            for (int mb = 0; mb < MB; ++mb) af[mb] = *(const bf16x8*)(As + (wm * MB * 32 + mb * 32 + r32) * RS + s * 32 + hi * 16);
#pragma unroll
            for (int nb = 0; nb < NB; ++nb) bfr[nb] = *(const bf16x8*)(Bs + (wn * NB * 32 + nb * 32 + r32) * RS + s * 32 + hi * 16);
#pragma unroll
            for (int nb = 0; nb < NB; ++nb)
#pragma unroll
                for (int mb = 0; mb < MB; ++mb) acc[nb][mb] = MFMA(bfr[nb], af[mb], acc[nb][mb]);
        }
    }
    if (NORM_A == 1) {
#pragma unroll
        for (int i = 0; i < LA; ++i) {
            float s = ss[i]; s += __shfl_xor(s, 1); s += __shfl_xor(s, 2); s += __shfl_xor(s, 4);
            if (lkc == 0) rsc[lrow + 32 * i] = rsqrtf(s / (float)K + EPS);
        }
        __syncthreads();
    }
    if (NORM_A == 2) {
        if (tid < BM) { const float* pp = part + (size_t)(m0 + tid) * 16; const f32x4 a = *(const f32x4*)pp, b = *(const f32x4*)(pp + 4), c = *(const f32x4*)(pp + 8), d = *(const f32x4*)(pp + 12);
            rsc[tid] = rsqrtf((((a[0] + a[1]) + (a[2] + a[3])) + ((b[0] + b[1]) + (b[2] + b[3])) + ((c[0] + c[1]) + (c[2] + c[3])) + ((d[0] + d[1]) + (d[2] + d[3]))) * (1.0f / 1024.0f) + EPS); }
        __syncthreads();
    }
    epi.template run<NB, MB>(acc, m0 + wm * MB * 32, n0 + wn * NB * 32, r32, hi, rsc + wm * MB * 32);
}

DI void glds16(const void* g, unsigned lds_addr) {
    unsigned sv;
    asm volatile("s_mov_b32 %0, m0\n\ts_mov_b32 m0, %2\n\ts_nop 0\n\tglobal_load_lds_dwordx4 %1, off\n\ts_mov_b32 m0, %0" : "=&s"(sv) : "v"(g), "s"(lds_addr) : "memory");
}
template <class E, class = void> struct IsStaged { static constexpr bool v = false; };
template <class E> struct IsStaged<E, decltype((void)E::STAGED)> { static constexpr bool v = E::STAGED; };
struct Tile256 { const bf16_t* A; const bf16_t* Bt; const float* part; int lda, ldb, K, m0, n0, npart, tag; float invk; };
template <class Epi, class TileFn>
DI void gemm256_stream(const TileFn& tf, int it0, int step, int ntiles, char* smem, const Epi& epi) {
    constexpr int MB = 4, NB = 2, BM = 256, STG = 65536, NSEG = 8;
    int tid_ = threadIdx.x; asm volatile("" : "+v"(tid_));
    const int tid = tid_, lane = tid & 63, wid = tid >> 6, r32 = lane & 31, hi = lane >> 5;
    const int wm = wid >> 2, wn = wid & 3;
    const int lr = lane >> 3, cc = lane & 7;
    const unsigned lds0 = (unsigned)(uintptr_t)smem;
    float* rsc = (float*)(smem + 2 * STG);
    int aoff[MB], boff[NB], asw[MB], bsw[NB];
#pragma unroll
    for (int mb = 0; mb < MB; ++mb) { const int r = wm * 128 + mb * 32 + r32; aoff[mb] = r * 128; asw[mb] = (r >> 1) & 7; }
#pragma unroll
    for (int nb = 0; nb < NB; ++nb) { const int r = wn * 64 + nb * 32 + r32; boff[nb] = (BM + r) * 128; bsw[nb] = (r >> 1) & 7; }
#define SRC_OF(T_, j_) ((j_) < 4 ? (T_).A + (size_t)((T_).m0 + 8 * (wid + 8 * (j_)) + lr) * (T_).lda + ((cc ^ (((8 * (wid + 8 * (j_)) + lr) >> 1) & 7)) * 8) \
                                 : (T_).Bt + (size_t)((T_).n0 + 8 * (wid + 8 * (j_)) + lr - BM) * (T_).ldb + ((cc ^ (((8 * (wid + 8 * (j_)) + lr - BM) >> 1) & 7)) * 8))
    bool primed = false;
    for (int it = it0; it < ntiles; it += step) {
        const Tile256 t = tf(it);
        const int nk = t.K >> 6;
        const bf16_t* src[NSEG];
#pragma unroll
        for (int j = 0; j < NSEG; ++j) src[j] = SRC_OF(t, j);
        f32x16 acc[NB][MB];
#pragma unroll
        for (int nb = 0; nb < NB; ++nb)
#pragma unroll
            for (int mb = 0; mb < MB; ++mb)
#pragma unroll
                for (int r = 0; r < 16; ++r) acc[nb][mb][r] = 0.f;
        if (!primed) {
            __syncthreads();
#pragma unroll
            for (int j = 0; j < NSEG; ++j) glds16(src[j], (unsigned)__builtin_amdgcn_readfirstlane((int)(lds0 + (wid + 8 * j) * 1024)));
        }
        for (int kt = 0; kt < nk; ++kt) {
            asm volatile("s_waitcnt vmcnt(0)\n\ts_barrier" ::: "memory");
            if (kt + 1 < nk) {
#pragma unroll
                for (int j = 0; j < NSEG; ++j) glds16(src[j] + (size_t)(kt + 1) * 64, (unsigned)__builtin_amdgcn_readfirstlane((int)(lds0 + ((kt + 1) & 1) * STG + (wid + 8 * j) * 1024)));
            } else if (it + step < ntiles) {
                const Tile256 tn = tf(it + step);
#pragma unroll
                for (int j = 0; j < NSEG; ++j) glds16(SRC_OF(tn, j), (unsigned)__builtin_amdgcn_readfirstlane((int)(lds0 + (wid + 8 * j) * 1024)));
                primed = true;
            }
            const char* st = smem + (kt & 1) * STG;
#pragma unroll
            for (int s = 0; s < 4; ++s) {
                bf16x8 af[MB], bfr[NB];
#pragma unroll
                for (int mb = 0; mb < MB; ++mb) af[mb] = *(const bf16x8*)(st + aoff[mb] + (((2 * s + hi) ^ asw[mb]) * 16));
#pragma unroll
                for (int nb = 0; nb < NB; ++nb) bfr[nb] = *(const bf16x8*)(st + boff[nb] + (((2 * s + hi) ^ bsw[nb]) * 16));
#pragma unroll
                for (int nb = 0; nb < NB; ++nb)
#pragma unroll
                    for (int mb = 0; mb < MB; ++mb) acc[nb][mb] = MFMA(bfr[nb], af[mb], acc[nb][mb]);
            }
        }
        if (t.part) {
            if (tid < BM) { const float* pp = t.part + (size_t)(t.m0 + tid) * t.npart; float sq = 0.f;
                for (int i = 0; i < t.npart; i += 2) sq += pp[i] + pp[i + 1];
                rsc[tid] = rsqrtf(sq * t.invk + EPS); }
            __syncthreads();
        }
        if constexpr (IsStaged<Epi>::v) epi.template run_staged<NB, MB>(acc, t.m0, t.n0, wm, wn, r32, hi, lane, wid, smem + STG);
        else epi.template run<NB, MB>(acc, t.m0 + wm * 128, t.n0 + wn * 64, r32, hi, rsc + wm * 128, t.tag);
        if (t.part) __syncthreads();
    }
#undef SRC_OF
}

struct EpiP1 {
    bf16_t* U; float* dtraw; float* pq; float* pkv;
    template <int NB, int MB> DI void run(f32x16 (&acc)[NB][MB], int mb0, int nb0, int r32, int hi, const float* rs, int tag = 0) const {
#pragma unroll
        for (int mb = 0; mb < MB; ++mb) { const int row = mb0 + mb * 32 + r32; const float sc = rs[mb * 32 + r32]; float ssq = 0.f;
#pragma unroll
            for (int nb = 0; nb < NB; ++nb) { const int cb = nb0 + nb * 32; u32x2 w[4];
#pragma unroll
                for (int g = 0; g < 4; ++g) {
                    const float v0 = acc[nb][mb][4 * g] * sc, v1 = acc[nb][mb][4 * g + 1] * sc, v2 = acc[nb][mb][4 * g + 2] * sc, v3 = acc[nb][mb][4 * g + 3] * sc;
                    w[g] = (u32x2){pk2(v0, v1), pk2(v2, v3)}; ssq += (v0 * v0 + v1 * v1) + (v2 * v2 + v3 * v3);
                    if (cb + 8 * g + 4 * hi == UC_DT) *(f32x4*)(dtraw + (size_t)row * 4) = (f32x4){v0, v1, v2, v3}; }
                bf16_t* blk = U + (size_t)row * NIN + cb;
                store_pair16(blk, hi, 0, w[0], w[1]); store_pair16(blk, hi, 2, w[2], w[3]); }
            if (nb0 < UC_KR) { ssq += __shfl_xor(ssq, 32);
                if (hi == 0) { if (nb0 < UC_CKV) pq[(size_t)row * 4 + (nb0 >> 6)] = ssq; else pkv[(size_t)row * 2 + ((nb0 - UC_CKV) >> 6)] = ssq; } } }
    }
};
struct EpiP1KV {
    EpiP1 p1; bf16_t* kmem; bf16_t* vmem;
    template <int NB, int MB> DI void run(f32x16 (&acc)[NB][MB], int mb0, int nb0, int r32, int hi, const float* rs, int tag = 0) const {
        if (mb0 < T) { p1.template run<NB, MB>(acc, mb0, nb0, r32, hi, rs); return; }
        bf16_t* O = (nb0 >> 10) ? vmem : kmem;
#pragma unroll
        for (int mb = 0; mb < MB; ++mb) { const int row = mb0 - T + mb * 32 + r32; const float sc = rs[mb * 32 + r32];
#pragma unroll
            for (int nb = 0; nb < NB; ++nb) { u32x2 w[4];
#pragma unroll
                for (int g = 0; g < 4; ++g) w[g] = (u32x2){pk2(acc[nb][mb][4 * g] * sc, acc[nb][mb][4 * g + 1] * sc), pk2(acc[nb][mb][4 * g + 2] * sc, acc[nb][mb][4 * g + 3] * sc)};
                bf16_t* blk = O + (size_t)row * 1024 + (nb0 & 1023) + nb * 32;
                store_pair16(blk, hi, 0, w[0], w[1]); store_pair16(blk, hi, 2, w[2], w[3]); } }
    }
};
template <bool USE_RS> struct EpiPlain {
    bf16_t* O; int ld; int row_off, col_off; float scale;
    template <int NB, int MB> DI void run(f32x16 (&acc)[NB][MB], int mb0, int nb0, int r32, int hi, const float* rs, int tag = 0) const {
#pragma unroll
        for (int mb = 0; mb < MB; ++mb) { const int row = mb0 + mb * 32 + r32 + row_off; const float sc = USE_RS ? rs[mb * 32 + r32] * scale : scale;
#pragma unroll
            for (int nb = 0; nb < NB; ++nb)
#pragma unroll
                for (int g = 0; g < 4; ++g) { const int col = nb0 + nb * 32 + 8 * g + 4 * hi + col_off;
                    *(u32x2*)(O + (size_t)row * ld + col) = (u32x2){pk2(acc[nb][mb][4 * g] * sc, acc[nb][mb][4 * g + 1] * sc), pk2(acc[nb][mb][4 * g + 2] * sc, acc[nb][mb][4 * g + 3] * sc)}; } }
    }
};
struct EpiRelu2 {
    bf16_t* H;
    template <int NB, int MB> DI void run(f32x16 (&acc)[NB][MB], int mb0, int nb0, int r32, int hi, const float* rs, int tag = 0) const {
#pragma unroll
        for (int mb = 0; mb < MB; ++mb) { const int row = mb0 + mb * 32 + r32; const float sc = rs[mb * 32 + r32];
#pragma unroll
            for (int nb = 0; nb < NB; ++nb) { u32x2 w[4];
#pragma unroll
                for (int g = 0; g < 4; ++g) { float v[4];
#pragma unroll
                    for (int j = 0; j < 4; ++j) { const float t = fmaxf(acc[nb][mb][4 * g + j] * sc, 0.f); v[j] = t * t; }
                    w[g] = (u32x2){pk2(v[0], v[1]), pk2(v[2], v[3])}; }
                bf16_t* blk = H + (size_t)row * 4096 + nb0 + nb * 32;
                store_pair16(blk, hi, 0, w[0], w[1]); store_pair16(blk, hi, 2, w[2], w[3]); } }
    }
};
struct EpiResid {
    static constexpr bool STAGED = true;
    const float* res; float* out; bf16_t* xb; float* part;
    template <int NB, int MB> DI void run_staged(f32x16 (&acc)[NB][MB], int m0, int n0, int wm, int wn, int r32, int hi, int lane, int wid, char* stage) const {
        asm volatile("s_waitcnt lgkmcnt(0)\n\ts_barrier" ::: "memory");
#pragma unroll 1
        for (int p = 0; p < 4; ++p) {
            const int c = lane & 15; f32x4 rr[4];
#pragma unroll
            for (int q = 0; q < 4; ++q) { const int r = wid * 32 + q * 4 + (lane >> 4); rr[q] = *(const f32x4*)(res + (size_t)(m0 + r) * DM + n0 + 64 * p + 4 * c); }
            if (wn == p) {
#pragma unroll
                for (int mb = 0; mb < MB; ++mb) { const int r = wm * 128 + mb * 32 + r32;
#pragma unroll
                    for (int nb = 0; nb < NB; ++nb)
#pragma unroll
                        for (int g = 0; g < 4; ++g) { const int cc = nb * 8 + 2 * g + hi;
                            *(f32x4*)(stage + r * 256 + ((cc ^ (r & 15)) * 16)) = (f32x4){acc[nb][mb][4 * g], acc[nb][mb][4 * g + 1], acc[nb][mb][4 * g + 2], acc[nb][mb][4 * g + 3]}; } }
            }
            asm volatile("s_waitcnt lgkmcnt(0)\n\ts_barrier" ::: "memory");
#pragma unroll 1
            for (int hq = 0; hq < 2; ++hq) {
                if (hq) {
#pragma unroll
                    for (int q = 0; q < 4; ++q) { const int r = wid * 32 + (4 + q) * 4 + (lane >> 4); rr[q] = *(const f32x4*)(res + (size_t)(m0 + r) * DM + n0 + 64 * p + 4 * c); }
                }
#pragma unroll
                for (int q = 0; q < 4; ++q) { const int r = wid * 32 + (4 * hq + q) * 4 + (lane >> 4); const size_t o = (size_t)(m0 + r) * DM + n0 + 64 * p + 4 * c;
                    f32x4 v = *(const f32x4*)(stage + r * 256 + ((c ^ (r & 15)) * 16));
                    v[0] += rr[q][0]; v[1] += rr[q][1]; v[2] += rr[q][2]; v[3] += rr[q][3];
                    *(f32x4*)(out + o) = v; *(u32x2*)(xb + o) = (u32x2){pk2(v[0], v[1]), pk2(v[2], v[3])};
                    float ssq = (v[0] * v[0] + v[1] * v[1]) + (v[2] * v[2] + v[3] * v[3]);
                    ssq += __shfl_xor(ssq, 1); ssq += __shfl_xor(ssq, 2); ssq += __shfl_xor(ssq, 4); ssq += __shfl_xor(ssq, 8);
                    if (c == 0) part[(size_t)(m0 + r) * 16 + (n0 >> 6) + p] = ssq; }
            }
            asm volatile("s_waitcnt lgkmcnt(0)\n\ts_barrier" ::: "memory");
        }
    }
    template <int NB, int MB> DI void run(f32x16 (&acc)[NB][MB], int mb0, int nb0, int r32, int hi, const float*, int tag = 0) const {
#pragma unroll
        for (int mb = 0; mb < MB; ++mb) { const int row = mb0 + mb * 32 + r32; float ssq = 0.f;
#pragma unroll
            for (int nb = 0; nb < NB; ++nb)
                { u32x2 w[4];
#pragma unroll
                for (int g = 0; g < 4; ++g) { const int col = nb0 + nb * 32 + 8 * g + 4 * hi; const size_t o = (size_t)row * DM + col;
                    f32x4 v = *(const f32x4*)(res + o);
                    v[0] += acc[nb][mb][4 * g]; v[1] += acc[nb][mb][4 * g + 1]; v[2] += acc[nb][mb][4 * g + 2]; v[3] += acc[nb][mb][4 * g + 3];
                    *(f32x4*)(out + o) = v; ssq += (v[0] * v[0] + v[1] * v[1]) + (v[2] * v[2] + v[3] * v[3]);
                    w[g] = (u32x2){pk2(v[0], v[1]), pk2(v[2], v[3])}; }
                bf16_t* blk = xb + (size_t)row * DM + nb0 + nb * 32;
                store_pair16(blk, hi, 0, w[0], w[1]); store_pair16(blk, hi, 2, w[2], w[3]); }
            ssq += __shfl_xor(ssq, 32);
            if (hi == 0) part[(size_t)row * 16 + (nb0 >> 6)] = ssq; }
    }
};
struct EpiSoftmax {
    bf16_t* P; float* xch;
    template <int NB, int MB> DI void run(f32x16 (&acc)[NB][MB], int mb0, int nb0, int r32, int hi, const float* rs, int tag = 0) const {
        const int row = mb0 + r32; const float sc = rs[r32]; const int wm = (mb0 >> 5) & 1, wn = (nb0 >> 7) & 1;
        float m = -3.0e38f;
#pragma unroll
        for (int nb = 0; nb < NB; ++nb)
#pragma unroll
            for (int r = 0; r < 16; ++r) { acc[nb][0][r] *= sc; m = fmaxf(m, acc[nb][0][r]); }
        m = fmaxf(m, __shfl_xor(m, 32));
        if (hi == 0) xch[(wm * 2 + wn) * 32 + r32] = m;
        __syncthreads();
        m = fmaxf(m, xch[(wm * 2 + (wn ^ 1)) * 32 + r32]);
        float s = 0.f;
#pragma unroll
        for (int nb = 0; nb < NB; ++nb)
#pragma unroll
            for (int r = 0; r < 16; ++r) { const float p = __builtin_amdgcn_exp2f(acc[nb][0][r] - m); acc[nb][0][r] = p; s += p; }
        s += __shfl_xor(s, 32);
        if (hi == 0) xch[128 + (wm * 2 + wn) * 32 + r32] = s;
        __syncthreads();
        s += xch[128 + (wm * 2 + (wn ^ 1)) * 32 + r32];
        const float inv = 1.0f / s;
#pragma unroll
        for (int nb = 0; nb < NB; ++nb)
#pragma unroll
            for (int g = 0; g < 4; ++g) { const int col = nb0 + nb * 32 + 8 * g + 4 * hi;
                *(u32x2*)(P + (size_t)row * DM + col) = (u32x2){pk2(acc[nb][0][4 * g] * inv, acc[nb][0][4 * g + 1] * inv), pk2(acc[nb][0][4 * g + 2] * inv, acc[nb][0][4 * g + 3] * inv)}; }
    }
};
struct EpiSoftmax256 {
    bf16_t* P; float* xch;
    template <int NB, int MB> DI void run(f32x16 (&acc)[NB][MB], int mb0, int nb0, int r32, int hi, const float* rs, int tag = 0) const {
        const int wn = (nb0 >> 6) & 3, lr0 = (mb0 & 255) + r32;
#pragma unroll
        for (int mb = 0; mb < MB; ++mb) { const float sc = rs[mb * 32 + r32]; float m = -3.0e38f;
#pragma unroll
            for (int nb = 0; nb < NB; ++nb)
#pragma unroll
                for (int r = 0; r < 16; ++r) { acc[nb][mb][r] *= sc; m = fmaxf(m, acc[nb][mb][r]); }
            m = fmaxf(m, __shfl_xor(m, 32));
            if (hi == 0) xch[(lr0 + mb * 32) * 4 + wn] = m; }
        __syncthreads();
#pragma unroll
        for (int mb = 0; mb < MB; ++mb) { const f32x4 mm = *(const f32x4*)(xch + (lr0 + mb * 32) * 4); const float m = fmaxf(fmaxf(mm[0], mm[1]), fmaxf(mm[2], mm[3])); float sm = 0.f;
#pragma unroll
            for (int nb = 0; nb < NB; ++nb)
#pragma unroll
                for (int r = 0; r < 16; ++r) { const float p = __builtin_amdgcn_exp2f(acc[nb][mb][r] - m); acc[nb][mb][r] = p; sm += p; }
            sm += __shfl_xor(sm, 32);
            if (hi == 0) xch[1024 + (lr0 + mb * 32) * 4 + wn] = sm; }
        __syncthreads();
#pragma unroll
        for (int mb = 0; mb < MB; ++mb) { const f32x4 sv = *(const f32x4*)(xch + 1024 + (lr0 + mb * 32) * 4); const float inv = __builtin_amdgcn_rcpf((sv[0] + sv[1]) + (sv[2] + sv[3]));
            const int row = mb0 + mb * 32 + r32;
#pragma unroll
            for (int nb = 0; nb < NB; ++nb) { u32x2 w[4];
#pragma unroll
                for (int g = 0; g < 4; ++g) w[g] = (u32x2){pk2(acc[nb][mb][4 * g] * inv, acc[nb][mb][4 * g + 1] * inv), pk2(acc[nb][mb][4 * g + 2] * inv, acc[nb][mb][4 * g + 3] * inv)};
                bf16_t* blk = P + (size_t)row * DM + nb0 + nb * 32;
                store_pair16(blk, hi, 0, w[0], w[1]); store_pair16(blk, hi, 2, w[2], w[3]); } }
    }
};
constexpr float QSCALE = 0.10206207261596575f * LOG2E;
struct EpiQ {
    bf16_t* Q; const float* cs; const float* sn;
    template <int NB, int MB> DI void run(f32x16 (&acc)[NB][MB], int mb0, int nb0, int r32, int hi, const float* rs, int tag = 0) const {
#pragma unroll
        for (int mb = 0; mb < MB; ++mb) { const int row = mb0 + mb * 32 + r32; const float sc = rs[mb * 32 + r32] * QSCALE; const int b = row >> 13, s = row & 8191;
#pragma unroll
            for (int nb = 0; nb < NB; ++nb) { const int cb = nb0 + nb * 32; const int h = cb / 96, d0 = cb - h * 96;
                float v[16];
#pragma unroll
                for (int r = 0; r < 16; ++r) v[r] = acc[nb][mb][r] * sc;
                if (d0 == 64) {
#pragma unroll
                    for (int g = 0; g < 2; ++g) { const f32x4 c = *(const f32x4*)(cs + (size_t)row * 16 + 8 * g + 4 * hi), sv = *(const f32x4*)(sn + (size_t)row * 16 + 8 * g + 4 * hi);
#pragma unroll
                        for (int j = 0; j < 4; ++j) { const float x1 = v[4 * g + j], x2 = v[4 * (g + 2) + j]; v[4 * g + j] = x1 * c[j] - x2 * sv[j]; v[4 * (g + 2) + j] = x2 * c[j] + x1 * sv[j]; } }
                }
                bf16_t* qp = Q + ((size_t)(b * 8 + h) * SEQ + s) * 96 + d0 + 4 * hi;
#pragma unroll
                for (int g = 0; g < 4; ++g) *(u32x2*)(qp + 8 * g) = (u32x2){pk2(v[4 * g], v[4 * g + 1]), pk2(v[4 * g + 2], v[4 * g + 3])}; } }
    }
};
struct EpiKV {
    bf16_t* Kimg; bf16_t* Vimg; const bf16_t* U; const float* cs; const float* sn;
    template <int NB, int MB> DI void run(f32x16 (&acc)[NB][MB], int mb0, int nb0, int r32, int hi, const float* rs, int tag = 0) const {
        const int h = nb0 >> 7, isv = (nb0 >> 6) & 1;
#pragma unroll
        for (int mb = 0; mb < MB; ++mb) { const int row = mb0 + mb * 32 + r32; const float sc = rs[mb * 32 + r32]; const int b = row >> 13, s = row & 8191, tile = s >> 6, rin = s & 63;
            const size_t tb = (size_t)(b * 8 + h) * 128 + tile;
#pragma unroll
            for (int nb = 0; nb < NB; ++nb)
#pragma unroll
                for (int g = 0; g < 4; ++g) { const u32x2 w = (u32x2){pk2(acc[nb][mb][4 * g] * sc, acc[nb][mb][4 * g + 1] * sc), pk2(acc[nb][mb][4 * g + 2] * sc, acc[nb][mb][4 * g + 3] * sc)};
                    if (!isv) *(u32x2*)(Kimg + (tb * 12 + nb * 4 + g) * 512 + rin * 8 + 4 * hi) = w;
                    else *(u32x2*)(Vimg + (tb * 2 + nb) * 2048 + rin * 32 + 8 * g + 4 * hi) = w; }
            if (!isv) {
                const u32x4 a = *(const u32x4*)(U + (size_t)row * NIN + UC_KR + 8 * hi), bq = *(const u32x4*)(U + (size_t)row * NIN + UC_KR + 16 + 8 * hi);
                unsigned w1[4], w2[4];
#pragma unroll
                for (int p = 0; p < 2; ++p) {
                    const f32x4 c = *(const f32x4*)(cs + (size_t)row * 16 + 8 * hi + 4 * p), sv = *(const f32x4*)(sn + (size_t)row * 16 + 8 * hi + 4 * p);
                    const float x1a = bflo(a[2 * p]), x1b = bfhi(a[2 * p]), x1c = bflo(a[2 * p + 1]), x1d = bfhi(a[2 * p + 1]);
                    const float x2a = bflo(bq[2 * p]), x2b = bfhi(bq[2 * p]), x2c = bflo(bq[2 * p + 1]), x2d = bfhi(bq[2 * p + 1]);
                    w1[2 * p] = pk2(x1a * c[0] - x2a * sv[0], x1b * c[1] - x2b * sv[1]); w1[2 * p + 1] = pk2(x1c * c[2] - x2c * sv[2], x1d * c[3] - x2d * sv[3]);
                    w2[2 * p] = pk2(x2a * c[0] + x1a * sv[0], x2b * c[1] + x1b * sv[1]); w2[2 * p + 1] = pk2(x2c * c[2] + x1c * sv[2], x2d * c[3] + x1d * sv[3]);
                }
                *(u32x4*)(Kimg + (tb * 12 + 8 + hi) * 512 + rin * 8) = (u32x4){w1[0], w1[1], w1[2], w1[3]};
                *(u32x4*)(Kimg + (tb * 12 + 10 + hi) * 512 + rin * 8) = (u32x4){w2[0], w2[1], w2[2], w2[3]};
            } }
    }
};

struct EpiStage1 {
    EpiKV kv; EpiQ q; bf16_t* wqkt; bf16_t* vwot;
    template <int NB, int MB> DI void run(f32x16 (&acc)[NB][MB], int mb0, int nb0, int r32, int hi, const float* rs, int tag = 0) const {
        const int kind = tag & 3, b = (tag >> 2) & 1, h = (tag >> 3) & 3;
        if (kind == 0) kv.template run<NB, MB>(acc, mb0, nb0, r32, hi, rs);
        else if (kind == 1) q.template run<NB, MB>(acc, mb0, nb0, r32, hi, rs);
        else if (kind == 2) { EpiPlain<false> e{wqkt + (size_t)b * 1048576, 1024, h * 256 - b * 256, 0, 0.0625f * LOG2E}; e.template run<NB, MB>(acc, mb0, nb0, r32, hi, rs); }
        else { EpiPlain<false> e{vwot + (size_t)b * 1048576, 1024, 0, h * 256, 1.0f}; e.template run<NB, MB>(acc, mb0, nb0, r32, hi, rs); }
    }
};

DI void convT_tiles(const float* __restrict__ src, int srcld, int K, int N, bf16_t* __restrict__ dst, int dstld, const float* __restrict__ gain, float* tl, int& base) {
    int tid_ = threadIdx.x & 255; asm volatile("" : "+v"(tid_));
    const int G = VGRID(), tid = tid_; const int tn = (N + 63) >> 6, tiles = (K >> 6) * tn;
    int start = (VBID() - base) % G; if (start < 0) start += G;
    const int niter = (tiles + G - 1) / G;
    for (int itr = 0; itr < niter; ++itr) {
        const int t = start + itr * G; const bool valid = t < tiles;
        const int k0 = valid ? (t / tn) * 64 : 0, n0 = valid ? (t % tn) * 64 : 0;
        __syncthreads();
        if (valid) {
#pragma unroll
        for (int i = 0; i < 4; ++i) { const int k = (tid >> 4) + 16 * i, nn = (tid & 15) * 4; const float g = gain ? gain[k0 + k] : 1.0f;
            f32x4 v = (f32x4){0.f, 0.f, 0.f, 0.f};
            if (n0 + nn + 3 < N) v = *(const f32x4*)(src + (size_t)(k0 + k) * srcld + n0 + nn);
            tl[k * 65 + nn] = v[0] * g; tl[k * 65 + nn + 1] = v[1] * g; tl[k * 65 + nn + 2] = v[2] * g; tl[k * 65 + nn + 3] = v[3] * g; }
        }
        __syncthreads();
        const int n = tid >> 2, ks = (tid & 3) * 16;
        if (valid && n0 + n < N) { unsigned w[8];
#pragma unroll
            for (int q = 0; q < 8; ++q) w[q] = pk2(tl[(ks + 2 * q) * 65 + n], tl[(ks + 2 * q + 1) * 65 + n]);
            bf16_t* d = dst + (size_t)(n0 + n) * dstld + k0 + ks;
            *(u32x4*)d = (u32x4){w[0], w[1], w[2], w[3]}; *(u32x4*)(d + 8) = (u32x4){w[4], w[5], w[6], w[7]}; }
    }
    base = (base + tiles) % G;
}
DI void convert_layer_weights(const Ctx& P, int l, float* tl) {
    bf16_t* W = (bf16_t*)(P.ws + ((l & 1) ? WS_WB1 : WS_WB0));
    int base = 0;
    const float* w_in = P.in[4] + (size_t)l * 1024 * 1700; const float* g_mix = P.in[3] + l * 1024;
    const int seg_src[10] = {0, 256, 384, 1184, 416, 672, 928, 1056, 1188, 1444};
    const int seg_w[10] = {256, 128, 32, 4, 256, 256, 128, 128, 256, 256};
    const int seg_dst[10] = {UC_CQ, UC_CKV, UC_KR, UC_DT, UC_Z, UC_XS, UC_BS, UC_CS, UC_XR, UC_GATE};
#pragma unroll
    for (int s = 0; s < 10; ++s) convT_tiles(w_in + seg_src[s], 1700, 1024, seg_w[s], W + WO_IN + (size_t)seg_dst[s] * 1024, 1024, g_mix, tl, base);
    {
        const size_t n = (size_t)92 * 1024 / 8; u32x4* z = (u32x4*)(W + WO_IN + (size_t)420 * 1024);
        int t_ = threadIdx.x & 255; asm volatile("" : "+v"(t_));
        for (size_t i = (size_t)VBID() * 256 + t_; i < n; i += (size_t)VGRID() * 256) z[i] = (u32x4){0u, 0u, 0u, 0u};
    }
    convT_tiles(P.in[7] + (size_t)l * 256 * 768, 768, 256, 768, W + WO_UQ, 256, P.in[5] + l * 256, tl, base);
    convT_tiles(P.in[8] + (size_t)l * 128 * 1024, 1024, 128, 1024, W + WO_UKV, 128, P.in[6] + l * 128, tl, base);
    convT_tiles(P.in[24] + (size_t)l * 1048576, 1024, 512, 1024, W + WO_OUT, 1024, P.in[9] + l * 512, tl, base);
    convT_tiles(P.in[24] + (size_t)l * 1048576 + (size_t)512 * 1024, 1024, 256, 1024, W + WO_OUT + 512, 1024, P.in[15] + l * 256, tl, base);
    convT_tiles(P.in[24] + (size_t)l * 1048576 + (size_t)768 * 1024, 1024, 256, 1024, W + WO_OUT + 768, 1024, P.in[23] + l * 256, tl, base);
    convT_tiles(P.in[28] + (size_t)l * 1048576, 1024, 1024, 1024, W + WO_MK, 1024, P.in[26] + l * 1024, tl, base);
    convT_tiles(P.in[29] + (size_t)l * 1048576, 1024, 1024, 1024, W + WO_MV, 1024, P.in[26] + l * 1024, tl, base);
    convT_tiles(P.in[30] + (size_t)l * 1048576, 1024, 1024, 1024, W + WO_MO, 1024, nullptr, tl, base);
    convT_tiles(P.in[32] + (size_t)l * 4194304, 4096, 1024, 4096, W + WO_1, 1024, P.in[31] + l * 1024, tl, base);
    convT_tiles(P.in[33] + (size_t)l * 4194304, 1024, 4096, 1024, W + WO_2, 4096, nullptr, tl, base);
    for (int n = 0; n < 4; ++n) {
        convT_tiles(P.in[18] + (size_t)(l * 4 + n) * 4096, 64, 64, 64, W + WO_A + n * 4096, 64, nullptr, tl, base);
        convT_tiles(P.in[20] + (size_t)(l * 4 + n) * 4096, 64, 64, 64, W + WO_I + n * 4096, 64, nullptr, tl, base);
    }
    {
        const float* src = P.in[27] + (size_t)l * 1048576; const float* g = P.in[25] + l * 1024; bf16_t* d = W + WO_MQ;
        int t_ = threadIdx.x & 255; asm volatile("" : "+v"(t_));
        for (size_t i = (size_t)VBID() * 256 + t_; i < 131072; i += (size_t)VGRID() * 256) {
            const float gg = g[i >> 7]; const f32x4 a = *(const f32x4*)(src + i * 8), b = *(const f32x4*)(src + i * 8 + 4);
            *(u32x4*)(d + i * 8) = (u32x4){pk2(a[0] * gg, a[1] * gg), pk2(a[2] * gg, a[3] * gg), pk2(b[0] * gg, b[1] * gg), pk2(b[2] * gg, b[3] * gg)}; }
    }
}
DI void phase_prologue(const Ctx& P, char* smem) {
    convert_layer_weights(P, 0, (float*)smem);
    int t_ = threadIdx.x & 255; asm volatile("" : "+v"(t_));
    const size_t gt = (size_t)VBID() * 256 + t_, gs = (size_t)VGRID() * 256;
    {   const float* x = P.in[0]; bf16_t* xb = (bf16_t*)(P.ws + WS_XB); float* part = (float*)(P.ws + WS_PART);
        const int lane = t_ & 63, wid = t_ >> 6;
        for (int row = VBID() * 4 + wid; row < T; row += VGRID() * 4) { float ss = 0.f;
#pragma unroll
            for (int i = 0; i < 4; ++i) { const size_t o = (size_t)row * DM + i * 256 + lane * 4; const f32x4 a = *(const f32x4*)(x + o);
                ss += (a[0] * a[0] + a[1] * a[1]) + (a[2] * a[2] + a[3] * a[3]); *(u32x2*)(xb + o) = (u32x2){pk2(a[0], a[1]), pk2(a[2], a[3])}; }
#pragma unroll
            for (int d = 1; d < 64; d <<= 1) ss += __shfl_xor(ss, d);
            if (lane < 16) part[(size_t)row * 16 + lane] = lane == 0 ? ss : 0.f; } }
    {   const float* x = P.in[1]; bf16_t* xb = (bf16_t*)(P.ws + WS_MEMB); float* part = (float*)(P.ws + WS_PART) + (size_t)T * 16;
        const int lane = t_ & 63, wid = t_ >> 6;
        for (int row = VBID() * 4 + wid; row < 512; row += VGRID() * 4) { float ss = 0.f;
#pragma unroll
            for (int i = 0; i < 4; ++i) { const size_t o = (size_t)row * DM + i * 256 + lane * 4; const f32x4 a = *(const f32x4*)(x + o);
                ss += (a[0] * a[0] + a[1] * a[1]) + (a[2] * a[2] + a[3] * a[3]); *(u32x2*)(xb + o) = (u32x2){pk2(a[0], a[1]), pk2(a[2], a[3])}; }
#pragma unroll
            for (int d = 1; d < 64; d <<= 1) ss += __shfl_xor(ss, d);
            if (lane < 16) part[(size_t)row * 16 + lane] = lane == 0 ? ss : 0.f; } }
    {   const int* pos = (const int*)P.in[2]; float* cs = (float*)(P.ws + WS_COS); float* sn = (float*)(P.ws + WS_SIN);
        for (size_t i = gt; i < (size_t)T * 16; i += gs) { const int tok = (int)(i >> 4), f = (int)(i & 15);
            const float inv = exp2f(-(float)f * (0.0625f * 13.287712379549449f));       const float ang = (float)pos[tok] * inv;
            double a = (double)ang; a -= 6.283185307179586 * rint(a * 0.15915494309189535);
            const float ar = (float)a; cs[i] = __cosf(ar); sn[i] = __sinf(ar); } }
}

DI void attn_item(const bf16_t* __restrict__ Q, const bf16_t* __restrict__ Kimg, const bf16_t* __restrict__ Vimg, bf16_t* __restrict__ Y, int bh, int qblk, int NTC, char* smem, int vb) {
    int tid_ = threadIdx.x & 255; asm volatile("" : "+v"(tid_));
    const int tid = tid_, lane = tid & 63, wid = tid >> 6, r32 = lane & 31, hi = lane >> 5;
    char* Kb = smem; char* Vb = smem + 36864; float* wsf = (float*)(smem + 61440 + vb * 17408) + wid * 64; bf16_t* stg = (bf16_t*)(smem + 61440 + vb * 17408 + 1024) + wid * 2048;
    const int gw = vb * 4 + wid;
    const int q0 = qblk * 128, NT = 2 * (qblk + 1);
    const int qrow = q0 + wid * 32 + r32;
    bf16x8 qr[6];
    { const bf16_t* qp = Q + ((size_t)bh * SEQ + qrow) * 96 + 8 * hi;
#pragma unroll
      for (int d0 = 0; d0 < 6; ++d0) qr[d0] = *(const bf16x8*)(qp + 16 * d0); }
    const bf16_t* kg = Kimg + (size_t)bh * 128 * 6144 + gw * 512 + lane * 8;
    const bf16_t* vg = Vimg + (size_t)bh * 128 * 4096 + gw * 512 + lane * 8;
    const unsigned ldsK = (unsigned)(uintptr_t)Kb + gw * 1024, ldsV = (unsigned)(uintptr_t)Vb + gw * 1024;
#define ATT_ISSUE(tt, st_) do { \
        glds16(kg + (size_t)(tt) * 6144, (unsigned)__builtin_amdgcn_readfirstlane((int)(ldsK + (st_) * 12288))); \
        if (gw < 4) glds16(kg + (size_t)(tt) * 6144 + 4096, (unsigned)__builtin_amdgcn_readfirstlane((int)(ldsK + (st_) * 12288 + 8192))); \
        glds16(vg + (size_t)(tt) * 4096, (unsigned)__builtin_amdgcn_readfirstlane((int)(ldsV + (st_) * 8192))); } while (0)
    __syncthreads();
    ATT_ISSUE(0, 0); ATT_ISSUE(1, 1);
    int sc = 0, s1 = 1, sn = 2;
    f32x16 o0, o1;
#pragma unroll
    for (int r = 0; r < 16; ++r) { o0[r] = 0.f; o1[r] = 0.f; }
    float lsum = 0.f;
    f32x16 negm;
#pragma unroll
    for (int r = 0; r < 16; ++r) negm[r] = 0.f;
    const char* vrd0 = Vb + ((lane >> 4) & 1) * 32 + (lane & 3) * 8 + (4 * hi + ((lane & 15) >> 2)) * 64;
#define ATT_QK(S0_, S1_, stg_) do { const char* kb_ = Kb + (stg_) * 12288 + r32 * 16; \
        { const bf16x8 k0 = *(const bf16x8*)(kb_ + hi * 1024), k1 = *(const bf16x8*)(kb_ + hi * 1024 + 512); S0_ = MFMA(k0, qr[0], negm); S1_ = MFMA(k1, qr[0], negm); } \
        _Pragma("unroll") for (int d0 = 1; d0 < 6; ++d0) { const bf16x8 k0 = *(const bf16x8*)(kb_ + (2 * d0 + hi) * 1024), k1 = *(const bf16x8*)(kb_ + (2 * d0 + hi) * 1024 + 512); \
            S0_ = MFMA(k0, qr[d0], S0_); S1_ = MFMA(k1, qr[d0], S1_); } } while (0)
#define MX3_(a, b, c) __builtin_fmaxf(__builtin_fmaxf((a), (b)), (c))
#define ATT_STEP(A0, A1, B0, B1, tt_) do { const int t = (tt_); \
        if (t + 1 < NTC) asm volatile("s_waitcnt vmcnt(0)\n\ts_barrier" ::: "memory");       \
        if (t + 2 < NTC) ATT_ISSUE(t + 2, sn); \
        const bool actN = (t + 1 < NT) && !(t + 1 == NT - 1 && wid < 2);                       \
        if (actN) ATT_QK(B0, B1, s1); \
        const bool actT = (t < NT) && !(t == NT - 1 && wid < 2); \
        if (actT) { \
            if (t >= NT - 2) { const int kbase = t * 64 + 4 * hi; \
                _Pragma("unroll") for (int r = 0; r < 16; ++r) { const int kv = kbase + (r & 3) + 8 * (r >> 2); if (kv > qrow) A0[r] = -INFINITY; if (kv + 32 > qrow) A1[r] = -INFINITY; } } \
            float ra_ = MX3_(A0[0], A0[1], A1[0]), rb_ = MX3_(A0[2], A0[3], A1[1]); ra_ = MX3_(ra_, A1[2], A1[3]); \
            _Pragma("unroll") for (int r = 4; r < 16; r += 4) { ra_ = MX3_(ra_, A0[r], A0[r + 1]); rb_ = MX3_(rb_, A0[r + 2], A0[r + 3]); ra_ = MX3_(ra_, A1[r], A1[r + 1]); rb_ = MX3_(rb_, A1[r + 2], A1[r + 3]); } \
            float rm = fmaxf(ra_, rb_); rm = fmaxf(rm, __shfl_xor(rm, 32));                    \
            const bool first = (t == 0);                                                       \
            if (first || __any(rm > 8.0f)) { \
                const float dl = first ? rm : fmaxf(rm, 0.f); const float f = __builtin_amdgcn_exp2f(-dl); lsum *= f; \
                if (hi == 0) wsf[r32] = f; \
                asm volatile("s_waitcnt lgkmcnt(0)" ::: "memory"); \
                _Pragma("unroll") for (int g = 0; g < 4; ++g) { const f32x4 fv = *(const f32x4*)(wsf + 8 * g + 4 * hi); \
                    _Pragma("unroll") for (int j = 0; j < 4; ++j) { o0[4 * g + j] *= fv[j]; o1[4 * g + j] *= fv[j]; } } \
                const float nm = negm[0] - dl; \
                _Pragma("unroll") for (int r = 0; r < 16; ++r) { A0[r] -= dl; A1[r] -= dl; negm[r] = nm; } \
                if (actN) { _Pragma("unroll") for (int r = 0; r < 16; ++r) { B0[r] -= dl; B1[r] -= dl; } }     \
            } \
            float ps = 0.f; \
            _Pragma("unroll") for (int r = 0; r < 16; ++r) { A0[r] = __builtin_amdgcn_exp2f(A0[r]); A1[r] = __builtin_amdgcn_exp2f(A1[r]); ps += A0[r] + A1[r]; } \
            lsum += ps; \
            bf16x8 pw[4]; \
            { u32x4 w; \
              w = (u32x4){pk2(A0[0], A0[1]), pk2(A0[2], A0[3]), pk2(A0[4], A0[5]), pk2(A0[6], A0[7])}; pw[0] = __builtin_bit_cast(bf16x8, w); \
              w = (u32x4){pk2(A0[8], A0[9]), pk2(A0[10], A0[11]), pk2(A0[12], A0[13]), pk2(A0[14], A0[15])}; pw[1] = __builtin_bit_cast(bf16x8, w); \
              w = (u32x4){pk2(A1[0], A1[1]), pk2(A1[2], A1[3]), pk2(A1[4], A1[5]), pk2(A1[6], A1[7])}; pw[2] = __builtin_bit_cast(bf16x8, w); \
              w = (u32x4){pk2(A1[8], A1[9]), pk2(A1[10], A1[11]), pk2(A1[12], A1[13]), pk2(A1[14], A1[15])}; pw[3] = __builtin_bit_cast(bf16x8, w); } \
            const char* vp = vrd0 + sc * 8192; \
            _Pragma("unroll") for (int s = 0; s < 4; ++s) { \
                const bf16x8 v0 = cat8(tr_read(vp + s * 1024), tr_read(vp + s * 1024 + 512)); \
                const bf16x8 v1 = cat8(tr_read(vp + 4096 + s * 1024), tr_read(vp + 4096 + s * 1024 + 512)); \
                o0 = MFMA(pw[s], v0, o0); o1 = MFMA(pw[s], v1, o1); } \
        } \
        { const int o_ = sc; sc = s1; s1 = sn; sn = o_; } } while (0)
    f32x16 sa0, sa1, sb0, sb1;
    asm volatile("s_waitcnt vmcnt(0)\n\ts_barrier" ::: "memory");
    ATT_QK(sa0, sa1, 0);
    for (int t2 = 0; t2 < NTC; t2 += 2) {
        ATT_STEP(sa0, sa1, sb0, sb1, t2);
        ATT_STEP(sb0, sb1, sa0, sa1, t2 + 1);
    }
#undef ATT_STEP
#undef ATT_QK
#undef MX3_
#undef ATT_ISSUE
    lsum += __shfl_xor(lsum, 32);
    if (hi == 0) wsf[32 + r32] = lsum;
    asm volatile("s_waitcnt lgkmcnt(0)" ::: "memory");
#pragma unroll
    for (int g = 0; g < 4; ++g) { const f32x4 lv = *(const f32x4*)(wsf + 32 + 8 * g + 4 * hi);
#pragma unroll
        for (int j = 0; j < 4; ++j) { const float inv = 1.0f / lv[j]; const int orow = 8 * g + 4 * hi + j;
            stg[orow * 64 + r32] = (bf16_t)(pk2(o0[4 * g + j] * inv, 0.f) & 0xffffu); stg[orow * 64 + 32 + r32] = (bf16_t)(pk2(o1[4 * g + j] * inv, 0.f) & 0xffffu); } }
    asm volatile("s_waitcnt lgkmcnt(0)" ::: "memory");
    const int b = bh >> 3, h = bh & 7;
    bf16_t* yp = Y + ((size_t)b * SEQ + q0 + wid * 32) * 512 + h * 64;
#pragma unroll
    for (int i = 0; i < 4; ++i) { const int row = i * 8 + (lane >> 3), ch = lane & 7; *(u32x4*)(yp + (size_t)row * 512 + ch * 8) = *(const u32x4*)(stg + row * 64 + ch * 8); }
}

template <int CW, int N8, bool ACT> DI void conv_row(const bf16_t* __restrict__ U, int tok, int tin, int col, const float* __restrict__ cw, const float* __restrict__ cb, int ch, float (&o)[8 * N8]) {
#pragma unroll
    for (int q = 0; q < N8; ++q) {
        float a[8];
        const f32x4 b0 = *(const f32x4*)(cb + ch + 8 * q), b1 = *(const f32x4*)(cb + ch + 8 * q + 4);
#pragma unroll
        for (int j = 0; j < 4; ++j) { a[j] = b0[j]; a[4 + j] = b1[j]; }
#pragma unroll
        for (int k = 0; k < 4; ++k) {
            if (tin - 3 + k >= 0) {
                const u32x4 u = *(const u32x4*)(U + (size_t)(tok - 3 + k) * NIN + col + 8 * q);
                const f32x4 w0 = *(const f32x4*)(cw + (size_t)k * CW + ch + 8 * q), w1 = *(const f32x4*)(cw + (size_t)k * CW + ch + 8 * q + 4);
                a[0] += w0[0] * bflo(u[0]); a[1] += w0[1] * bfhi(u[0]); a[2] += w0[2] * bflo(u[1]); a[3] += w0[3] * bfhi(u[1]);
                a[4] += w1[0] * bflo(u[2]); a[5] += w1[1] * bfhi(u[2]); a[6] += w1[2] * bflo(u[3]); a[7] += w1[3] * bfhi(u[3]);
            }
        }
#pragma unroll
        for (int j = 0; j < 8; ++j) o[8 * q + j] = ACT ? siluf_(a[j]) : a[j];
    }
}
DI void ssd_local_item(const Ctx& P, int l, int item, char* smem) {
    int tid_ = threadIdx.x & 255; asm volatile("" : "+v"(tid_));
    const int tid = tid_, lane = tid & 63, wid = tid >> 6, r32 = lane & 31, hi = lane >> 5;
    const int h = item & 3, c = (item >> 2) & 63, b = item >> 8, g = h >> 1;
    const int tok0 = b * SEQ + c * 128, tin0 = c * 128;
    const bf16_t* U = (const bf16_t*)(P.ws + AR_U);
    const float* cw = P.in[10] + (size_t)l * 4 * 512; const float* cb = P.in[11] + l * 512;
    char* Btr = smem; char* Xtr = smem + 16384; float* acs = (float*)(smem + 32768); float* dts = acs + 128; float* wts = dts + 128; float* tot = wts + 128;
    __syncthreads();
    if (tid < 128) {
        const float dtr = ((const float*)(P.ws + WS_DTRAW))[(size_t)(tok0 + tid) * 4 + h];
        const float dt = softplus_fast(dtr + P.in[12][l * 4 + h]);
        float v = -__expf(P.in[13][l * 4 + h]) * dt;
#pragma unroll
        for (int d = 1; d < 64; d <<= 1) { const float u = __shfl_up(v, d); if (lane >= d) v += u; }
        dts[tid] = dt; acs[tid] = v;
        if (tid == 63) tot[0] = v;
    }
    __syncthreads();
    if (tid >= 64 && tid < 128) acs[tid] += tot[0];
    __syncthreads();
    if (tid < 128) {
        const float ac = acs[tid], ae = acs[127];
        wts[tid] = __expf(ae - ac);
        ((float*)(P.ws + WS_ACUM))[(size_t)(tok0 + tid) * 4 + h] = ac;
        if (tid == 127) ((float*)(P.ws + WS_ATOT))[(b * 4 + h) * 64 + c] = ae;
    }
    {
        const int row = tid >> 1, half = tid & 1; float o[32];
        conv_row<512, 4, true>(U, tok0 + row, tin0 + row, UC_BS + g * 64 + half * 32, cw, cb, 256 + g * 64 + half * 32, o);
#pragma unroll
        for (int q = 0; q < 4; ++q) *(u32x4*)(Btr + half * 8192 + row * 64 + q * 16) = (u32x4){pk2(o[8 * q], o[8 * q + 1]), pk2(o[8 * q + 2], o[8 * q + 3]), pk2(o[8 * q + 4], o[8 * q + 5]), pk2(o[8 * q + 6], o[8 * q + 7])};
        conv_row<512, 4, true>(U, tok0 + row, tin0 + row, UC_XS + h * 64 + half * 32, cw, cb, h * 64 + half * 32, o);
        const float dt = dts[row];
#pragma unroll
        for (int q = 0; q < 4; ++q) *(u32x4*)(Xtr + half * 8192 + row * 64 + q * 16) = (u32x4){pk2(o[8 * q] * dt, o[8 * q + 1] * dt), pk2(o[8 * q + 2] * dt, o[8 * q + 3] * dt), pk2(o[8 * q + 4] * dt, o[8 * q + 5] * dt), pk2(o[8 * q + 6] * dt, o[8 * q + 7] * dt)};
    }
    bf16x8 cf[4];
    {
        const int row = wid * 32 + r32;
#pragma unroll
        for (int d0 = 0; d0 < 4; ++d0) { float o[8];
            conv_row<512, 1, true>(U, tok0 + row, tin0 + row, UC_CS + g * 64 + 16 * d0 + 8 * hi, cw, cb, 384 + g * 64 + 16 * d0 + 8 * hi, o);
            const u32x4 w = (u32x4){pk2(o[0], o[1]), pk2(o[2], o[3]), pk2(o[4], o[5]), pk2(o[6], o[7])};
            cf[d0] = __builtin_bit_cast(bf16x8, w);
            if ((h & 1) == 0) *(u32x4*)((bf16_t*)(P.ws + AR_CC) + (size_t)(tok0 + row) * 128 + g * 64 + 16 * d0 + 8 * hi) = w; }
    }
    __syncthreads();
    f32x16 y0, y1;
#pragma unroll
    for (int r = 0; r < 16; ++r) { y0[r] = 0.f; y1[r] = 0.f; }
    const int lrow = wid * 32 + r32; const float acl = acs[lrow];
    const char* xrd = Xtr + ((lane >> 4) & 1) * 32 + (lane & 3) * 8 + (4 * hi + ((lane & 15) >> 2)) * 64;
    for (int sb = 0; sb <= wid; ++sb) {
        f32x16 gt;
#pragma unroll
        for (int r = 0; r < 16; ++r) gt[r] = 0.f;
#pragma unroll
        for (int d0 = 0; d0 < 4; ++d0) { const bf16x8 bfg = *(const bf16x8*)(Btr + (d0 >> 1) * 8192 + (sb * 32 + r32) * 64 + (d0 & 1) * 32 + hi * 16); gt = MFMA(bfg, cf[d0], gt); }
#pragma unroll
        for (int q = 0; q < 4; ++q) { const f32x4 av = *(const f32x4*)(acs + sb * 32 + 8 * q + 4 * hi);
#pragma unroll
            for (int j = 0; j < 4; ++j) { const int s = sb * 32 + 8 * q + 4 * hi + j; gt[4 * q + j] = (s <= lrow) ? gt[4 * q + j] * __expf(acl - av[j]) : 0.f; } }
        u32x4 w0 = (u32x4){pk2(gt[0], gt[1]), pk2(gt[2], gt[3]), pk2(gt[4], gt[5]), pk2(gt[6], gt[7])};
        u32x4 w1 = (u32x4){pk2(gt[8], gt[9]), pk2(gt[10], gt[11]), pk2(gt[12], gt[13]), pk2(gt[14], gt[15])};
        const bf16x8 p0 = __builtin_bit_cast(bf16x8, w0), p1 = __builtin_bit_cast(bf16x8, w1);
        const char* xp = xrd + sb * 2048;
        { const bf16x8 xa = cat8(tr_read(xp), tr_read(xp + 512)); y0 = MFMA(xa, p0, y0); }
        { const bf16x8 xa = cat8(tr_read(xp + 1024), tr_read(xp + 1024 + 512)); y0 = MFMA(xa, p1, y0); }
        { const bf16x8 xa = cat8(tr_read(xp + 8192), tr_read(xp + 8192 + 512)); y1 = MFMA(xa, p0, y1); }
        { const bf16x8 xa = cat8(tr_read(xp + 8192 + 1024), tr_read(xp + 8192 + 1024 + 512)); y1 = MFMA(xa, p1, y1); }
    }
    {
        const float dsk = P.in[14][l * 4 + h], idt = 1.0f / dts[lrow];
        bf16_t* yl = (bf16_t*)(P.ws + AR_YLOC) + (size_t)(tok0 + lrow) * 256 + h * 64;
#pragma unroll
        for (int pb = 0; pb < 2; ++pb)
#pragma unroll
            for (int q = 0; q < 4; ++q) { const u32x2 xv = *(const u32x2*)(Xtr + pb * 8192 + lrow * 64 + (8 * q + 4 * hi) * 2);
                const float f = dsk * idt; const f32x16& yy = pb ? y1 : y0;
                const float v0 = yy[4 * q] + f * bflo(xv[0]), v1 = yy[4 * q + 1] + f * bfhi(xv[0]), v2 = yy[4 * q + 2] + f * bflo(xv[1]), v3 = yy[4 * q + 3] + f * bfhi(xv[1]);
                *(u32x2*)(yl + pb * 32 + 8 * q + 4 * hi) = (u32x2){pk2(v0, v1), pk2(v2, v3)}; }
    }
    {
        const int pbk = wid >> 1, nbk = wid & 1;
        f32x16 st;
#pragma unroll
        for (int r = 0; r < 16; ++r) st[r] = 0.f;
        const int trow = 4 * hi + ((lane & 15) >> 2), tcol = ((lane >> 4) & 1) * 32 + (lane & 3) * 8;
#pragma unroll
        for (int ks = 0; ks < 8; ++ks) {
            const s16x4 xl = tr_read(Xtr + pbk * 8192 + (16 * ks + trow) * 64 + tcol), xh = tr_read(Xtr + pbk * 8192 + (16 * ks + 8 + trow) * 64 + tcol);
            const s16x4 bl = tr_read(Btr + nbk * 8192 + (16 * ks + trow) * 64 + tcol), bh2 = tr_read(Btr + nbk * 8192 + (16 * ks + 8 + trow) * 64 + tcol);
            const f32x4 wl = *(const f32x4*)(wts + 16 * ks + 4 * hi), wh = *(const f32x4*)(wts + 16 * ks + 8 + 4 * hi);
            float xf[8];
#pragma unroll
            for (int j = 0; j < 4; ++j) { xf[j] = __uint_as_float(((unsigned)(unsigned short)xl[j]) << 16) * wl[j]; xf[4 + j] = __uint_as_float(((unsigned)(unsigned short)xh[j]) << 16) * wh[j]; }
            const u32x4 xw = (u32x4){pk2(xf[0], xf[1]), pk2(xf[2], xf[3]), pk2(xf[4], xf[5]), pk2(xf[6], xf[7])};
            st = MFMA(__builtin_bit_cast(bf16x8, xw), cat8(bl, bh2), st);
        }
        float* sp = (float*)(P.ws + AR_STATES) + ((size_t)((b * 64 + c) * 4 + h) * 64 + pbk * 32) * 64 + nbk * 32 + r32;
#pragma unroll
        for (int r = 0; r < 16; ++r) sp[(size_t)crow(r, hi) * 64] = st[r];
    }
}

DI void lru_local_item(const Ctx& P, int l, int item, char* smem) {
    int tid_ = threadIdx.x & 255; asm volatile("" : "+v"(tid_));
    const int tid = tid_, lane = tid & 63, wid = tid >> 6, r32 = lane & 31, hi = lane >> 5;
    const int nb = item & 3, c = (item >> 2) & 63, b = item >> 8;
    const int tok0 = b * SEQ + c * 128, tin0 = c * 128;
    const bf16_t* U = (const bf16_t*)(P.ws + AR_U);
    const bf16_t* W = (const bf16_t*)(P.ws + ((l & 1) ? WS_WB1 : WS_WB0));
    float* xc = (float*)smem;
    float* totA = (float*)(smem + 34816); float* totH = totA + 256;
    __syncthreads();
    {
        const int row = tid >> 1, half = tid & 1; float o[32];
        conv_row<256, 4, false>(U, tok0 + row, tin0 + row, UC_XR + nb * 64 + half * 32, P.in[16] + (size_t)l * 4 * 256, P.in[17] + l * 256, nb * 64 + half * 32, o);
#pragma unroll
        for (int q = 0; q < 8; ++q) *(f32x4*)(xc + row * 68 + half * 32 + 4 * q) = (f32x4){o[4 * q], o[4 * q + 1], o[4 * q + 2], o[4 * q + 3]};
    }
    __syncthreads();
    const int row = wid * 32 + r32;
    bf16x8 xf[4];
#pragma unroll
    for (int d0 = 0; d0 < 4; ++d0) {
        const f32x4 a = *(const f32x4*)(xc + row * 68 + 16 * d0 + 8 * hi), bq = *(const f32x4*)(xc + row * 68 + 16 * d0 + 8 * hi + 4);
        const u32x4 xw = (u32x4){pk2(a[0], a[1]), pk2(a[2], a[3]), pk2(bq[0], bq[1]), pk2(bq[2], bq[3])};
        xf[d0] = __builtin_bit_cast(bf16x8, xw);
    }
    float Av[32], Hv[32];
    const float* ba = P.in[19] + l * 256 + nb * 64; const float* bi = P.in[21] + l * 256 + nb * 64; const float* lam = P.in[22] + l * 256 + nb * 64;
#pragma unroll
    for (int e = 0; e < 2; ++e) {
        f32x16 ar, ai;
#pragma unroll
        for (int r = 0; r < 16; ++r) { ar[r] = 0.f; ai[r] = 0.f; }
#pragma unroll
        for (int d0 = 0; d0 < 4; ++d0) {
            const bf16x8 wa = *(const bf16x8*)(W + WO_A + nb * 4096 + (e * 32 + r32) * 64 + 16 * d0 + 8 * hi);
            const bf16x8 wi = *(const bf16x8*)(W + WO_I + nb * 4096 + (e * 32 + r32) * 64 + 16 * d0 + 8 * hi);
            ar = MFMA(wa, xf[d0], ar); ai = MFMA(wi, xf[d0], ai);
        }
#pragma unroll
        for (int q = 0; q < 4; ++q) { const int ch = e * 32 + 8 * q + 4 * hi;
            const f32x4 bav = *(const f32x4*)(ba + ch), biv = *(const f32x4*)(bi + ch), lv = *(const f32x4*)(lam + ch), xv = *(const f32x4*)(xc + row * 68 + ch);
#pragma unroll
            for (int j = 0; j < 4; ++j) {
                const float rg = sigmoidf_(ar[4 * q + j] + bav[j]), ig = sigmoidf_(ai[4 * q + j] + biv[j]);
                const float la = -8.0f * rg * softplus_fast(-lv[j]);
                Av[e * 16 + 4 * q + j] = __expf(la);
                Hv[e * 16 + 4 * q + j] = __builtin_amdgcn_sqrtf(neg_expm1_fast(2.0f * la)) * (ig * xv[j]);
            } }
        asm volatile("" ::: "memory");
    }
#pragma unroll
    for (int d = 1; d < 32; d <<= 1) {
#pragma unroll
        for (int i = 0; i < 32; ++i) { const float ap = __shfl_up(Av[i], d, 32), hp = __shfl_up(Hv[i], d, 32); if (r32 >= d) { Hv[i] = Av[i] * hp + Hv[i]; Av[i] = Av[i] * ap; }
            if ((i & 7) == 7) __builtin_amdgcn_sched_barrier(0); }
    }
    if (r32 == 31) {
#pragma unroll
        for (int e = 0; e < 2; ++e)
#pragma unroll
            for (int q = 0; q < 4; ++q)
#pragma unroll
                for (int j = 0; j < 4; ++j) { const int ch = e * 32 + 8 * q + 4 * hi + j; totA[wid * 64 + ch] = Av[e * 16 + 4 * q + j]; totH[wid * 64 + ch] = Hv[e * 16 + 4 * q + j]; }
    }
    __syncthreads();
    float* carA = totH + 256 + wid * 64; float* carH = carA + 256;
    { float Ac = 1.f, Hc = 0.f;
      for (int w = 0; w < wid; ++w) { const float a2 = totA[w * 64 + lane], h2 = totH[w * 64 + lane]; Hc = a2 * Hc + h2; Ac = Ac * a2; }
      carA[lane] = Ac; carH[lane] = Hc; }
    asm volatile("s_waitcnt lgkmcnt(0)" ::: "memory");
    {
        bf16_t* hl = (bf16_t*)(P.ws + AR_HLOC) + (size_t)(tok0 + row) * 256 + nb * 64; bf16_t* ac = (bf16_t*)(P.ws + AR_ACP) + (size_t)(tok0 + row) * 256 + nb * 64;
#pragma unroll
        for (int e = 0; e < 2; ++e)
#pragma unroll
            for (int q = 0; q < 4; ++q) { const int ch = e * 32 + 8 * q + 4 * hi; float av[4], hv[4];
                const f32x4 ca = *(const f32x4*)(carA + ch), chv = *(const f32x4*)(carH + ch);
#pragma unroll
                for (int j = 0; j < 4; ++j) { const int i = e * 16 + 4 * q + j; hv[j] = Av[i] * chv[j] + Hv[i]; av[j] = Av[i] * ca[j]; }
                *(u32x2*)(hl + ch) = (u32x2){pk2(hv[0], hv[1]), pk2(hv[2], hv[3])};
                *(u32x2*)(ac + ch) = (u32x2){pk2(av[0], av[1]), pk2(av[2], av[3])};
                if (wid == 3 && r32 == 31) { float* he = (float*)(P.ws + WS_HEND) + (size_t)(b * 64 + c) * 256 + nb * 64 + ch; float* ae = (float*)(P.ws + WS_AEND) + (size_t)(b * 64 + c) * 256 + nb * 64 + ch;
                    *(f32x4*)he = (f32x4){hv[0], hv[1], hv[2], hv[3]}; *(f32x4*)ae = (f32x4){av[0], av[1], av[2], av[3]}; } }
    }
}

DI void carries(const Ctx& P, int bid) {
    int tid_ = threadIdx.x & 255; asm volatile("" : "+v"(tid_));
    const int tid = tid_;
    if (bid < 128) {
        const int idx = bid * 256 + tid;
        const int b = idx >> 14, h = (idx >> 12) & 3, e = idx & 4095;
        const float* st = (const float*)(P.ws + AR_STATES) + ((size_t)(b * 64) * 4 + h) * 4096 + e;
        bf16_t* so = (bf16_t*)(P.ws + AR_SIN) + ((size_t)(b * 64) * 4 + h) * 4096 + e;
        const float* at = (const float*)(P.ws + WS_ATOT) + (b * 4 + h) * 64;
        float S = 0.f;
        for (int c0 = 0; c0 < 64; c0 += 8) {
            float v[8], a[8];
#pragma unroll
            for (int j = 0; j < 8; ++j) { v[j] = st[(size_t)(c0 + j) * 16384]; a[j] = __expf(at[c0 + j]); }
#pragma unroll
            for (int j = 0; j < 8; ++j) { so[(size_t)(c0 + j) * 16384] = (bf16_t)(pk2(S, 0.f) & 0xffffu); S = a[j] * S + v[j]; }
        }
    } else if (bid < 130) {
        const int idx = (bid - 128) * 256 + tid;
        const int b = idx >> 8, ch = idx & 255;
        const float* he = (const float*)(P.ws + WS_HEND) + (size_t)b * 64 * 256 + ch; const float* ae = (const float*)(P.ws + WS_AEND) + (size_t)b * 64 * 256 + ch;
        float* hin = (float*)(P.ws + WS_HIN) + (size_t)b * 64 * 256 + ch;
        float Hc = 0.f;
        for (int c = 0; c < 64; ++c) { hin[c * 256] = Hc; Hc = ae[c * 256] * Hc + he[c * 256]; }
    }
}

DI void ssd_z_item(const Ctx& P, int item) {
    int tid_ = threadIdx.x & 255; asm volatile("" : "+v"(tid_));
    const int tid = tid_, lane = tid & 63, wid = tid >> 6, r32 = lane & 31, hi = lane >> 5;
    const int g = item & 1, c = (item >> 1) & 63, b = item >> 7;
    const int tok = b * SEQ + c * 128 + wid * 32 + r32;
    const bf16_t* Cc = (const bf16_t*)(P.ws + AR_CC) + (size_t)tok * 128 + g * 64 + 8 * hi;
    bf16x8 cf[4];
#pragma unroll
    for (int d0 = 0; d0 < 4; ++d0) cf[d0] = *(const bf16x8*)(Cc + 16 * d0);
    f32x16 acc[2][2];
#pragma unroll
    for (int hh = 0; hh < 2; ++hh)
#pragma unroll
        for (int pb = 0; pb < 2; ++pb) {
#pragma unroll
            for (int r = 0; r < 16; ++r) acc[hh][pb][r] = 0.f;
            const bf16_t* sp = (const bf16_t*)(P.ws + AR_SIN) + ((size_t)((b * 64 + c) * 4 + 2 * g + hh) * 64 + pb * 32 + r32) * 64 + 8 * hi;
#pragma unroll
            for (int d0 = 0; d0 < 4; ++d0) { const bf16x8 sf = *(const bf16x8*)(sp + 16 * d0); acc[hh][pb] = MFMA(sf, cf[d0], acc[hh][pb]); }
        }
    const f32x4 acv = *(const f32x4*)((const float*)(P.ws + WS_ACUM) + (size_t)tok * 4);
    const bf16_t* yl = (const bf16_t*)(P.ws + AR_YLOC) + (size_t)tok * 256 + g * 128;
    const bf16_t* zp = (const bf16_t*)(P.ws + AR_U) + (size_t)tok * NIN + UC_Z + g * 128;
    float ss = 0.f;
#pragma unroll
    for (int hh = 0; hh < 2; ++hh) { const float ea = __expf(acv[2 * g + hh]);
#pragma unroll
        for (int pb = 0; pb < 2; ++pb)
#pragma unroll
            for (int q = 0; q < 4; ++q) { const int col = hh * 64 + pb * 32 + 8 * q + 4 * hi;
                const u32x2 yv = *(const u32x2*)(yl + col), zv = *(const u32x2*)(zp + col);
                const float yy[4] = {bflo(yv[0]), bfhi(yv[0]), bflo(yv[1]), bfhi(yv[1])}, zz[4] = {bflo(zv[0]), bfhi(zv[0]), bflo(zv[1]), bfhi(zv[1])};
#pragma unroll
                for (int j = 0; j < 4; ++j) { const float v = (acc[hh][pb][4 * q + j] * ea + yy[j]) * siluf_(zz[j]); acc[hh][pb][4 * q + j] = v; ss += v * v; } } }
    ss += __shfl_xor(ss, 32);
    const float rs = rsqrtf(ss * (1.0f / 128.0f) + EPS);
    bf16_t* ym = (bf16_t*)(P.ws + AR_YMIX) + (size_t)tok * 1024 + 512 + g * 128;
#pragma unroll
    for (int hh = 0; hh < 2; ++hh)
#pragma unroll
        for (int pb = 0; pb < 2; ++pb)
#pragma unroll
            for (int q = 0; q < 4; ++q) { const int col = hh * 64 + pb * 32 + 8 * q + 4 * hi;
                *(u32x2*)(ym + col) = (u32x2){pk2(acc[hh][pb][4 * q] * rs, acc[hh][pb][4 * q + 1] * rs), pk2(acc[hh][pb][4 * q + 2] * rs, acc[hh][pb][4 * q + 3] * rs)}; }
}
DI void rowfin_item(const Ctx& P, int item) {
    int tid_ = threadIdx.x & 255; asm volatile("" : "+v"(tid_));
    const int lane = tid_ & 63, wid = tid_ >> 6;
#pragma unroll
    for (int u = 0; u < 4; ++u) {
    const int tok = item * 16 + wid * 4 + u;
    bf16_t* ym = (bf16_t*)(P.ws + AR_YMIX) + (size_t)tok * 1024;
    {
        const u32x4 v = *(const u32x4*)((const bf16_t*)(P.ws + AR_YMLA) + (size_t)tok * 512 + lane * 8);
        float f[8] = {bflo(v[0]), bfhi(v[0]), bflo(v[1]), bfhi(v[1]), bflo(v[2]), bfhi(v[2]), bflo(v[3]), bfhi(v[3])};
        float ss = 0.f;
#pragma unroll
        for (int j = 0; j < 8; ++j) ss += f[j] * f[j];
#pragma unroll
        for (int d = 1; d < 64; d <<= 1) ss += __shfl_xor(ss, d);
        const float rs = rsqrtf(ss * (1.0f / 512.0f) + EPS);
        *(u32x4*)(ym + lane * 8) = (u32x4){pk2(f[0] * rs, f[1] * rs), pk2(f[2] * rs, f[3] * rs), pk2(f[4] * rs, f[5] * rs), pk2(f[6] * rs, f[7] * rs)};
    }
    {
        const int b = tok >> 13, c = (tok & 8191) >> 7, ch = lane * 4;
        const u32x2 hv = *(const u32x2*)((const bf16_t*)(P.ws + AR_HLOC) + (size_t)tok * 256 + ch), av = *(const u32x2*)((const bf16_t*)(P.ws + AR_ACP) + (size_t)tok * 256 + ch);
        const u32x2 gv = *(const u32x2*)((const bf16_t*)(P.ws + AR_U) + (size_t)tok * NIN + UC_GATE + ch);
        const f32x4 hin = *(const f32x4*)((const float*)(P.ws + WS_HIN) + (size_t)(b * 64 + c) * 256 + ch);
        const float hl[4] = {bflo(hv[0]), bfhi(hv[0]), bflo(hv[1]), bfhi(hv[1])}, aa[4] = {bflo(av[0]), bfhi(av[0]), bflo(av[1]), bfhi(av[1])}, gg[4] = {bflo(gv[0]), bfhi(gv[0]), bflo(gv[1]), bfhi(gv[1])};
        float y[4], ss = 0.f;
#pragma unroll
        for (int j = 0; j < 4; ++j) { y[j] = (hl[j] + aa[j] * hin[j]) * gelu_tanh_(gg[j]); ss += y[j] * y[j]; }
#pragma unroll
        for (int d = 1; d < 64; d <<= 1) ss += __shfl_xor(ss, d);
        const float rs = rsqrtf(ss * (1.0f / 256.0f) + EPS);
        *(u32x2*)(ym + 768 + ch) = (u32x2){pk2(y[0] * rs, y[1] * rs), pk2(y[2] * rs, y[3] * rs)};
    }
    }
}

DI void run_phase(const Params& PP, int ph, char* smem, unsigned* sh_item, int rep = 0) {
    int z_; asm volatile("s_mov_b32 %0, 0" : "=s"(z_));
    Ctx P; P.in = PP.in + z_; P.out = PP.out + z_; P.ws = PP.ws + z_;
    const int vb = __builtin_amdgcn_readfirstlane((int)(threadIdx.x >> 8));
    const int bid = (int)blockIdx.x * 2 + vb + z_;
    const int G = (int)gridDim.x * 2;
    const int pb = (int)blockIdx.x + z_, PG = (int)gridDim.x;
    char* const smem_full = smem; smem = smem + vb * VB_LDS;
    unsigned char* ws = P.ws;
    bf16_t* XB = (bf16_t*)(ws + WS_XB);
#if !defined(ONLY) || ONLY == 9
    if (ph == 0) { phase_prologue(P, smem); return; }
#endif
    if (ph == NPHASE - 1) {
        int t_ = threadIdx.x & 255; asm volatile("" : "+v"(t_));
        const int lane = t_ & 63, wid = t_ >> 6; const float* g = P.in[34];
        for (int row = bid * 4 + wid; row < T; row += G * 4) {
            float* xr = P.out + (size_t)row * DM; f32x4 v[4]; float ss = 0.f;
#pragma unroll
            for (int i = 0; i < 4; ++i) { v[i] = *(const f32x4*)(xr + i * 256 + lane * 4); ss += v[i][0] * v[i][0] + v[i][1] * v[i][1] + v[i][2] * v[i][2] + v[i][3] * v[i][3]; }
#pragma unroll
            for (int d = 1; d < 64; d <<= 1) ss += __shfl_xor(ss, d);
            const float rs = rsqrtf(ss * (1.0f / 1024.0f) + EPS);
#pragma unroll
            for (int i = 0; i < 4; ++i) { const f32x4 gv = *(const f32x4*)(g + i * 256 + lane * 4); *(f32x4*)(xr + i * 256 + lane * 4) = (f32x4){v[i][0] * rs * gv[0], v[i][1] * rs * gv[1], v[i][2] * rs * gv[2], v[i][3] * rs * gv[3]}; }
        }
        return;
    }
    const int l = (ph - 1) / 9, st = (ph - 1) % 9;
    const bf16_t* W = (const bf16_t*)(ws + ((l & 1) ? WS_WB1 : WS_WB0));
    switch (st) {
#if !defined(ONLY) || ONLY == 0
    case 0: {
        { EpiP1KV e{EpiP1{(bf16_t*)(ws + AR_U), (float*)(ws + WS_DTRAW), (float*)(ws + WS_PQ), (float*)(ws + WS_PKV)}, (bf16_t*)(ws + WS_KMEM), (bf16_t*)(ws + WS_VMEM)};
          const bf16_t* Wi = W + WO_IN; const bf16_t* Wk = W + WO_MK; const bf16_t* Am = (const bf16_t*)(ws + WS_MEMB) - (size_t)T * 1024; const float* part = (const float*)(ws + WS_PART);
          auto tf = [=](int it) { const int xcd = it & 7, idx = it >> 3;
                                  if (idx < 56) return Tile256{XB, Wi, part, 1024, 1024, 1024, (xcd * 8 + idx / 7) * 256, (idx % 7) * 256, 16, 0, 1.0f / 1024.0f};
                                  const int j = xcd * 2 + (idx - 56); return Tile256{Am, Wk, part, 1024, 1024, 1024, T + ((j >> 2) & 1) * 256, (j >> 3) * 1024 + (j & 3) * 256, 16, 0, 1.0f / 1024.0f}; };
          gemm256_stream(tf, pb, PG, 464, smem_full, e); }
    } break;
#endif
#if !defined(ONLY) || ONLY == 1
    case 1: {
        {
            const int tv = (pb >> 1) * 2 + vb, tvn = (PG >> 1) * 2;
            for (int k = tv; k < 512; k += tvn) { if (pb & 1) lru_local_item(P, l, k, smem); else ssd_local_item(P, l, k, smem); }
        }
        __syncthreads();
        { EpiStage1 e{EpiKV{(bf16_t*)(ws + AR_K), (bf16_t*)(ws + AR_V), (const bf16_t*)(ws + AR_U), (const float*)(ws + WS_COS), (const float*)(ws + WS_SIN)},
                      EpiQ{(bf16_t*)(ws + AR_Q), (const float*)(ws + WS_COS), (const float*)(ws + WS_SIN)}, (bf16_t*)(ws + WS_WQKT), (bf16_t*)(ws + WS_VWOT)};
          const bf16_t* Uq = (const bf16_t*)(ws + AR_U) + UC_CQ; const bf16_t* Ukv = (const bf16_t*)(ws + AR_U) + UC_CKV; const bf16_t* Wq = W + WO_UQ; const bf16_t* Wkv = W + WO_UKV;
          const bf16_t* Km = (const bf16_t*)(ws + WS_KMEM); const bf16_t* Vm = (const bf16_t*)(ws + WS_VMEM); const bf16_t* Wmq = W + WO_MQ; const bf16_t* Wmo = W + WO_MO;
          const float* pq = (const float*)(ws + WS_PQ); const float* pkv = (const float*)(ws + WS_PKV);
          auto tf = [=](int it) {
              if (it < 256) return Tile256{Ukv, Wkv, pkv, NIN, 128, 128, (it >> 2) * 256, (it & 3) * 256, 2, 0, 1.0f / 128.0f};
              if (it < 448) { const int j = it - 256; return Tile256{Uq, Wq, pq, NIN, 256, 256, (j / 3) * 256, (j % 3) * 256, 4, 1, 1.0f / 256.0f}; }
              if (it < 480) { const int j = it - 448, b = j >> 4, h = (j >> 2) & 3, nt = j & 3; return Tile256{Km + h * 256, Wmq + h * 256, nullptr, 1024, 1024, 256, b * 256, nt * 256, 0, 2 | (b << 2) | (h << 3), 0.f}; }
              const int j = it - 480, b = j >> 4, h = (j >> 2) & 3, mt = j & 3; return Tile256{Wmo + h * 256, Vm + (size_t)b * 256 * 1024 + h * 256, nullptr, 1024, 1024, 256, mt * 256, 0, 0, 3 | (b << 2) | (h << 3), 0.f}; };
          gemm256_stream(tf, pb, PG, 512, smem_full, e); }
    } break;
#endif
#if !defined(ONLY) || ONLY == 2
    case 2: {
        carries(P, bid);
        unsigned* ctr = (unsigned*)ws + CW_QUEUE + (l * 8 + (pb & 7)) * 64 + rep * 16;
        for (;;) {
            __syncthreads();
            if (threadIdx.x == 0) *sh_item = atomicAdd(ctr, 1u);
            __syncthreads();
            const unsigned j2 = *sh_item;
            if (j2 >= 64u) break;
            const int pi = 31 - (int)(j2 & 31u), qb = 2 * pi + 1 - vb;
            attn_item((const bf16_t*)(ws + AR_Q), (const bf16_t*)(ws + AR_K), (const bf16_t*)(ws + AR_V), (bf16_t*)(ws + AR_YMLA), (pb & 7) * 2 + (int)(j2 >> 5), qb, 2 * (2 * pi + 2), smem_full, vb);
        }
    } break;
#endif
#if !defined(ONLY) || ONLY == 3
    case 3: {
        for (int it = bid; it < 256 + 1024; it += G) { if (it < 256) ssd_z_item(P, it); else rowfin_item(P, it - 256); }
    } break;
#endif
#if !defined(ONLY) || ONLY == 4
    case 4: {
        EpiResid e{l == 0 ? P.in[0] : P.out, P.out, XB, (float*)(ws + WS_PART)};
        { const bf16_t* Ay = (const bf16_t*)(ws + AR_YMIX); const bf16_t* Wo = W + WO_OUT;
          auto tf = [=](int it) { const int xcd = it & 7, idx = it >> 3, mt = xcd * 8 + (idx >> 2), nt = idx & 3; return Tile256{Ay, Wo, nullptr, 1024, 1024, 1024, mt * 256, nt * 256, 0, 0, 0.f}; };
          gemm256_stream(tf, pb, PG, 256, smem_full, e); }
    } break;
#endif
#if !defined(ONLY) || ONLY == 5
    case 5: {
        { EpiSoftmax256 e{(bf16_t*)(ws + AR_P), (float*)(smem_full + 2 * 65536 + 1024)}; const bf16_t* Wq = (const bf16_t*)(ws + WS_WQKT); const float* part = (const float*)(ws + WS_PART);
          auto tf = [=](int it) { const int xcd = it & 7, idx = it >> 3, mt = xcd * 8 + (idx >> 2), hh = idx & 3; return Tile256{XB, Wq + (size_t)(mt >> 5) * 1048576, part, 1024, 1024, 1024, mt * 256, hh * 256, 16, 0, 1.0f / 1024.0f}; };
          gemm256_stream(tf, pb, PG, 256, smem_full, e); }
    } break;
#endif
#if !defined(ONLY) || ONLY == 6
    case 6: {
        EpiResid e{P.out, P.out, XB, (float*)(ws + WS_PART)};
        { const bf16_t* Ap = (const bf16_t*)(ws + AR_P); const bf16_t* Vw = (const bf16_t*)(ws + WS_VWOT);
          auto tf = [=](int it) { const int xcd = it & 7, idx = it >> 3, mt = xcd * 8 + (idx >> 2), nt = idx & 3; return Tile256{Ap, Vw + (size_t)(mt >> 5) * 1048576, nullptr, 1024, 1024, 1024, mt * 256, nt * 256, 0, 0, 0.f}; };
          gemm256_stream(tf, pb, PG, 256, smem_full, e); }
    } break;
#endif
#if !defined(ONLY) || ONLY == 7
    case 7: {
        EpiRelu2 e{(bf16_t*)(ws + AR_H)};
        { const bf16_t* W1 = W + WO_1; const float* part = (const float*)(ws + WS_PART);
          auto tf = [=](int it) { const int rnd = it >> 8, w = it & 255, xcd = w & 7, idx = w >> 3, mt = rnd * 16 + (xcd >> 1) * 4 + (idx >> 3), nt = (xcd & 1) * 8 + (idx & 7); return Tile256{XB, W1, part, 1024, 1024, 1024, mt * 256, nt * 256, 16, 0, 1.0f / 1024.0f}; };
          gemm256_stream(tf, pb, PG, 1024, smem_full, e); }
    } break;
#endif
#if !defined(ONLY) || ONLY == 8
    case 8: {
        EpiResid e{P.out, P.out, XB, (float*)(ws + WS_PART)};
        { const bf16_t* Ah = (const bf16_t*)(ws + AR_H); const bf16_t* W2 = W + WO_2;
          auto tf = [=](int it) { const int xcd = it & 7, idx = it >> 3, mt = xcd * 8 + (idx >> 2), nt = idx & 3; return Tile256{Ah, W2, nullptr, 4096, 4096, 4096, mt * 256, nt * 256, 0, 0, 0.f}; };
          gemm256_stream(tf, pb, PG, 256, smem_full, e); }
        if (l + 1 < NL) { __syncthreads(); convert_layer_weights(P, l + 1, (float*)smem); }
    } break;
#endif
    }
}

__global__ void __launch_bounds__(512, 2) hymba_mega(Params P, int ph_lo, int ph_hi, int coop) {
    extern __shared__ __attribute__((aligned(16))) char smem[];
    __shared__ unsigned sh_item;
    if (coop) {
        if (threadIdx.x == 0) *(uint4*)(smem + XB_LDS_OFF) = make_uint4(0u, 0u, 0u, 0u);
        __syncthreads();
        (void)xcd_barrier_post((unsigned*)P.ws, (volatile unsigned*)(smem + XB_LDS_OFF));
    }
    for (int ph = ph_lo; ph < ph_hi; ++ph) {
        run_phase(P, ph, smem, &sh_item);
#ifdef REP_ST
        if (ph >= 1 && ph < NPHASE - 1 && (ph - 1) % 9 == REP_ST) { xcd_barrier((unsigned*)P.ws); run_phase(P, ph, smem, &sh_item, 1); }
#endif
        if (coop && ph + 1 < ph_hi) {
            if (ph == ph_lo) cg::this_grid().sync();
            else { xcd_barrier((unsigned*)P.ws);
#ifdef DBL_BAR
                xcd_barrier((unsigned*)P.ws); xcd_barrier((unsigned*)P.ws);
#endif
            }
        }
    }
}

extern "C" void kernel_launch(void* const* d_in, const int* in_sizes, int n_in, void* d_out, int out_size, void* d_ws, size_t ws_size, hipStream_t stream) {
    static int grid = 0;
    if (grid == 0) {
        if (n_in != 35 || out_size != T * DM || ws_size < WS_END) { fprintf(stderr, "kernel_launch: unexpected shapes (n_in %d out %d ws %zu need %zu)\n", n_in, out_size, ws_size, (size_t)WS_END); grid = -1; return; }
        int dev = 0, cus = 0, per_cu = 0;
        hipGetDevice(&dev); hipDeviceGetAttribute(&cus, hipDeviceAttributeMultiprocessorCount, dev);
        if (hipFuncSetAttribute((const void*)hymba_mega, hipFuncAttributeMaxDynamicSharedMemorySize, LDS_BYTES) != hipSuccess) { fprintf(stderr, "kernel_launch: hipFuncSetAttribute failed\n"); grid = -1; return; }
        (void)hipOccupancyMaxActiveBlocksPerMultiprocessor(&per_cu, (const void*)hymba_mega, 512, LDS_BYTES);
        if (per_cu < 1) { fprintf(stderr, "kernel_launch: occupancy query failed\n"); grid = -1; return; }
        if (per_cu > 1) per_cu = 1;
        grid = cus * per_cu;
    }
    if (grid < 0) return;
    hipMemsetAsync((char*)d_ws + WS_CTL, 0, 65536, stream);
    Params p{};
    for (int i = 0; i < 35; ++i) p.in[i] = (const float*)d_in[i];
    p.out = (float*)d_out; p.ws = (unsigned char*)d_ws;
#if MK_MULTI
    for (int ph = 0; ph < NPHASE; ++ph) hipLaunchKernelGGL(hymba_mega, dim3(grid), dim3(512), LDS_BYTES, stream, p, ph, ph + 1, 0);
#else
    int lo = 0, hi = NPHASE, coop = 1;
    void* args[] = {&p, &lo, &hi, &coop};
    hipError_t e = hipLaunchCooperativeKernel((const void*)hymba_mega, dim3(grid), dim3(512), args, LDS_BYTES, stream);
    if (e != hipSuccess) fprintf(stderr, "cooperative launch failed: %s (grid %d)\n", hipGetErrorString(e), grid);
#endif
}
```

```cpp
#include <hip/hip_runtime.h>
#include <hip/hip_cooperative_groups.h>
#include <stdint.h>
#include <stdio.h>
namespace cg = cooperative_groups;

#ifndef MK_MULTI
#define MK_MULTI 0
#endif

#define DI __device__ __forceinline__
#define LAS __attribute__((address_space(3)))
typedef unsigned short bf16_t;
typedef short bf16x8 __attribute__((ext_vector_type(8)));
typedef short s16x4 __attribute__((ext_vector_type(4)));
typedef float f32x16 __attribute__((ext_vector_type(16)));
typedef float f32x4 __attribute__((ext_vector_type(4)));
typedef unsigned u32x4 __attribute__((ext_vector_type(4)));
typedef unsigned u32x2 __attribute__((ext_vector_type(2)));
#define MFMA(a, b, c) __builtin_amdgcn_mfma_f32_32x32x16_bf16((a), (b), (c), 0, 0, 0)

constexpr int T = 16384, SEQ = 8192, DM = 1024, NL = 4;
constexpr int NIN = 1792;
constexpr float EPS = 1e-6f;
constexpr float LOG2E = 1.4426950408889634f;
constexpr int VB_LDS = 78848;
constexpr int XB_LDS_OFF = 2 * VB_LDS;
constexpr int LDS_BYTES = XB_LDS_OFF + 16;
constexpr int NPHASE = 2 + 9 * NL;

constexpr int UC_CQ = 0, UC_CKV = 256, UC_KR = 384, UC_DT = 416, UC_Z = 512, UC_XS = 768, UC_BS = 1024, UC_CS = 1152, UC_XR = 1280, UC_GATE = 1536;

constexpr size_t WO_IN = 0;
constexpr size_t WO_UQ = WO_IN + (size_t)NIN * 1024;
constexpr size_t WO_UKV = WO_UQ + 768 * 256;
constexpr size_t WO_OUT = WO_UKV + 1024 * 128;
constexpr size_t WO_MQ = WO_OUT + 1048576;
constexpr size_t WO_MK = WO_MQ + 1048576;
constexpr size_t WO_MV = WO_MK + 1048576;
constexpr size_t WO_MO = WO_MV + 1048576;
constexpr size_t WO_1 = WO_MO + 1048576;
constexpr size_t WO_2 = WO_1 + 4194304;
constexpr size_t WO_A = WO_2 + 4194304;
constexpr size_t WO_I = WO_A + 16384;
constexpr size_t WB_ELEMS = WO_I + 16384;

constexpr size_t al256(size_t x) { return (x + 255) & ~(size_t)255; }
constexpr size_t WS_CTL = 0;
constexpr size_t WS_WB0 = 65536;
constexpr size_t WS_WB1 = WS_WB0 + al256(WB_ELEMS * 2);
constexpr size_t WS_XB = WS_WB1 + al256(WB_ELEMS * 2);
constexpr size_t WS_MEMB = WS_XB + (size_t)T * 1024 * 2;
constexpr size_t WS_COS = WS_MEMB + 512 * 1024 * 2;
constexpr size_t WS_SIN = WS_COS + (size_t)T * 16 * 4;
constexpr size_t WS_KMEM = WS_SIN + (size_t)T * 16 * 4;
constexpr size_t WS_VMEM = WS_KMEM + 512 * 1024 * 2;
constexpr size_t WS_WQKT = WS_VMEM + 512 * 1024 * 2;
constexpr size_t WS_VWOT = WS_WQKT + 2 * 1048576 * 2;
constexpr size_t WS_DTRAW = WS_VWOT + 2 * 1048576 * 2;
constexpr size_t WS_ACUM = WS_DTRAW + (size_t)T * 16;
constexpr size_t WS_ATOT = WS_ACUM + (size_t)T * 16;
constexpr size_t WS_HEND = WS_ATOT + 4096;
constexpr size_t WS_AEND = WS_HEND + 131072;
constexpr size_t WS_HIN = WS_AEND + 131072;
constexpr size_t WS_PART = WS_HIN + 131072;
constexpr size_t WS_PQ = WS_PART + (size_t)(T + 512) * 64;
constexpr size_t WS_PKV = WS_PQ + (size_t)T * 16;
constexpr size_t WS_ARENA = WS_PKV + (size_t)T * 8;
constexpr size_t AR_U = WS_ARENA;
constexpr size_t AR_Q = AR_U + (size_t)T * NIN * 2;
constexpr size_t AR_K = AR_Q + (size_t)16 * 8192 * 96 * 2;
constexpr size_t AR_V = AR_K + (size_t)16 * 8192 * 96 * 2;
constexpr size_t AR_YMLA = AR_V + (size_t)16 * 8192 * 64 * 2;
constexpr size_t AR_YLOC = AR_YMLA + (size_t)T * 512 * 2;
constexpr size_t AR_STATES = AR_YLOC + (size_t)T * 256 * 2;
constexpr size_t AR_SIN = AR_STATES + (size_t)2 * 64 * 4 * 4096 * 4;
constexpr size_t AR_CC = AR_SIN + (size_t)2 * 64 * 4 * 4096 * 2;
constexpr size_t AR_HLOC = AR_CC + (size_t)T * 128 * 2;
constexpr size_t AR_ACP = AR_HLOC + (size_t)T * 256 * 2;
constexpr size_t WS_END = AR_ACP + (size_t)T * 256 * 2;
constexpr size_t AR_YMIX = AR_Q;
constexpr size_t AR_P = AR_U;
constexpr size_t AR_H = WS_ARENA;
static_assert(AR_H + (size_t)T * 4096 * 2 <= WS_END, "H overlay");
static_assert(AR_YMIX + (size_t)T * 1024 * 2 <= AR_V, "ymix overlay");

#define XB_TMO      128
#define XB_XCNT(j)  (256  + 64 * (j))
#define XB_XSUB(j)  (1280 + 64 * (j))
#define XB_XGEN(j)  (2304 + 64 * (j))
#define XB_TOP      3328
#define XB_TOPGEN   3392
#define XCD_BAR_WORDS 3456
#define XB_SPIN_CAP (1u << 20)
constexpr int CW_QUEUE = 4096;

struct Params {
    const float* in[35];
    float* out;
    unsigned char* ws;
};

struct Ctx { const float* const* in; float* out; unsigned char* ws; };
DI int VBID() { int z_; asm volatile("s_mov_b32 %0, 0" : "=s"(z_)); return (int)blockIdx.x * 2 + (int)(threadIdx.x >> 8) + z_; }
DI int VGRID() { return (int)gridDim.x * 2; }

typedef __bf16 bf16x2_t __attribute__((ext_vector_type(2)));
DI unsigned pk2(float lo, float hi) { const bf16x2_t v = {(__bf16)lo, (__bf16)hi}; return __builtin_bit_cast(unsigned, v); }
DI float bflo(unsigned u) { return __uint_as_float(u << 16); }
DI float bfhi(unsigned u) { return __uint_as_float(u & 0xffff0000u); }
DI float sigmoidf_(float x) { return __builtin_amdgcn_rcpf(1.0f + __expf(-x)); }
DI float softplus_fast(float x) { const float y = __expf(x); const float ser = y * (1.0f - y * (0.5f - y * (0.33333334f - 0.25f * y))); const float lg = __logf(1.0f + y); return x > 15.f ? x : (y < 0.03f ? ser : lg); }
DI float neg_expm1_fast(float x) { const float ser = -x * (1.0f + x * (0.5f + x * (0.16666667f + x * (0.041666668f + x * 0.008333334f)))); const float ex = 1.0f - __expf(x); return x > -0.1f ? ser : ex; }
DI float siluf_(float x) { return x * sigmoidf_(x); }
DI float softplusf_(float x) { return x > 20.f ? x : log1pf(__expf(x)); }
DI float gelu_tanh_(float x) { const float y = 0.7978845608028654f * (x + 0.044715f * x * x * x); const float t = 1.0f - 2.0f / (__expf(2.0f * y) + 1.0f); return 0.5f * x * (1.0f + t); }
DI int crow(int r, int hi) { return (r & 3) + 8 * (r >> 2) + 4 * hi; }
typedef short v4i16_t __attribute__((ext_vector_type(4)));
DI s16x4 tr_read(const char* p) { return __builtin_bit_cast(s16x4, __builtin_amdgcn_ds_read_tr16_b64_v4i16((LAS v4i16_t*)(uintptr_t)(unsigned)(uintptr_t)p)); }
DI bf16x8 cat8(s16x4 lo, s16x4 hi) { return (bf16x8){lo[0], lo[1], lo[2], lo[3], hi[0], hi[1], hi[2], hi[3]}; }

DI void store_pair16(bf16_t* blk, int hi, int k, u32x2 a, u32x2 b) {
    const auto r0 = __builtin_amdgcn_permlane32_swap(a[0], b[0], false, false);
    const auto r1 = __builtin_amdgcn_permlane32_swap(a[1], b[1], false, false);
    *(u32x4*)(blk + 8 * k + 8 * hi) = (u32x4){r0[0], r1[0], r0[1], r1[1]};
}

DI unsigned xb_ld(unsigned* p) { return __hip_atomic_load(p, __ATOMIC_RELAXED, __HIP_MEMORY_SCOPE_AGENT); }
DI unsigned xb_add(unsigned* p, unsigned v) { return __hip_atomic_fetch_add(p, v, __ATOMIC_RELAXED, __HIP_MEMORY_SCOPE_AGENT); }
DI unsigned xb_xcc_id() { return (unsigned)__builtin_amdgcn_s_getreg((3 << 11) | 20) & 0xFu; }
#define XB_SPIN(cond, bar) do { unsigned _sp = 0; while (cond) { __builtin_amdgcn_s_sleep(1); \
    if ((++_sp & 255u) == 0u) { if (xb_ld(&(bar)[XB_TMO])) break; if (_sp > XB_SPIN_CAP) { atomicAdd(&(bar)[XB_TMO], 1u); break; } } } } while (0)
struct XcdBarrier { unsigned* bar; unsigned x; volatile unsigned* st; };
DI XcdBarrier xcd_barrier_post(unsigned* bar, volatile unsigned* st) {
    XcdBarrier b; b.bar = bar; b.x = xb_xcc_id(); b.st = st;
    if (threadIdx.x == 0) (void)xb_add(&bar[XB_XCNT(b.x)], 1u);
    return b;
}
DI void xcd_barrier_complete(unsigned* bar, unsigned x, unsigned& nloc, unsigned& nx) {
    const unsigned G = gridDim.x;
    unsigned sum, cnt, mine, sp = 0u;
    for (;;) {
        sum = 0u; cnt = 0u; mine = 0u;
#pragma unroll
        for (unsigned j = 0; j < 16; ++j) { const unsigned c = xb_ld(&bar[XB_XCNT(j)]); sum += c; cnt += (c > 0u) ? 1u : 0u; mine = (j == x) ? c : mine; }
        if (sum == G) break;
        __builtin_amdgcn_s_sleep(1);
        if ((++sp & 255u) == 0u) { if (xb_ld(&bar[XB_TMO])) break; if (sp > XB_SPIN_CAP) { atomicAdd(&bar[XB_TMO], 1u); break; } }
    }
    nloc = mine > 0u ? mine : 1u; nx = cnt > 0u ? cnt : 1u;
}
DI void xcd_barrier(unsigned* bar_in) {
    extern __shared__ __attribute__((aligned(16))) char dyn_lds_[];
    XcdBarrier b; b.bar = bar_in; b.st = (volatile unsigned*)(dyn_lds_ + XB_LDS_OFF); b.x = xb_xcc_id();
    asm volatile("s_waitcnt vmcnt(0)" ::: "memory");
    __syncthreads();
    if (threadIdx.x == 0) {
        int z_; asm volatile("s_mov_b32 %0, 0" : "=s"(z_));
        unsigned* bar = b.bar + z_;
        __builtin_amdgcn_s_waitcnt(0);
        unsigned nloc = b.st[0], nx = b.st[1];
        if (nloc == 0u) { xcd_barrier_complete(bar, b.x, nloc, nx); b.st[0] = nloc; b.st[1] = nx; }
        const unsigned old = xb_add(&bar[XB_XSUB(b.x)], 1u);
        const unsigned gen = old / nloc;
        if (old + 1u == (gen + 1u) * nloc) {
            __builtin_amdgcn_fence(__ATOMIC_RELEASE, "agent");
            asm volatile("s_waitcnt vmcnt(0)" ::: "memory");
            const unsigned og = xb_add(&bar[XB_TOP], 1u);
            const unsigned tg = og / nx;
            if (og + 1u == (tg + 1u) * nx) xb_add(&bar[XB_TOPGEN], 1u);
            else XB_SPIN(xb_ld(&bar[XB_TOPGEN]) == tg, bar);
            __builtin_amdgcn_fence(__ATOMIC_ACQUIRE, "agent");
            xb_add(&bar[XB_XGEN(b.x)], 1u);
            asm volatile("s_waitcnt vmcnt(0)" ::: "memory");
        } else {
            XB_SPIN(xb_ld(&bar[XB_XGEN(b.x)]) == gen, bar);
            __builtin_amdgcn_fence(__ATOMIC_ACQUIRE, "agent");
            asm volatile("s_waitcnt vmcnt(0)" ::: "memory");
        }
    }
    __syncthreads();
}

template <int WAVES_M, int WAVES_N, int MB, int NB, int NORM_A  , class Epi>
DI void gemm_tile(const bf16_t* __restrict__ A, int lda, const bf16_t* __restrict__ Bt, int ldb, int K, int m0, int n0, char* smem, const Epi& epi, const float* part = nullptr) {
    constexpr int BM = WAVES_M * MB * 32, BN = WAVES_N * NB * 32, LA = BM / 32, LB = BN / 32, RS = 144;
    char* As = smem; char* Bs = smem + BM * RS; float* rsc = (float*)(smem + (BM + BN) * RS);
    int tid_ = threadIdx.x & 255; asm volatile("" : "+v"(tid_));
    const int tid = tid_, lane = tid & 63, wid = tid >> 6, r32 = lane & 31, hi = lane >> 5;
    const int wm = wid / WAVES_N, wn = wid % WAVES_N;
    const int lrow = tid >> 3, lkc = tid & 7;
    const bf16_t* Ap = A + (size_t)(m0 + lrow) * lda + lkc * 8;
    const bf16_t* Bp = Bt + (size_t)(n0 + lrow) * ldb + lkc * 8;
    u32x4 ra[LA], rb[LB]; float ss[LA];
    f32x16 acc[NB][MB];
#pragma unroll
    for (int i = 0; i < LA; ++i) ss[i] = 0.f;
#pragma unroll
    for (int nb = 0; nb < NB; ++nb)
#pragma unroll
        for (int mb = 0; mb < MB; ++mb)
#pragma unroll
            for (int r = 0; r < 16; ++r) acc[nb][mb][r] = 0.f;
#pragma unroll
    for (int i = 0; i < LA; ++i) ra[i] = *(const u32x4*)(Ap + (size_t)i * 32 * lda);
#pragma unroll
    for (int i = 0; i < LB; ++i) rb[i] = *(const u32x4*)(Bp + (size_t)i * 32 * ldb);
    const int nk = K >> 6;
    for (int kt = 0; kt < nk; ++kt) {
        __syncthreads();
#pragma unroll
        for (int i = 0; i < LA; ++i) *(u32x4*)(As + (lrow + 32 * i) * RS + lkc * 16) = ra[i];
#pragma unroll
        for (int i = 0; i < LB; ++i) *(u32x4*)(Bs + (lrow + 32 * i) * RS + lkc * 16) = rb[i];
        if (NORM_A == 1) {
#pragma unroll
            for (int i = 0; i < LA; ++i)
#pragma unroll
                for (int j = 0; j < 4; ++j) { const float a = bflo(ra[i][j]), b = bfhi(ra[i][j]); ss[i] += a * a + b * b; }
        }
        __syncthreads();
        if (kt + 1 < nk) {
            Ap += 64; Bp += 64;
#pragma unroll
            for (int i = 0; i < LA; ++i) ra[i] = *(const u32x4*)(Ap + (size_t)i * 32 * lda);
#pragma unroll
            for (int i = 0; i < LB; ++i) rb[i] = *(const u32x4*)(Bp + (size_t)i * 32 * ldb);
        }
#pragma unroll
        for (int s = 0; s < 4; ++s) {
            bf16x8 af[MB], bfr[NB];
#pragma unroll
            for (int mb = 0; mb < MB; ++mb) af[mb] = *(const bf16x8*)(As + (wm * MB * 32 + mb * 32 + r32) * RS + s * 32 + hi * 16);
#pragma unroll
            for (int nb = 0; nb < NB; ++nb) bfr[nb] = *(const bf16x8*)(Bs + (wn * NB * 32 + nb * 32 + r32) * RS + s * 32 + hi * 16);
#pragma unroll
            for (int nb = 0; nb < NB; ++nb)
#pragma unroll
                for (int mb = 0; mb < MB; ++mb) acc[nb][mb] = MFMA(bfr[nb], af[mb], acc[nb][mb]);
        }
    }
    if (NORM_A == 1) {
#pragma unroll
        for (int i = 0; i < LA; ++i) {
            float s = ss[i]; s += __shfl_xor(s, 1); s += __shfl_xor(s, 2); s += __shfl_xor(s, 4);
            if (lkc == 0) rsc[lrow + 32 * i] = rsqrtf(s / (float)K + EPS);
        }
        __syncthreads();
    }
    if (NORM_A == 2) {
        if (tid < BM) { const float* pp = part + (size_t)(m0 + tid) * 16; const f32x4 a = *(const f32x4*)pp, b = *(const f32x4*)(pp + 4), c = *(const f32x4*)(pp + 8), d = *(const f32x4*)(pp + 12);
            rsc[tid] = rsqrtf((((a[0] + a[1]) + (a[2] + a[3])) + ((b[0] + b[1]) + (b[2] + b[3])) + ((c[0] + c[1]) + (c[2] + c[3])) + ((d[0] + d[1]) + (d[2] + d[3]))) * (1.0f / 1024.0f) + EPS); }
        __syncthreads();
    }
    epi.template run<NB, MB>(acc, m0 + wm * MB * 32, n0 + wn * NB * 32, r32, hi, rsc + wm * MB * 32);
}

DI void glds16(const void* g, unsigned lds_addr) {
    unsigned sv;
    asm volatile("s_mov_b32 %0, m0\n\ts_mov_b32 m0, %2\n\ts_nop 0\n\tglobal_load_lds_dwordx4 %1, off\n\ts_mov_b32 m0, %0" : "=&s"(sv) : "v"(g), "s"(lds_addr) : "memory");
}
template <class E, class = void> struct IsStaged { static constexpr bool v = false; };
template <class E> struct IsStaged<E, decltype((void)E::STAGED)> { static constexpr bool v = E::STAGED; };
struct Tile256 { const bf16_t* A; const bf16_t* Bt; const float* part; int lda, ldb, K, m0, n0, npart, tag; float invk; };
template <class Epi, class TileFn>
DI void gemm256_stream(const TileFn& tf, int it0, int step, int ntiles, char* smem, const Epi& epi) {
    constexpr int MB = 4, NB = 2, BM = 256, STG = 65536, NSEG = 8;
    int tid_ = threadIdx.x; asm volatile("" : "+v"(tid_));
    const int tid = tid_, lane = tid & 63, wid = tid >> 6, r32 = lane & 31, hi = lane >> 5;
    const int wm = wid >> 2, wn = wid & 3;
    const int lr = lane >> 3, cc = lane & 7;
    const unsigned lds0 = (unsigned)(uintptr_t)smem;
    float* rsc = (float*)(smem + 2 * STG);
    int aoff[MB], boff[NB], asw[MB], bsw[NB];
#pragma unroll
    for (int mb = 0; mb < MB; ++mb) { const int r = wm * 128 + mb * 32 + r32; aoff[mb] = r * 128; asw[mb] = (r >> 1) & 7; }
#pragma unroll
    for (int nb = 0; nb < NB; ++nb) { const int r = wn * 64 + nb * 32 + r32; boff[nb] = (BM + r) * 128; bsw[nb] = (r >> 1) & 7; }
#define SRC_OF(T_, j_) ((j_) < 4 ? (T_).A + (size_t)((T_).m0 + 8 * (wid + 8 * (j_)) + lr) * (T_).lda + ((cc ^ (((8 * (wid + 8 * (j_)) + lr) >> 1) & 7)) * 8) \
                                 : (T_).Bt + (size_t)((T_).n0 + 8 * (wid + 8 * (j_)) + lr - BM) * (T_).ldb + ((cc ^ (((8 * (wid + 8 * (j_)) + lr - BM) >> 1) & 7)) * 8))
    bool primed = false;
    for (int it = it0; it < ntiles; it += step) {
        const Tile256 t = tf(it);
        const int nk = t.K >> 6;
        const bf16_t* src[NSEG];
#pragma unroll
        for (int j = 0; j < NSEG; ++j) src[j] = SRC_OF(t, j);
        f32x16 acc[NB][MB];
#pragma unroll
        for (int nb = 0; nb < NB; ++nb)
#pragma unroll
            for (int mb = 0; mb < MB; ++mb)
#pragma unroll
                for (int r = 0; r < 16; ++r) acc[nb][mb][r] = 0.f;
        if (!primed) {
            __syncthreads();
#pragma unroll
            for (int j = 0; j < NSEG; ++j) glds16(src[j], (unsigned)__builtin_amdgcn_readfirstlane((int)(lds0 + (wid + 8 * j) * 1024)));
        }
        float sq = 0.f;
        for (int kt = 0; kt < nk; ++kt) {
            asm volatile("s_waitcnt vmcnt(0)\n\ts_barrier" ::: "memory");
            if (kt == nk - 1 && t.part && tid < BM) {
                const float* pp = t.part + (size_t)(t.m0 + tid) * t.npart;
                for (int i = 0; i < t.npart; i += 2) sq += pp[i] + pp[i + 1]; }
            if (kt + 1 < nk) {
#pragma unroll
                for (int j = 0; j < NSEG; ++j) glds16(src[j] + (size_t)(kt + 1) * 64, (unsigned)__builtin_amdgcn_readfirstlane((int)(lds0 + ((kt + 1) & 1) * STG + (wid + 8 * j) * 1024)));
            } else if (it + step < ntiles) {
                const Tile256 tn = tf(it + step);
#pragma unroll
                for (int j = 0; j < NSEG; ++j) glds16(SRC_OF(tn, j), (unsigned)__builtin_amdgcn_readfirstlane((int)(lds0 + (wid + 8 * j) * 1024)));
                primed = true;
            }
            const char* st = smem + (kt & 1) * STG;
#pragma unroll
            for (int s = 0; s < 4; ++s) {
                bf16x8 af[MB], bfr[NB];
#pragma unroll
                for (int mb = 0; mb < MB; ++mb) af[mb] = *(const bf16x8*)(st + aoff[mb] + (((2 * s + hi) ^ asw[mb]) * 16));
#pragma unroll
                for (int nb = 0; nb < NB; ++nb) bfr[nb] = *(const bf16x8*)(st + boff[nb] + (((2 * s + hi) ^ bsw[nb]) * 16));
#pragma unroll
                for (int nb = 0; nb < NB; ++nb)
#pragma unroll
                    for (int mb = 0; mb < MB; ++mb) acc[nb][mb] = MFMA(bfr[nb], af[mb], acc[nb][mb]);
            }
        }
        if (t.part) {
            if (tid < BM) rsc[tid] = rsqrtf(sq * t.invk + EPS);
            __syncthreads();
        }
        if constexpr (IsStaged<Epi>::v) epi.template run_staged<NB, MB>(acc, t.m0, t.n0, wm, wn, r32, hi, lane, wid, smem + STG);
        else epi.template run<NB, MB>(acc, t.m0 + wm * 128, t.n0 + wn * 64, r32, hi, rsc + wm * 128, t.tag);
        if (t.part) __syncthreads();
    }
#undef SRC_OF
}

struct EpiP1 {
    bf16_t* U; float* dtraw; float* pq; float* pkv;
    template <int NB, int MB> DI void run(f32x16 (&acc)[NB][MB], int mb0, int nb0, int r32, int hi, const float* rs, int tag = 0) const {
#pragma unroll
        for (int mb = 0; mb < MB; ++mb) { const int row = mb0 + mb * 32 + r32; const float sc = rs[mb * 32 + r32]; float ssq = 0.f;
#pragma unroll
            for (int nb = 0; nb < NB; ++nb) { const int cb = nb0 + nb * 32; u32x2 w[4];
#pragma unroll
                for (int g = 0; g < 4; ++g) {
                    const float v0 = acc[nb][mb][4 * g] * sc, v1 = acc[nb][mb][4 * g + 1] * sc, v2 = acc[nb][mb][4 * g + 2] * sc, v3 = acc[nb][mb][4 * g + 3] * sc;
                    w[g] = (u32x2){pk2(v0, v1), pk2(v2, v3)}; ssq += (v0 * v0 + v1 * v1) + (v2 * v2 + v3 * v3);
                    if (cb + 8 * g + 4 * hi == UC_DT) *(f32x4*)(dtraw + (size_t)row * 4) = (f32x4){v0, v1, v2, v3}; }
                bf16_t* blk = U + (size_t)row * NIN + cb;
                store_pair16(blk, hi, 0, w[0], w[1]); store_pair16(blk, hi, 2, w[2], w[3]); }
            if (nb0 < UC_KR) { ssq += __shfl_xor(ssq, 32);
                if (hi == 0) { if (nb0 < UC_CKV) pq[(size_t)row * 4 + (nb0 >> 6)] = ssq; else pkv[(size_t)row * 2 + ((nb0 - UC_CKV) >> 6)] = ssq; } } }
    }
};
struct EpiP1KV {
    EpiP1 p1; bf16_t* kmem; bf16_t* vmem;
    template <int NB, int MB> DI void run(f32x16 (&acc)[NB][MB], int mb0, int nb0, int r32, int hi, const float* rs, int tag = 0) const {
        if (mb0 < T) { p1.template run<NB, MB>(acc, mb0, nb0, r32, hi, rs); return; }
        bf16_t* O = (nb0 >> 10) ? vmem : kmem;
#pragma unroll
        for (int mb = 0; mb < MB; ++mb) { const int row = mb0 - T + mb * 32 + r32; const float sc = rs[mb * 32 + r32];
#pragma unroll
            for (int nb = 0; nb < NB; ++nb) { u32x2 w[4];
#pragma unroll
                for (int g = 0; g < 4; ++g) w[g] = (u32x2){pk2(acc[nb][mb][4 * g] * sc, acc[nb][mb][4 * g + 1] * sc), pk2(acc[nb][mb][4 * g + 2] * sc, acc[nb][mb][4 * g + 3] * sc)};
                bf16_t* blk = O + (size_t)row * 1024 + (nb0 & 1023) + nb * 32;
                store_pair16(blk, hi, 0, w[0], w[1]); store_pair16(blk, hi, 2, w[2], w[3]); } }
    }
};
template <bool USE_RS> struct EpiPlain {
    bf16_t* O; int ld; int row_off, col_off; float scale;
    template <int NB, int MB> DI void run(f32x16 (&acc)[NB][MB], int mb0, int nb0, int r32, int hi, const float* rs, int tag = 0) const {
#pragma unroll
        for (int mb = 0; mb < MB; ++mb) { const int row = mb0 + mb * 32 + r32 + row_off; const float sc = USE_RS ? rs[mb * 32 + r32] * scale : scale;
#pragma unroll
            for (int nb = 0; nb < NB; ++nb)
#pragma unroll
                for (int g = 0; g < 4; ++g) { const int col = nb0 + nb * 32 + 8 * g + 4 * hi + col_off;
                    *(u32x2*)(O + (size_t)row * ld + col) = (u32x2){pk2(acc[nb][mb][4 * g] * sc, acc[nb][mb][4 * g + 1] * sc), pk2(acc[nb][mb][4 * g + 2] * sc, acc[nb][mb][4 * g + 3] * sc)}; } }
    }
};
struct EpiRelu2 {
    bf16_t* H;
    template <int NB, int MB> DI void run(f32x16 (&acc)[NB][MB], int mb0, int nb0, int r32, int hi, const float* rs, int tag = 0) const {
#pragma unroll
        for (int mb = 0; mb < MB; ++mb) { const int row = mb0 + mb * 32 + r32; const float sc = rs[mb * 32 + r32];
#pragma unroll
            for (int nb = 0; nb < NB; ++nb) { u32x2 w[4];
#pragma unroll
                for (int g = 0; g < 4; ++g) { float v[4];
#pragma unroll
                    for (int j = 0; j < 4; ++j) { const float t = fmaxf(acc[nb][mb][4 * g + j] * sc, 0.f); v[j] = t * t; }
                    w[g] = (u32x2){pk2(v[0], v[1]), pk2(v[2], v[3])}; }
                bf16_t* blk = H + (size_t)row * 4096 + nb0 + nb * 32;
                store_pair16(blk, hi, 0, w[0], w[1]); store_pair16(blk, hi, 2, w[2], w[3]); } }
    }
};
struct EpiResid {
    static constexpr bool STAGED = true;
    const float* res; float* out; bf16_t* xb; float* part;
    template <int NB, int MB> DI void run_staged(f32x16 (&acc)[NB][MB], int m0, int n0, int wm, int wn, int r32, int hi, int lane, int wid, char* stage) const {
        asm volatile("s_waitcnt lgkmcnt(0)\n\ts_barrier" ::: "memory");
#pragma unroll 1
        for (int p = 0; p < 4; ++p) {
            const int c = lane & 15; f32x4 rr[4];
#pragma unroll
            for (int q = 0; q < 4; ++q) { const int r = wid * 32 + q * 4 + (lane >> 4); rr[q] = *(const f32x4*)(res + (size_t)(m0 + r) * DM + n0 + 64 * p + 4 * c); }
            if (wn == p) {
#pragma unroll
                for (int mb = 0; mb < MB; ++mb) { const int r = wm * 128 + mb * 32 + r32;
#pragma unroll
                    for (int nb = 0; nb < NB; ++nb)
#pragma unroll
                        for (int g = 0; g < 4; ++g) { const int cc = nb * 8 + 2 * g + hi;
                            *(f32x4*)(stage + r * 256 + ((cc ^ (r & 15)) * 16)) = (f32x4){acc[nb][mb][4 * g], acc[nb][mb][4 * g + 1], acc[nb][mb][4 * g + 2], acc[nb][mb][4 * g + 3]}; } }
            }
            asm volatile("s_waitcnt lgkmcnt(0)\n\ts_barrier" ::: "memory");
#pragma unroll 1
            for (int hq = 0; hq < 2; ++hq) {
                if (hq) {
#pragma unroll
                    for (int q = 0; q < 4; ++q) { const int r = wid * 32 + (4 + q) * 4 + (lane >> 4); rr[q] = *(const f32x4*)(res + (size_t)(m0 + r) * DM + n0 + 64 * p + 4 * c); }
                }
#pragma unroll
                for (int q = 0; q < 4; ++q) { const int r = wid * 32 + (4 * hq + q) * 4 + (lane >> 4); const size_t o = (size_t)(m0 + r) * DM + n0 + 64 * p + 4 * c;
                    f32x4 v = *(const f32x4*)(stage + r * 256 + ((c ^ (r & 15)) * 16));
                    v[0] += rr[q][0]; v[1] += rr[q][1]; v[2] += rr[q][2]; v[3] += rr[q][3];
                    *(f32x4*)(out + o) = v; *(u32x2*)(xb + o) = (u32x2){pk2(v[0], v[1]), pk2(v[2], v[3])};
                    float ssq = (v[0] * v[0] + v[1] * v[1]) + (v[2] * v[2] + v[3] * v[3]);
                    ssq += __shfl_xor(ssq, 1); ssq += __shfl_xor(ssq, 2); ssq += __shfl_xor(ssq, 4); ssq += __shfl_xor(ssq, 8);
                    if (c == 0) part[(size_t)(m0 + r) * 16 + (n0 >> 6) + p] = ssq; }
            }
            asm volatile("s_waitcnt lgkmcnt(0)\n\ts_barrier" ::: "memory");
        }
    }
    template <int NB, int MB> DI void run(f32x16 (&acc)[NB][MB], int mb0, int nb0, int r32, int hi, const float*, int tag = 0) const {
#pragma unroll
        for (int mb = 0; mb < MB; ++mb) { const int row = mb0 + mb * 32 + r32; float ssq = 0.f;
#pragma unroll
            for (int nb = 0; nb < NB; ++nb)
                { u32x2 w[4];
#pragma unroll
                for (int g = 0; g < 4; ++g) { const int col = nb0 + nb * 32 + 8 * g + 4 * hi; const size_t o = (size_t)row * DM + col;
                    f32x4 v = *(const f32x4*)(res + o);
                    v[0] += acc[nb][mb][4 * g]; v[1] += acc[nb][mb][4 * g + 1]; v[2] += acc[nb][mb][4 * g + 2]; v[3] += acc[nb][mb][4 * g + 3];
                    *(f32x4*)(out + o) = v; ssq += (v[0] * v[0] + v[1] * v[1]) + (v[2] * v[2] + v[3] * v[3]);
                    w[g] = (u32x2){pk2(v[0], v[1]), pk2(v[2], v[3])}; }
                bf16_t* blk = xb + (size_t)row * DM + nb0 + nb * 32;
                store_pair16(blk, hi, 0, w[0], w[1]); store_pair16(blk, hi, 2, w[2], w[3]); }
            ssq += __shfl_xor(ssq, 32);
            if (hi == 0) part[(size_t)row * 16 + (nb0 >> 6)] = ssq; }
    }
};
struct EpiSoftmax {
    bf16_t* P; float* xch;
    template <int NB, int MB> DI void run(f32x16 (&acc)[NB][MB], int mb0, int nb0, int r32, int hi, const float* rs, int tag = 0) const {
        const int row = mb0 + r32; const float sc = rs[r32]; const int wm = (mb0 >> 5) & 1, wn = (nb0 >> 7) & 1;
        float m = -3.0e38f;
#pragma unroll
        for (int nb = 0; nb < NB; ++nb)
#pragma unroll
            for (int r = 0; r < 16; ++r) { acc[nb][0][r] *= sc; m = fmaxf(m, acc[nb][0][r]); }
        m = fmaxf(m, __shfl_xor(m, 32));
        if (hi == 0) xch[(wm * 2 + wn) * 32 + r32] = m;
        __syncthreads();
        m = fmaxf(m, xch[(wm * 2 + (wn ^ 1)) * 32 + r32]);
        float s = 0.f;
#pragma unroll
        for (int nb = 0; nb < NB; ++nb)
#pragma unroll
            for (int r = 0; r < 16; ++r) { const float p = __builtin_amdgcn_exp2f(acc[nb][0][r] - m); acc[nb][0][r] = p; s += p; }
        s += __shfl_xor(s, 32);
        if (hi == 0) xch[128 + (wm * 2 + wn) * 32 + r32] = s;
        __syncthreads();
        s += xch[128 + (wm * 2 + (wn ^ 1)) * 32 + r32];
        const float inv = 1.0f / s;
#pragma unroll
        for (int nb = 0; nb < NB; ++nb)
#pragma unroll
            for (int g = 0; g < 4; ++g) { const int col = nb0 + nb * 32 + 8 * g + 4 * hi;
                *(u32x2*)(P + (size_t)row * DM + col) = (u32x2){pk2(acc[nb][0][4 * g] * inv, acc[nb][0][4 * g + 1] * inv), pk2(acc[nb][0][4 * g + 2] * inv, acc[nb][0][4 * g + 3] * inv)}; }
    }
};
struct EpiSoftmax256 {
    bf16_t* P; float* xch;
    template <int NB, int MB> DI void run(f32x16 (&acc)[NB][MB], int mb0, int nb0, int r32, int hi, const float* rs, int tag = 0) const {
        const int wn = (nb0 >> 6) & 3, lr0 = (mb0 & 255) + r32;
#pragma unroll
        for (int mb = 0; mb < MB; ++mb) { const float sc = rs[mb * 32 + r32]; float m = -3.0e38f;
#pragma unroll
            for (int nb = 0; nb < NB; ++nb)
#pragma unroll
                for (int r = 0; r < 16; ++r) { acc[nb][mb][r] *= sc; m = fmaxf(m, acc[nb][mb][r]); }
            m = fmaxf(m, __shfl_xor(m, 32));
            if (hi == 0) xch[(lr0 + mb * 32) * 4 + wn] = m; }
        __syncthreads();
#pragma unroll
        for (int mb = 0; mb < MB; ++mb) { const f32x4 mm = *(const f32x4*)(xch + (lr0 + mb * 32) * 4); const float m = fmaxf(fmaxf(mm[0], mm[1]), fmaxf(mm[2], mm[3])); float sm = 0.f;
#pragma unroll
            for (int nb = 0; nb < NB; ++nb)
#pragma unroll
                for (int r = 0; r < 16; ++r) { const float p = __builtin_amdgcn_exp2f(acc[nb][mb][r] - m); acc[nb][mb][r] = p; sm += p; }
            sm += __shfl_xor(sm, 32);
            if (hi == 0) xch[1024 + (lr0 + mb * 32) * 4 + wn] = sm; }
        __syncthreads();
#pragma unroll
        for (int mb = 0; mb < MB; ++mb) { const f32x4 sv = *(const f32x4*)(xch + 1024 + (lr0 + mb * 32) * 4); const float inv = __builtin_amdgcn_rcpf((sv[0] + sv[1]) + (sv[2] + sv[3]));
            const int row = mb0 + mb * 32 + r32;
#pragma unroll
            for (int nb = 0; nb < NB; ++nb) { u32x2 w[4];
#pragma unroll
                for (int g = 0; g < 4; ++g) w[g] = (u32x2){pk2(acc[nb][mb][4 * g] * inv, acc[nb][mb][4 * g + 1] * inv), pk2(acc[nb][mb][4 * g + 2] * inv, acc[nb][mb][4 * g + 3] * inv)};
                bf16_t* blk = P + (size_t)row * DM + nb0 + nb * 32;
                store_pair16(blk, hi, 0, w[0], w[1]); store_pair16(blk, hi, 2, w[2], w[3]); } }
    }
};
constexpr float QSCALE = 0.10206207261596575f * LOG2E;
struct EpiQ {
    bf16_t* Q; const float* cs; const float* sn;
    template <int NB, int MB> DI void run(f32x16 (&acc)[NB][MB], int mb0, int nb0, int r32, int hi, const float* rs, int tag = 0) const {
#pragma unroll
        for (int mb = 0; mb < MB; ++mb) { const int row = mb0 + mb * 32 + r32; const float sc = rs[mb * 32 + r32] * QSCALE; const int b = row >> 13, s = row & 8191;
#pragma unroll
            for (int nb = 0; nb < NB; ++nb) { const int cb = nb0 + nb * 32; const int h = cb / 96, d0 = cb - h * 96;
                float v[16];
#pragma unroll
                for (int r = 0; r < 16; ++r) v[r] = acc[nb][mb][r] * sc;
                if (d0 == 64) {
#pragma unroll
                    for (int g = 0; g < 2; ++g) { const f32x4 c = *(const f32x4*)(cs + (size_t)row * 16 + 8 * g + 4 * hi), sv = *(const f32x4*)(sn + (size_t)row * 16 + 8 * g + 4 * hi);
#pragma unroll
                        for (int j = 0; j < 4; ++j) { const float x1 = v[4 * g + j], x2 = v[4 * (g + 2) + j]; v[4 * g + j] = x1 * c[j] - x2 * sv[j]; v[4 * (g + 2) + j] = x2 * c[j] + x1 * sv[j]; } }
                }
                bf16_t* qp = Q + ((size_t)(b * 8 + h) * SEQ + s) * 96 + d0 + 4 * hi;
#pragma unroll
                for (int g = 0; g < 4; ++g) *(u32x2*)(qp + 8 * g) = (u32x2){pk2(v[4 * g], v[4 * g + 1]), pk2(v[4 * g + 2], v[4 * g + 3])}; } }
    }
};
struct EpiKV {
    bf16_t* Kimg; bf16_t* Vimg; const bf16_t* U; const float* cs; const float* sn;
    template <int NB, int MB> DI void run(f32x16 (&acc)[NB][MB], int mb0, int nb0, int r32, int hi, const float* rs, int tag = 0) const {
        const int h = nb0 >> 7, isv = (nb0 >> 6) & 1;
#pragma unroll
        for (int mb = 0; mb < MB; ++mb) { const int row = mb0 + mb * 32 + r32; const float sc = rs[mb * 32 + r32]; const int b = row >> 13, s = row & 8191, tile = s >> 6, rin = s & 63;
            const size_t tb = (size_t)(b * 8 + h) * 128 + tile;
#pragma unroll
            for (int nb = 0; nb < NB; ++nb)
#pragma unroll
                for (int g = 0; g < 4; ++g) { const u32x2 w = (u32x2){pk2(acc[nb][mb][4 * g] * sc, acc[nb][mb][4 * g + 1] * sc), pk2(acc[nb][mb][4 * g + 2] * sc, acc[nb][mb][4 * g + 3] * sc)};
                    if (!isv) *(u32x2*)(Kimg + (tb * 12 + nb * 4 + g) * 512 + rin * 8 + 4 * hi) = w;
                    else *(u32x2*)(Vimg + (tb * 2 + nb) * 2048 + rin * 32 + 8 * g + 4 * hi) = w; }
            if (!isv) {
                const u32x4 a = *(const u32x4*)(U + (size_t)row * NIN + UC_KR + 8 * hi), bq = *(const u32x4*)(U + (size_t)row * NIN + UC_KR + 16 + 8 * hi);
                unsigned w1[4], w2[4];
#pragma unroll
                for (int p = 0; p < 2; ++p) {
                    const f32x4 c = *(const f32x4*)(cs + (size_t)row * 16 + 8 * hi + 4 * p), sv = *(const f32x4*)(sn + (size_t)row * 16 + 8 * hi + 4 * p);
                    const float x1a = bflo(a[2 * p]), x1b = bfhi(a[2 * p]), x1c = bflo(a[2 * p + 1]), x1d = bfhi(a[2 * p + 1]);
                    const float x2a = bflo(bq[2 * p]), x2b = bfhi(bq[2 * p]), x2c = bflo(bq[2 * p + 1]), x2d = bfhi(bq[2 * p + 1]);
                    w1[2 * p] = pk2(x1a * c[0] - x2a * sv[0], x1b * c[1] - x2b * sv[1]); w1[2 * p + 1] = pk2(x1c * c[2] - x2c * sv[2], x1d * c[3] - x2d * sv[3]);
                    w2[2 * p] = pk2(x2a * c[0] + x1a * sv[0], x2b * c[1] + x1b * sv[1]); w2[2 * p + 1] = pk2(x2c * c[2] + x1c * sv[2], x2d * c[3] + x1d * sv[3]);
                }
                *(u32x4*)(Kimg + (tb * 12 + 8 + hi) * 512 + rin * 8) = (u32x4){w1[0], w1[1], w1[2], w1[3]};
                *(u32x4*)(Kimg + (tb * 12 + 10 + hi) * 512 + rin * 8) = (u32x4){w2[0], w2[1], w2[2], w2[3]};
            } }
    }
};

struct EpiStage1 {
    EpiKV kv; EpiQ q; bf16_t* wqkt; bf16_t* vwot;
    template <int NB, int MB> DI void run(f32x16 (&acc)[NB][MB], int mb0, int nb0, int r32, int hi, const float* rs, int tag = 0) const {
        const int kind = tag & 3, b = (tag >> 2) & 1, h = (tag >> 3) & 3;
        if (kind == 0) kv.template run<NB, MB>(acc, mb0, nb0, r32, hi, rs);
        else if (kind == 1) q.template run<NB, MB>(acc, mb0, nb0, r32, hi, rs);
        else if (kind == 2) { EpiPlain<false> e{wqkt + (size_t)b * 1048576, 1024, h * 256 - b * 256, 0, 0.0625f * LOG2E}; e.template run<NB, MB>(acc, mb0, nb0, r32, hi, rs); }
        else { EpiPlain<false> e{vwot + (size_t)b * 1048576, 1024, 0, h * 256, 1.0f}; e.template run<NB, MB>(acc, mb0, nb0, r32, hi, rs); }
    }
};

DI void convT_tiles(const float* __restrict__ src, int srcld, int K, int N, bf16_t* __restrict__ dst, int dstld, const float* __restrict__ gain, float* tl, int& base) {
    int tid_ = threadIdx.x & 255; asm volatile("" : "+v"(tid_));
    const int G = VGRID(), tid = tid_; const int tn = (N + 63) >> 6, tiles = (K >> 6) * tn;
    int start = (VBID() - base) % G; if (start < 0) start += G;
    const int niter = (tiles + G - 1) / G;
    for (int itr = 0; itr < niter; ++itr) {
        const int t = start + itr * G; const bool valid = t < tiles;
        const int k0 = valid ? (t / tn) * 64 : 0, n0 = valid ? (t % tn) * 64 : 0;
        __syncthreads();
        if (valid) {
#pragma unroll
        for (int i = 0; i < 4; ++i) { const int k = (tid >> 4) + 16 * i, nn = (tid & 15) * 4; const float g = gain ? gain[k0 + k] : 1.0f;
            f32x4 v = (f32x4){0.f, 0.f, 0.f, 0.f};
            if (n0 + nn + 3 < N) v = *(const f32x4*)(src + (size_t)(k0 + k) * srcld + n0 + nn);
            tl[k * 65 + nn] = v[0] * g; tl[k * 65 + nn + 1] = v[1] * g; tl[k * 65 + nn + 2] = v[2] * g; tl[k * 65 + nn + 3] = v[3] * g; }
        }
        __syncthreads();
        const int n = tid >> 2, ks = (tid & 3) * 16;
        if (valid && n0 + n < N) { unsigned w[8];
#pragma unroll
            for (int q = 0; q < 8; ++q) w[q] = pk2(tl[(ks + 2 * q) * 65 + n], tl[(ks + 2 * q + 1) * 65 + n]);
            bf16_t* d = dst + (size_t)(n0 + n) * dstld + k0 + ks;
            *(u32x4*)d = (u32x4){w[0], w[1], w[2], w[3]}; *(u32x4*)(d + 8) = (u32x4){w[4], w[5], w[6], w[7]}; }
    }
    base = (base + tiles) % G;
}
DI void convert_layer_weights(const Ctx& P, int l, float* tl) {
    bf16_t* W = (bf16_t*)(P.ws + ((l & 1) ? WS_WB1 : WS_WB0));
    int base = 0;
    const float* w_in = P.in[4] + (size_t)l * 1024 * 1700; const float* g_mix = P.in[3] + l * 1024;
    const int seg_src[10] = {0, 256, 384, 1184, 416, 672, 928, 1056, 1188, 1444};
    const int seg_w[10] = {256, 128, 32, 4, 256, 256, 128, 128, 256, 256};
    const int seg_dst[10] = {UC_CQ, UC_CKV, UC_KR, UC_DT, UC_Z, UC_XS, UC_BS, UC_CS, UC_XR, UC_GATE};
#pragma unroll
    for (int s = 0; s < 10; ++s) convT_tiles(w_in + seg_src[s], 1700, 1024, seg_w[s], W + WO_IN + (size_t)seg_dst[s] * 1024, 1024, g_mix, tl, base);
    {
        const size_t n = (size_t)92 * 1024 / 8; u32x4* z = (u32x4*)(W + WO_IN + (size_t)420 * 1024);
        int t_ = threadIdx.x & 255; asm volatile("" : "+v"(t_));
        for (size_t i = (size_t)VBID() * 256 + t_; i < n; i += (size_t)VGRID() * 256) z[i] = (u32x4){0u, 0u, 0u, 0u};
    }
    convT_tiles(P.in[7] + (size_t)l * 256 * 768, 768, 256, 768, W + WO_UQ, 256, P.in[5] + l * 256, tl, base);
    convT_tiles(P.in[8] + (size_t)l * 128 * 1024, 1024, 128, 1024, W + WO_UKV, 128, P.in[6] + l * 128, tl, base);
    convT_tiles(P.in[24] + (size_t)l * 1048576, 1024, 512, 1024, W + WO_OUT, 1024, P.in[9] + l * 512, tl, base);
    convT_tiles(P.in[24] + (size_t)l * 1048576 + (size_t)512 * 1024, 1024, 256, 1024, W + WO_OUT + 512, 1024, P.in[15] + l * 256, tl, base);
    convT_tiles(P.in[24] + (size_t)l * 1048576 + (size_t)768 * 1024, 1024, 256, 1024, W + WO_OUT + 768, 1024, P.in[23] + l * 256, tl, base);
    convT_tiles(P.in[28] + (size_t)l * 1048576, 1024, 1024, 1024, W + WO_MK, 1024, P.in[26] + l * 1024, tl, base);
    convT_tiles(P.in[29] + (size_t)l * 1048576, 1024, 1024, 1024, W + WO_MV, 1024, P.in[26] + l * 1024, tl, base);
    convT_tiles(P.in[30] + (size_t)l * 1048576, 1024, 1024, 1024, W + WO_MO, 1024, nullptr, tl, base);
    convT_tiles(P.in[32] + (size_t)l * 4194304, 4096, 1024, 4096, W + WO_1, 1024, P.in[31] + l * 1024, tl, base);
    convT_tiles(P.in[33] + (size_t)l * 4194304, 1024, 4096, 1024, W + WO_2, 4096, nullptr, tl, base);
    for (int n = 0; n < 4; ++n) {
        convT_tiles(P.in[18] + (size_t)(l * 4 + n) * 4096, 64, 64, 64, W + WO_A + n * 4096, 64, nullptr, tl, base);
        convT_tiles(P.in[20] + (size_t)(l * 4 + n) * 4096, 64, 64, 64, W + WO_I + n * 4096, 64, nullptr, tl, base);
    }
    {
        const float* src = P.in[27] + (size_t)l * 1048576; const float* g = P.in[25] + l * 1024; bf16_t* d = W + WO_MQ;
        int t_ = threadIdx.x & 255; asm volatile("" : "+v"(t_));
        for (size_t i = (size_t)VBID() * 256 + t_; i < 131072; i += (size_t)VGRID() * 256) {
            const float gg = g[i >> 7]; const f32x4 a = *(const f32x4*)(src + i * 8), b = *(const f32x4*)(src + i * 8 + 4);
            *(u32x4*)(d + i * 8) = (u32x4){pk2(a[0] * gg, a[1] * gg), pk2(a[2] * gg, a[3] * gg), pk2(b[0] * gg, b[1] * gg), pk2(b[2] * gg, b[3] * gg)}; }
    }
}
DI void phase_prologue(const Ctx& P, char* smem) {
    convert_layer_weights(P, 0, (float*)smem);
    int t_ = threadIdx.x & 255; asm volatile("" : "+v"(t_));
    const size_t gt = (size_t)VBID() * 256 + t_, gs = (size_t)VGRID() * 256;
    {   const float* x = P.in[0]; bf16_t* xb = (bf16_t*)(P.ws + WS_XB); float* part = (float*)(P.ws + WS_PART);
        const int lane = t_ & 63, wid = t_ >> 6;
        for (int row = VBID() * 4 + wid; row < T; row += VGRID() * 4) { float ss = 0.f;
#pragma unroll
            for (int i = 0; i < 4; ++i) { const size_t o = (size_t)row * DM + i * 256 + lane * 4; const f32x4 a = *(const f32x4*)(x + o);
                ss += (a[0] * a[0] + a[1] * a[1]) + (a[2] * a[2] + a[3] * a[3]); *(u32x2*)(xb + o) = (u32x2){pk2(a[0], a[1]), pk2(a[2], a[3])}; }
#pragma unroll
            for (int d = 1; d < 64; d <<= 1) ss += __shfl_xor(ss, d);
            if (lane < 16) part[(size_t)row * 16 + lane] = lane == 0 ? ss : 0.f; } }
    {   const float* x = P.in[1]; bf16_t* xb = (bf16_t*)(P.ws + WS_MEMB); float* part = (float*)(P.ws + WS_PART) + (size_t)T * 16;
        const int lane = t_ & 63, wid = t_ >> 6;
        for (int row = VBID() * 4 + wid; row < 512; row += VGRID() * 4) { float ss = 0.f;
#pragma unroll
            for (int i = 0; i < 4; ++i) { const size_t o = (size_t)row * DM + i * 256 + lane * 4; const f32x4 a = *(const f32x4*)(x + o);
                ss += (a[0] * a[0] + a[1] * a[1]) + (a[2] * a[2] + a[3] * a[3]); *(u32x2*)(xb + o) = (u32x2){pk2(a[0], a[1]), pk2(a[2], a[3])}; }
#pragma unroll
            for (int d = 1; d < 64; d <<= 1) ss += __shfl_xor(ss, d);
            if (lane < 16) part[(size_t)row * 16 + lane] = lane == 0 ? ss : 0.f; } }
    {   const int* pos = (const int*)P.in[2]; float* cs = (float*)(P.ws + WS_COS); float* sn = (float*)(P.ws + WS_SIN);
        for (size_t i = gt; i < (size_t)T * 16; i += gs) { const int tok = (int)(i >> 4), f = (int)(i & 15);
            const float inv = exp2f(-(float)f * (0.0625f * 13.287712379549449f));       const float ang = (float)pos[tok] * inv;
            double a = (double)ang; a -= 6.283185307179586 * rint(a * 0.15915494309189535);
            const float ar = (float)a; cs[i] = __cosf(ar); sn[i] = __sinf(ar); } }
}

DI void attn_item(const bf16_t* __restrict__ Q, const bf16_t* __restrict__ Kimg, const bf16_t* __restrict__ Vimg, bf16_t* __restrict__ Y, int bh, int qblk, int NTC, char* smem, int vb) {
    int tid_ = threadIdx.x & 255; asm volatile("" : "+v"(tid_));
    const int tid = tid_, lane = tid & 63, wid = tid >> 6, r32 = lane & 31, hi = lane >> 5;
    char* Kb = smem; char* Vb = smem + 36864; float* wsf = (float*)(smem + 61440 + vb * 17408) + wid * 64; bf16_t* stg = (bf16_t*)(smem + 61440 + vb * 17408 + 1024) + wid * 2048;
    const int gw = vb * 4 + wid;
    const int q0 = qblk * 128, NT = 2 * (qblk + 1);
    const int qrow = q0 + wid * 32 + r32;
    bf16x8 qr[6];
    { const bf16_t* qp = Q + ((size_t)bh * SEQ + qrow) * 96 + 8 * hi;
#pragma unroll
      for (int d0 = 0; d0 < 6; ++d0) qr[d0] = *(const bf16x8*)(qp + 16 * d0); }
    const bf16_t* kg = Kimg + (size_t)bh * 128 * 6144 + gw * 512 + lane * 8;
    const bf16_t* vg = Vimg + (size_t)bh * 128 * 4096 + gw * 512 + lane * 8;
    const unsigned ldsK = (unsigned)(uintptr_t)Kb + gw * 1024, ldsV = (unsigned)(uintptr_t)Vb + gw * 1024;
#define ATT_ISSUE(tt, st_) do { \
        glds16(kg + (size_t)(tt) * 6144, (unsigned)__builtin_amdgcn_readfirstlane((int)(ldsK + (st_) * 12288))); \
        if (gw < 4) glds16(kg + (size_t)(tt) * 6144 + 4096, (unsigned)__builtin_amdgcn_readfirstlane((int)(ldsK + (st_) * 12288 + 8192))); \
        glds16(vg + (size_t)(tt) * 4096, (unsigned)__builtin_amdgcn_readfirstlane((int)(ldsV + (st_) * 8192))); } while (0)
    __syncthreads();
    ATT_ISSUE(0, 0); ATT_ISSUE(1, 1);
    int sc = 0, s1 = 1, sn = 2;
    f32x16 o0, o1;
#pragma unroll
    for (int r = 0; r < 16; ++r) { o0[r] = 0.f; o1[r] = 0.f; }
    float lsum = 0.f;
    f32x16 negm;
#pragma unroll
    for (int r = 0; r < 16; ++r) negm[r] = 0.f;
    const char* vrd0 = Vb + ((lane >> 4) & 1) * 32 + (lane & 3) * 8 + (4 * hi + ((lane & 15) >> 2)) * 64;
#define ATT_QK(S0_, S1_, stg_) do { const char* kb_ = Kb + (stg_) * 12288 + r32 * 16; \
        { const bf16x8 k0 = *(const bf16x8*)(kb_ + hi * 1024), k1 = *(const bf16x8*)(kb_ + hi * 1024 + 512); S0_ = MFMA(k0, qr[0], negm); S1_ = MFMA(k1, qr[0], negm); } \
        _Pragma("unroll") for (int d0 = 1; d0 < 6; ++d0) { const bf16x8 k0 = *(const bf16x8*)(kb_ + (2 * d0 + hi) * 1024), k1 = *(const bf16x8*)(kb_ + (2 * d0 + hi) * 1024 + 512); \
            S0_ = MFMA(k0, qr[d0], S0_); S1_ = MFMA(k1, qr[d0], S1_); } } while (0)
#define MX3_(a, b, c) __builtin_fmaxf(__builtin_fmaxf((a), (b)), (c))
#define ATT_STEP(A0, A1, B0, B1, tt_) do { const int t = (tt_); \
        if (t + 1 < NTC) asm volatile("s_waitcnt vmcnt(0)\n\ts_barrier" ::: "memory");       \
        if (t + 2 < NTC) ATT_ISSUE(t + 2, sn); \
        const bool actN = (t + 1 < NT) && !(t + 1 == NT - 1 && wid < 2);                       \
        if (actN) ATT_QK(B0, B1, s1); \
        const bool actT = (t < NT) && !(t == NT - 1 && wid < 2); \
        if (actT) { \
            if (t >= NT - 2) { const int kbase = t * 64 + 4 * hi; \
                _Pragma("unroll") for (int r = 0; r < 16; ++r) { const int kv = kbase + (r & 3) + 8 * (r >> 2); if (kv > qrow) A0[r] = -INFINITY; if (kv + 32 > qrow) A1[r] = -INFINITY; } } \
            float ra_ = MX3_(A0[0], A0[1], A1[0]), rb_ = MX3_(A0[2], A0[3], A1[1]); ra_ = MX3_(ra_, A1[2], A1[3]); \
            _Pragma("unroll") for (int r = 4; r < 16; r += 4) { ra_ = MX3_(ra_, A0[r], A0[r + 1]); rb_ = MX3_(rb_, A0[r + 2], A0[r + 3]); ra_ = MX3_(ra_, A1[r], A1[r + 1]); rb_ = MX3_(rb_, A1[r + 2], A1[r + 3]); } \
            float rm = fmaxf(ra_, rb_); rm = fmaxf(rm, __shfl_xor(rm, 32));                    \
            const bool first = (t == 0);                                                       \
            if (first || __any(rm > 8.0f)) { \
                const float dl = first ? rm : fmaxf(rm, 0.f); const float f = __builtin_amdgcn_exp2f(-dl); lsum *= f; \
                if (hi == 0) wsf[r32] = f; \
                asm volatile("s_waitcnt lgkmcnt(0)" ::: "memory"); \
                _Pragma("unroll") for (int g = 0; g < 4; ++g) { const f32x4 fv = *(const f32x4*)(wsf + 8 * g + 4 * hi); \
                    _Pragma("unroll") for (int j = 0; j < 4; ++j) { o0[4 * g + j] *= fv[j]; o1[4 * g + j] *= fv[j]; } } \
                const float nm = negm[0] - dl; \
                _Pragma("unroll") for (int r = 0; r < 16; ++r) { A0[r] -= dl; A1[r] -= dl; negm[r] = nm; } \
                if (actN) { _Pragma("unroll") for (int r = 0; r < 16; ++r) { B0[r] -= dl; B1[r] -= dl; } }     \
            } \
            float ps = 0.f; \
            _Pragma("unroll") for (int r = 0; r < 16; ++r) { A0[r] = __builtin_amdgcn_exp2f(A0[r]); A1[r] = __builtin_amdgcn_exp2f(A1[r]); ps += A0[r] + A1[r]; } \
            lsum += ps; \
            bf16x8 pw[4]; \
            { u32x4 w; \
              w = (u32x4){pk2(A0[0], A0[1]), pk2(A0[2], A0[3]), pk2(A0[4], A0[5]), pk2(A0[6], A0[7])}; pw[0] = __builtin_bit_cast(bf16x8, w); \
              w = (u32x4){pk2(A0[8], A0[9]), pk2(A0[10], A0[11]), pk2(A0[12], A0[13]), pk2(A0[14], A0[15])}; pw[1] = __builtin_bit_cast(bf16x8, w); \
              w = (u32x4){pk2(A1[0], A1[1]), pk2(A1[2], A1[3]), pk2(A1[4], A1[5]), pk2(A1[6], A1[7])}; pw[2] = __builtin_bit_cast(bf16x8, w); \
              w = (u32x4){pk2(A1[8], A1[9]), pk2(A1[10], A1[11]), pk2(A1[12], A1[13]), pk2(A1[14], A1[15])}; pw[3] = __builtin_bit_cast(bf16x8, w); } \
            const char* vp = vrd0 + sc * 8192; \
            _Pragma("unroll") for (int s = 0; s < 4; ++s) { \
                const bf16x8 v0 = cat8(tr_read(vp + s * 1024), tr_read(vp + s * 1024 + 512)); \
                const bf16x8 v1 = cat8(tr_read(vp + 4096 + s * 1024), tr_read(vp + 4096 + s * 1024 + 512)); \
                o0 = MFMA(pw[s], v0, o0); o1 = MFMA(pw[s], v1, o1); } \
        } \
        { const int o_ = sc; sc = s1; s1 = sn; sn = o_; } } while (0)
    f32x16 sa0, sa1, sb0, sb1;
    asm volatile("s_waitcnt vmcnt(0)\n\ts_barrier" ::: "memory");
    ATT_QK(sa0, sa1, 0);
    for (int t2 = 0; t2 < NTC; t2 += 2) {
        ATT_STEP(sa0, sa1, sb0, sb1, t2);
        ATT_STEP(sb0, sb1, sa0, sa1, t2 + 1);
    }
#undef ATT_STEP
#undef ATT_QK
#undef MX3_
#undef ATT_ISSUE
    lsum += __shfl_xor(lsum, 32);
    if (hi == 0) wsf[32 + r32] = lsum;
    asm volatile("s_waitcnt lgkmcnt(0)" ::: "memory");
#pragma unroll
    for (int g = 0; g < 4; ++g) { const f32x4 lv = *(const f32x4*)(wsf + 32 + 8 * g + 4 * hi);
#pragma unroll
        for (int j = 0; j < 4; ++j) { const float inv = 1.0f / lv[j]; const int orow = 8 * g + 4 * hi + j;
            stg[orow * 64 + r32] = (bf16_t)(pk2(o0[4 * g + j] * inv, 0.f) & 0xffffu); stg[orow * 64 + 32 + r32] = (bf16_t)(pk2(o1[4 * g + j] * inv, 0.f) & 0xffffu); } }
    asm volatile("s_waitcnt lgkmcnt(0)" ::: "memory");
    const int b = bh >> 3, h = bh & 7;
    bf16_t* yp = Y + ((size_t)b * SEQ + q0 + wid * 32) * 512 + h * 64;
#pragma unroll
    for (int i = 0; i < 4; ++i) { const int row = i * 8 + (lane >> 3), ch = lane & 7; *(u32x4*)(yp + (size_t)row * 512 + ch * 8) = *(const u32x4*)(stg + row * 64 + ch * 8); }
}

template <int CW, int N8, bool ACT> DI void conv_row(const bf16_t* __restrict__ U, int tok, int tin, int col, const float* __restrict__ cw, const float* __restrict__ cb, int ch, float (&o)[8 * N8]) {
#pragma unroll
    for (int q = 0; q < N8; ++q) {
        float a[8];
        const f32x4 b0 = *(const f32x4*)(cb + ch + 8 * q), b1 = *(const f32x4*)(cb + ch + 8 * q + 4);
#pragma unroll
        for (int j = 0; j < 4; ++j) { a[j] = b0[j]; a[4 + j] = b1[j]; }
#pragma unroll
        for (int k = 0; k < 4; ++k) {
            if (tin - 3 + k >= 0) {
                const u32x4 u = *(const u32x4*)(U + (size_t)(tok - 3 + k) * NIN + col + 8 * q);
                const f32x4 w0 = *(const f32x4*)(cw + (size_t)k * CW + ch + 8 * q), w1 = *(const f32x4*)(cw + (size_t)k * CW + ch + 8 * q + 4);
                a[0] += w0[0] * bflo(u[0]); a[1] += w0[1] * bfhi(u[0]); a[2] += w0[2] * bflo(u[1]); a[3] += w0[3] * bfhi(u[1]);
                a[4] += w1[0] * bflo(u[2]); a[5] += w1[1] * bfhi(u[2]); a[6] += w1[2] * bflo(u[3]); a[7] += w1[3] * bfhi(u[3]);
            }
        }
#pragma unroll
        for (int j = 0; j < 8; ++j) o[8 * q + j] = ACT ? siluf_(a[j]) : a[j];
    }
}
DI void ssd_local_item(const Ctx& P, int l, int item, char* smem) {
    int tid_ = threadIdx.x & 255; asm volatile("" : "+v"(tid_));
    const int tid = tid_, lane = tid & 63, wid = tid >> 6, r32 = lane & 31, hi = lane >> 5;
    const int h = item & 3, c = (item >> 2) & 63, b = item >> 8, g = h >> 1;
    const int tok0 = b * SEQ + c * 128, tin0 = c * 128;
    const bf16_t* U = (const bf16_t*)(P.ws + AR_U);
    const float* cw = P.in[10] + (size_t)l * 4 * 512; const float* cb = P.in[11] + l * 512;
    char* Btr = smem; char* Xtr = smem + 16384; float* acs = (float*)(smem + 32768); float* dts = acs + 128; float* wts = dts + 128; float* tot = wts + 128;
    __syncthreads();
    if (tid < 128) {
        const float dtr = ((const float*)(P.ws + WS_DTRAW))[(size_t)(tok0 + tid) * 4 + h];
        const float dt = softplus_fast(dtr + P.in[12][l * 4 + h]);
        float v = -__expf(P.in[13][l * 4 + h]) * dt;
#pragma unroll
        for (int d = 1; d < 64; d <<= 1) { const float u = __shfl_up(v, d); if (lane >= d) v += u; }
        dts[tid] = dt; acs[tid] = v;
        if (tid == 63) tot[0] = v;
    }
    __syncthreads();
    if (tid >= 64 && tid < 128) acs[tid] += tot[0];
    __syncthreads();
    if (tid < 128) {
        const float ac = acs[tid], ae = acs[127];
        wts[tid] = __expf(ae - ac);
        ((float*)(P.ws + WS_ACUM))[(size_t)(tok0 + tid) * 4 + h] = ac;
        if (tid == 127) ((float*)(P.ws + WS_ATOT))[(b * 4 + h) * 64 + c] = ae;
    }
    {
        const int row = tid >> 1, half = tid & 1; float o[32];
        conv_row<512, 4, true>(U, tok0 + row, tin0 + row, UC_BS + g * 64 + half * 32, cw, cb, 256 + g * 64 + half * 32, o);
#pragma unroll
        for (int q = 0; q < 4; ++q) *(u32x4*)(Btr + half * 8192 + row * 64 + q * 16) = (u32x4){pk2(o[8 * q], o[8 * q + 1]), pk2(o[8 * q + 2], o[8 * q + 3]), pk2(o[8 * q + 4], o[8 * q + 5]), pk2(o[8 * q + 6], o[8 * q + 7])};
        conv_row<512, 4, true>(U, tok0 + row, tin0 + row, UC_XS + h * 64 + half * 32, cw, cb, h * 64 + half * 32, o);
        const float dt = dts[row];
#pragma unroll
        for (int q = 0; q < 4; ++q) *(u32x4*)(Xtr + half * 8192 + row * 64 + q * 16) = (u32x4){pk2(o[8 * q] * dt, o[8 * q + 1] * dt), pk2(o[8 * q + 2] * dt, o[8 * q + 3] * dt), pk2(o[8 * q + 4] * dt, o[8 * q + 5] * dt), pk2(o[8 * q + 6] * dt, o[8 * q + 7] * dt)};
    }
    bf16x8 cf[4];
    {
        const int row = wid * 32 + r32;
#pragma unroll
        for (int d0 = 0; d0 < 4; ++d0) { float o[8];
            conv_row<512, 1, true>(U, tok0 + row, tin0 + row, UC_CS + g * 64 + 16 * d0 + 8 * hi, cw, cb, 384 + g * 64 + 16 * d0 + 8 * hi, o);
            const u32x4 w = (u32x4){pk2(o[0], o[1]), pk2(o[2], o[3]), pk2(o[4], o[5]), pk2(o[6], o[7])};
            cf[d0] = __builtin_bit_cast(bf16x8, w);
            if ((h & 1) == 0) *(u32x4*)((bf16_t*)(P.ws + AR_CC) + (size_t)(tok0 + row) * 128 + g * 64 + 16 * d0 + 8 * hi) = w; }
    }
    __syncthreads();
    f32x16 y0, y1;
#pragma unroll
    for (int r = 0; r < 16; ++r) { y0[r] = 0.f; y1[r] = 0.f; }
    const int lrow = wid * 32 + r32; const float acl = acs[lrow];
    const char* xrd = Xtr + ((lane >> 4) & 1) * 32 + (lane & 3) * 8 + (4 * hi + ((lane & 15) >> 2)) * 64;
    for (int sb = 0; sb <= wid; ++sb) {
        f32x16 gt;
#pragma unroll
        for (int r = 0; r < 16; ++r) gt[r] = 0.f;
#pragma unroll
        for (int d0 = 0; d0 < 4; ++d0) { const bf16x8 bfg = *(const bf16x8*)(Btr + (d0 >> 1) * 8192 + (sb * 32 + r32) * 64 + (d0 & 1) * 32 + hi * 16); gt = MFMA(bfg, cf[d0], gt); }
#pragma unroll
        for (int q = 0; q < 4; ++q) { const f32x4 av = *(const f32x4*)(acs + sb * 32 + 8 * q + 4 * hi);
#pragma unroll
            for (int j = 0; j < 4; ++j) { const int s = sb * 32 + 8 * q + 4 * hi + j; gt[4 * q + j] = (s <= lrow) ? gt[4 * q + j] * __expf(acl - av[j]) : 0.f; } }
        u32x4 w0 = (u32x4){pk2(gt[0], gt[1]), pk2(gt[2], gt[3]), pk2(gt[4], gt[5]), pk2(gt[6], gt[7])};
        u32x4 w1 = (u32x4){pk2(gt[8], gt[9]), pk2(gt[10], gt[11]), pk2(gt[12], gt[13]), pk2(gt[14], gt[15])};
        const bf16x8 p0 = __builtin_bit_cast(bf16x8, w0), p1 = __builtin_bit_cast(bf16x8, w1);
        const char* xp = xrd + sb * 2048;
        { const bf16x8 xa = cat8(tr_read(xp), tr_read(xp + 512)); y0 = MFMA(xa, p0, y0); }
        { const bf16x8 xa = cat8(tr_read(xp + 1024), tr_read(xp + 1024 + 512)); y0 = MFMA(xa, p1, y0); }
        { const bf16x8 xa = cat8(tr_read(xp + 8192), tr_read(xp + 8192 + 512)); y1 = MFMA(xa, p0, y1); }
        { const bf16x8 xa = cat8(tr_read(xp + 8192 + 1024), tr_read(xp + 8192 + 1024 + 512)); y1 = MFMA(xa, p1, y1); }
    }
    {
        const float dsk = P.in[14][l * 4 + h], idt = 1.0f / dts[lrow];
        bf16_t* yl = (bf16_t*)(P.ws + AR_YLOC) + (size_t)(tok0 + lrow) * 256 + h * 64;
#pragma unroll
        for (int pb = 0; pb < 2; ++pb)
#pragma unroll
            for (int q = 0; q < 4; ++q) { const u32x2 xv = *(const u32x2*)(Xtr + pb * 8192 + lrow * 64 + (8 * q + 4 * hi) * 2);
                const float f = dsk * idt; const f32x16& yy = pb ? y1 : y0;
                const float v0 = yy[4 * q] + f * bflo(xv[0]), v1 = yy[4 * q + 1] + f * bfhi(xv[0]), v2 = yy[4 * q + 2] + f * bflo(xv[1]), v3 = yy[4 * q + 3] + f * bfhi(xv[1]);
                *(u32x2*)(yl + pb * 32 + 8 * q + 4 * hi) = (u32x2){pk2(v0, v1), pk2(v2, v3)}; }
    }
    {
        const int pbk = wid >> 1, nbk = wid & 1;
        f32x16 st;
#pragma unroll
        for (int r = 0; r < 16; ++r) st[r] = 0.f;
        const int trow = 4 * hi + ((lane & 15) >> 2), tcol = ((lane >> 4) & 1) * 32 + (lane & 3) * 8;
#pragma unroll
        for (int ks = 0; ks < 8; ++ks) {
            const s16x4 xl = tr_read(Xtr + pbk * 8192 + (16 * ks + trow) * 64 + tcol), xh = tr_read(Xtr + pbk * 8192 + (16 * ks + 8 + trow) * 64 + tcol);
            const s16x4 bl = tr_read(Btr + nbk * 8192 + (16 * ks + trow) * 64 + tcol), bh2 = tr_read(Btr + nbk * 8192 + (16 * ks + 8 + trow) * 64 + tcol);
            const f32x4 wl = *(const f32x4*)(wts + 16 * ks + 4 * hi), wh = *(const f32x4*)(wts + 16 * ks + 8 + 4 * hi);
            float xf[8];
#pragma unroll
            for (int j = 0; j < 4; ++j) { xf[j] = __uint_as_float(((unsigned)(unsigned short)xl[j]) << 16) * wl[j]; xf[4 + j] = __uint_as_float(((unsigned)(unsigned short)xh[j]) << 16) * wh[j]; }
            const u32x4 xw = (u32x4){pk2(xf[0], xf[1]), pk2(xf[2], xf[3]), pk2(xf[4], xf[5]), pk2(xf[6], xf[7])};
            st = MFMA(__builtin_bit_cast(bf16x8, xw), cat8(bl, bh2), st);
        }
        float* sp = (float*)(P.ws + AR_STATES) + ((size_t)((b * 64 + c) * 4 + h) * 64 + pbk * 32) * 64 + nbk * 32 + r32;
#pragma unroll
        for (int r = 0; r < 16; ++r) sp[(size_t)crow(r, hi) * 64] = st[r];
    }
}

DI void lru_local_item(const Ctx& P, int l, int item, char* smem) {
    int tid_ = threadIdx.x & 255; asm volatile("" : "+v"(tid_));
    const int tid = tid_, lane = tid & 63, wid = tid >> 6, r32 = lane & 31, hi = lane >> 5;
    const int nb = item & 3, c = (item >> 2) & 63, b = item >> 8;
    const int tok0 = b * SEQ + c * 128, tin0 = c * 128;
    const bf16_t* U = (const bf16_t*)(P.ws + AR_U);
    const bf16_t* W = (const bf16_t*)(P.ws + ((l & 1) ? WS_WB1 : WS_WB0));
    float* xc = (float*)smem;
    float* totA = (float*)(smem + 34816); float* totH = totA + 256;
    __syncthreads();
    {
        const int row = tid >> 1, half = tid & 1; float o[32];
        conv_row<256, 4, false>(U, tok0 + row, tin0 + row, UC_XR + nb * 64 + half * 32, P.in[16] + (size_t)l * 4 * 256, P.in[17] + l * 256, nb * 64 + half * 32, o);
#pragma unroll
        for (int q = 0; q < 8; ++q) *(f32x4*)(xc + row * 68 + half * 32 + 4 * q) = (f32x4){o[4 * q], o[4 * q + 1], o[4 * q + 2], o[4 * q + 3]};
    }
    __syncthreads();
    const int row = wid * 32 + r32;
    bf16x8 xf[4];
#pragma unroll
    for (int d0 = 0; d0 < 4; ++d0) {
        const f32x4 a = *(const f32x4*)(xc + row * 68 + 16 * d0 + 8 * hi), bq = *(const f32x4*)(xc + row * 68 + 16 * d0 + 8 * hi + 4);
        const u32x4 xw = (u32x4){pk2(a[0], a[1]), pk2(a[2], a[3]), pk2(bq[0], bq[1]), pk2(bq[2], bq[3])};
        xf[d0] = __builtin_bit_cast(bf16x8, xw);
    }
    float Av[32], Hv[32];
    const float* ba = P.in[19] + l * 256 + nb * 64; const float* bi = P.in[21] + l * 256 + nb * 64; const float* lam = P.in[22] + l * 256 + nb * 64;
#pragma unroll
    for (int e = 0; e < 2; ++e) {
        f32x16 ar, ai;
#pragma unroll
        for (int r = 0; r < 16; ++r) { ar[r] = 0.f; ai[r] = 0.f; }
#pragma unroll
        for (int d0 = 0; d0 < 4; ++d0) {
            const bf16x8 wa = *(const bf16x8*)(W + WO_A + nb * 4096 + (e * 32 + r32) * 64 + 16 * d0 + 8 * hi);
            const bf16x8 wi = *(const bf16x8*)(W + WO_I + nb * 4096 + (e * 32 + r32) * 64 + 16 * d0 + 8 * hi);
            ar = MFMA(wa, xf[d0], ar); ai = MFMA(wi, xf[d0], ai);
        }
#pragma unroll
        for (int q = 0; q < 4; ++q) { const int ch = e * 32 + 8 * q + 4 * hi;
            const f32x4 bav = *(const f32x4*)(ba + ch), biv = *(const f32x4*)(bi + ch), lv = *(const f32x4*)(lam + ch), xv = *(const f32x4*)(xc + row * 68 + ch);
#pragma unroll
            for (int j = 0; j < 4; ++j) {
                const float rg = sigmoidf_(ar[4 * q + j] + bav[j]), ig = sigmoidf_(ai[4 * q + j] + biv[j]);
                const float la = -8.0f * rg * softplus_fast(-lv[j]);
                Av[e * 16 + 4 * q + j] = __expf(la);
                Hv[e * 16 + 4 * q + j] = __builtin_amdgcn_sqrtf(neg_expm1_fast(2.0f * la)) * (ig * xv[j]);
            } }
        asm volatile("" ::: "memory");
    }
#pragma unroll
    for (int d = 1; d < 32; d <<= 1) {
#pragma unroll
        for (int i = 0; i < 32; ++i) { const float ap = __shfl_up(Av[i], d, 32), hp = __shfl_up(Hv[i], d, 32); if (r32 >= d) { Hv[i] = Av[i] * hp + Hv[i]; Av[i] = Av[i] * ap; }
            if ((i & 7) == 7) __builtin_amdgcn_sched_barrier(0); }
    }
    if (r32 == 31) {
#pragma unroll
        for (int e = 0; e < 2; ++e)
#pragma unroll
            for (int q = 0; q < 4; ++q)
#pragma unroll
                for (int j = 0; j < 4; ++j) { const int ch = e * 32 + 8 * q + 4 * hi + j; totA[wid * 64 + ch] = Av[e * 16 + 4 * q + j]; totH[wid * 64 + ch] = Hv[e * 16 + 4 * q + j]; }
    }
    __syncthreads();
    float* carA = totH + 256 + wid * 64; float* carH = carA + 256;
    { float Ac = 1.f, Hc = 0.f;
      for (int w = 0; w < wid; ++w) { const float a2 = totA[w * 64 + lane], h2 = totH[w * 64 + lane]; Hc = a2 * Hc + h2; Ac = Ac * a2; }
      carA[lane] = Ac; carH[lane] = Hc; }
    asm volatile("s_waitcnt lgkmcnt(0)" ::: "memory");
    {
        bf16_t* hl = (bf16_t*)(P.ws + AR_HLOC) + (size_t)(tok0 + row) * 256 + nb * 64; bf16_t* ac = (bf16_t*)(P.ws + AR_ACP) + (size_t)(tok0 + row) * 256 + nb * 64;
#pragma unroll
        for (int e = 0; e < 2; ++e)
#pragma unroll
            for (int q = 0; q < 4; ++q) { const int ch = e * 32 + 8 * q + 4 * hi; float av[4], hv[4];
                const f32x4 ca = *(const f32x4*)(carA + ch), chv = *(const f32x4*)(carH + ch);
#pragma unroll
                for (int j = 0; j < 4; ++j) { const int i = e * 16 + 4 * q + j; hv[j] = Av[i] * chv[j] + Hv[i]; av[j] = Av[i] * ca[j]; }
                *(u32x2*)(hl + ch) = (u32x2){pk2(hv[0], hv[1]), pk2(hv[2], hv[3])};
                *(u32x2*)(ac + ch) = (u32x2){pk2(av[0], av[1]), pk2(av[2], av[3])};
                if (wid == 3 && r32 == 31) { float* he = (float*)(P.ws + WS_HEND) + (size_t)(b * 64 + c) * 256 + nb * 64 + ch; float* ae = (float*)(P.ws + WS_AEND) + (size_t)(b * 64 + c) * 256 + nb * 64 + ch;
                    *(f32x4*)he = (f32x4){hv[0], hv[1], hv[2], hv[3]}; *(f32x4*)ae = (f32x4){av[0], av[1], av[2], av[3]}; } }
    }
}

DI void carries(const Ctx& P, int bid) {
    int tid_ = threadIdx.x & 255; asm volatile("" : "+v"(tid_));
    const int tid = tid_;
    if (bid < 128) {
        const int idx = bid * 256 + tid;
        const int b = idx >> 14, h = (idx >> 12) & 3, e = idx & 4095;
        const float* st = (const float*)(P.ws + AR_STATES) + ((size_t)(b * 64) * 4 + h) * 4096 + e;
        bf16_t* so = (bf16_t*)(P.ws + AR_SIN) + ((size_t)(b * 64) * 4 + h) * 4096 + e;
        const float* at = (const float*)(P.ws + WS_ATOT) + (b * 4 + h) * 64;
        float S = 0.f;
        for (int c0 = 0; c0 < 64; c0 += 8) {
            float v[8], a[8];
#pragma unroll
            for (int j = 0; j < 8; ++j) { v[j] = st[(size_t)(c0 + j) * 16384]; a[j] = __expf(at[c0 + j]); }
#pragma unroll
            for (int j = 0; j < 8; ++j) { so[(size_t)(c0 + j) * 16384] = (bf16_t)(pk2(S, 0.f) & 0xffffu); S = a[j] * S + v[j]; }
        }
    } else if (bid < 130) {
        const int idx = (bid - 128) * 256 + tid;
        const int b = idx >> 8, ch = idx & 255;
        const float* he = (const float*)(P.ws + WS_HEND) + (size_t)b * 64 * 256 + ch; const float* ae = (const float*)(P.ws + WS_AEND) + (size_t)b * 64 * 256 + ch;
        float* hin = (float*)(P.ws + WS_HIN) + (size_t)b * 64 * 256 + ch;
        float Hc = 0.f;
        for (int c = 0; c < 64; ++c) { hin[c * 256] = Hc; Hc = ae[c * 256] * Hc + he[c * 256]; }
    }
}

DI void ssd_z_item(const Ctx& P, int item) {
    int tid_ = threadIdx.x & 255; asm volatile("" : "+v"(tid_));
    const int tid = tid_, lane = tid & 63, wid = tid >> 6, r32 = lane & 31, hi = lane >> 5;
    const int g = item & 1, c = (item >> 1) & 63, b = item >> 7;
    const int tok = b * SEQ + c * 128 + wid * 32 + r32;
    const bf16_t* Cc = (const bf16_t*)(P.ws + AR_CC) + (size_t)tok * 128 + g * 64 + 8 * hi;
    bf16x8 cf[4];
#pragma unroll
    for (int d0 = 0; d0 < 4; ++d0) cf[d0] = *(const bf16x8*)(Cc + 16 * d0);
    f32x16 acc[2][2];
#pragma unroll
    for (int hh = 0; hh < 2; ++hh)
#pragma unroll
        for (int pb = 0; pb < 2; ++pb) {
#pragma unroll
            for (int r = 0; r < 16; ++r) acc[hh][pb][r] = 0.f;
            const bf16_t* sp = (const bf16_t*)(P.ws + AR_SIN) + ((size_t)((b * 64 + c) * 4 + 2 * g + hh) * 64 + pb * 32 + r32) * 64 + 8 * hi;
#pragma unroll
            for (int d0 = 0; d0 < 4; ++d0) { const bf16x8 sf = *(const bf16x8*)(sp + 16 * d0); acc[hh][pb] = MFMA(sf, cf[d0], acc[hh][pb]); }
        }
    const f32x4 acv = *(const f32x4*)((const float*)(P.ws + WS_ACUM) + (size_t)tok * 4);
    const bf16_t* yl = (const bf16_t*)(P.ws + AR_YLOC) + (size_t)tok * 256 + g * 128;
    const bf16_t* zp = (const bf16_t*)(P.ws + AR_U) + (size_t)tok * NIN + UC_Z + g * 128;
    float ss = 0.f;
#pragma unroll
    for (int hh = 0; hh < 2; ++hh) { const float ea = __expf(acv[2 * g + hh]);
#pragma unroll
        for (int pb = 0; pb < 2; ++pb)
#pragma unroll
            for (int q = 0; q < 4; ++q) { const int col = hh * 64 + pb * 32 + 8 * q + 4 * hi;
                const u32x2 yv = *(const u32x2*)(yl + col), zv = *(const u32x2*)(zp + col);
                const float yy[4] = {bflo(yv[0]), bfhi(yv[0]), bflo(yv[1]), bfhi(yv[1])}, zz[4] = {bflo(zv[0]), bfhi(zv[0]), bflo(zv[1]), bfhi(zv[1])};
#pragma unroll
                for (int j = 0; j < 4; ++j) { const float v = (acc[hh][pb][4 * q + j] * ea + yy[j]) * siluf_(zz[j]); acc[hh][pb][4 * q + j] = v; ss += v * v; } } }
    ss += __shfl_xor(ss, 32);
    const float rs = rsqrtf(ss * (1.0f / 128.0f) + EPS);
    bf16_t* ym = (bf16_t*)(P.ws + AR_YMIX) + (size_t)tok * 1024 + 512 + g * 128;
#pragma unroll
    for (int hh = 0; hh < 2; ++hh)
#pragma unroll
        for (int pb = 0; pb < 2; ++pb)
#pragma unroll
            for (int q = 0; q < 4; ++q) { const int col = hh * 64 + pb * 32 + 8 * q + 4 * hi;
                *(u32x2*)(ym + col) = (u32x2){pk2(acc[hh][pb][4 * q] * rs, acc[hh][pb][4 * q + 1] * rs), pk2(acc[hh][pb][4 * q + 2] * rs, acc[hh][pb][4 * q + 3] * rs)}; }
}
DI void rowfin_item(const Ctx& P, int item) {
    int tid_ = threadIdx.x & 255; asm volatile("" : "+v"(tid_));
    const int lane = tid_ & 63, wid = tid_ >> 6;
#pragma unroll
    for (int u = 0; u < 4; ++u) {
    const int tok = item * 16 + wid * 4 + u;
    bf16_t* ym = (bf16_t*)(P.ws + AR_YMIX) + (size_t)tok * 1024;
    {
        const u32x4 v = *(const u32x4*)((const bf16_t*)(P.ws + AR_YMLA) + (size_t)tok * 512 + lane * 8);
        float f[8] = {bflo(v[0]), bfhi(v[0]), bflo(v[1]), bfhi(v[1]), bflo(v[2]), bfhi(v[2]), bflo(v[3]), bfhi(v[3])};
        float ss = 0.f;
#pragma unroll
        for (int j = 0; j < 8; ++j) ss += f[j] * f[j];
#pragma unroll
        for (int d = 1; d < 64; d <<= 1) ss += __shfl_xor(ss, d);
        const float rs = rsqrtf(ss * (1.0f / 512.0f) + EPS);
        *(u32x4*)(ym + lane * 8) = (u32x4){pk2(f[0] * rs, f[1] * rs), pk2(f[2] * rs, f[3] * rs), pk2(f[4] * rs, f[5] * rs), pk2(f[6] * rs, f[7] * rs)};
    }
    {
        const int b = tok >> 13, c = (tok & 8191) >> 7, ch = lane * 4;
        const u32x2 hv = *(const u32x2*)((const bf16_t*)(P.ws + AR_HLOC) + (size_t)tok * 256 + ch), av = *(const u32x2*)((const bf16_t*)(P.ws + AR_ACP) + (size_t)tok * 256 + ch);
        const u32x2 gv = *(const u32x2*)((const bf16_t*)(P.ws + AR_U) + (size_t)tok * NIN + UC_GATE + ch);
        const f32x4 hin = *(const f32x4*)((const float*)(P.ws + WS_HIN) + (size_t)(b * 64 + c) * 256 + ch);
        const float hl[4] = {bflo(hv[0]), bfhi(hv[0]), bflo(hv[1]), bfhi(hv[1])}, aa[4] = {bflo(av[0]), bfhi(av[0]), bflo(av[1]), bfhi(av[1])}, gg[4] = {bflo(gv[0]), bfhi(gv[0]), bflo(gv[1]), bfhi(gv[1])};
        float y[4], ss = 0.f;
#pragma unroll
        for (int j = 0; j < 4; ++j) { y[j] = (hl[j] + aa[j] * hin[j]) * gelu_tanh_(gg[j]); ss += y[j] * y[j]; }
#pragma unroll
        for (int d = 1; d < 64; d <<= 1) ss += __shfl_xor(ss, d);
        const float rs = rsqrtf(ss * (1.0f / 256.0f) + EPS);
        *(u32x2*)(ym + 768 + ch) = (u32x2){pk2(y[0] * rs, y[1] * rs), pk2(y[2] * rs, y[3] * rs)};
    }
    }
}

DI void run_phase(const Params& PP, int ph, char* smem, unsigned* sh_item, int rep = 0) {
    int z_; asm volatile("s_mov_b32 %0, 0" : "=s"(z_));
    Ctx P; P.in = PP.in + z_; P.out = PP.out + z_; P.ws = PP.ws + z_;
    const int vb = __builtin_amdgcn_readfirstlane((int)(threadIdx.x >> 8));
    const int bid = (int)blockIdx.x * 2 + vb + z_;
    const int G = (int)gridDim.x * 2;
    const int pb = (int)blockIdx.x + z_, PG = (int)gridDim.x;
    char* const smem_full = smem; smem = smem + vb * VB_LDS;
    unsigned char* ws = P.ws;
    bf16_t* XB = (bf16_t*)(ws + WS_XB);
#if !defined(ONLY) || ONLY == 9
    if (ph == 0) { phase_prologue(P, smem); return; }
#endif
    if (ph == NPHASE - 1) {
        int t_ = threadIdx.x & 255; asm volatile("" : "+v"(t_));
        const int lane = t_ & 63, wid = t_ >> 6; const float* g = P.in[34];
        for (int row = bid * 4 + wid; row < T; row += G * 4) {
            float* xr = P.out + (size_t)row * DM; f32x4 v[4]; float ss = 0.f;
#pragma unroll
            for (int i = 0; i < 4; ++i) { v[i] = *(const f32x4*)(xr + i * 256 + lane * 4); ss += v[i][0] * v[i][0] + v[i][1] * v[i][1] + v[i][2] * v[i][2] + v[i][3] * v[i][3]; }
#pragma unroll
            for (int d = 1; d < 64; d <<= 1) ss += __shfl_xor(ss, d);
            const float rs = rsqrtf(ss * (1.0f / 1024.0f) + EPS);
#pragma unroll
            for (int i = 0; i < 4; ++i) { const f32x4 gv = *(const f32x4*)(g + i * 256 + lane * 4); *(f32x4*)(xr + i * 256 + lane * 4) = (f32x4){v[i][0] * rs * gv[0], v[i][1] * rs * gv[1], v[i][2] * rs * gv[2], v[i][3] * rs * gv[3]}; }
        }
        return;
    }
    const int l = (ph - 1) / 9, st = (ph - 1) % 9;
    const bf16_t* W = (const bf16_t*)(ws + ((l & 1) ? WS_WB1 : WS_WB0));
    switch (st) {
#if !defined(ONLY) || ONLY == 0
    case 0: {
        { EpiP1KV e{EpiP1{(bf16_t*)(ws + AR_U), (float*)(ws + WS_DTRAW), (float*)(ws + WS_PQ), (float*)(ws + WS_PKV)}, (bf16_t*)(ws + WS_KMEM), (bf16_t*)(ws + WS_VMEM)};
          const bf16_t* Wi = W + WO_IN; const bf16_t* Wk = W + WO_MK; const bf16_t* Am = (const bf16_t*)(ws + WS_MEMB) - (size_t)T * 1024; const float* part = (const float*)(ws + WS_PART);
          auto tf = [=](int it) { const int xcd = it & 7, idx = it >> 3;
                                  if (idx < 56) return Tile256{XB, Wi, part, 1024, 1024, 1024, (xcd * 8 + idx / 7) * 256, (idx % 7) * 256, 16, 0, 1.0f / 1024.0f};
                                  const int j = xcd * 2 + (idx - 56); return Tile256{Am, Wk, part, 1024, 1024, 1024, T + ((j >> 2) & 1) * 256, (j >> 3) * 1024 + (j & 3) * 256, 16, 0, 1.0f / 1024.0f}; };
          gemm256_stream(tf, pb, PG, 464, smem_full, e); }
    } break;
#endif
#if !defined(ONLY) || ONLY == 1
    case 1: {
        {
            const int tv = (pb >> 1) * 2 + vb, tvn = (PG >> 1) * 2;
            for (int k = tv; k < 512; k += tvn) { if (pb & 1) lru_local_item(P, l, k, smem); else ssd_local_item(P, l, k, smem); }
        }
        __syncthreads();
        { EpiStage1 e{EpiKV{(bf16_t*)(ws + AR_K), (bf16_t*)(ws + AR_V), (const bf16_t*)(ws + AR_U), (const float*)(ws + WS_COS), (const float*)(ws + WS_SIN)},
                      EpiQ{(bf16_t*)(ws + AR_Q), (const float*)(ws + WS_COS), (const float*)(ws + WS_SIN)}, (bf16_t*)(ws + WS_WQKT), (bf16_t*)(ws + WS_VWOT)};
          const bf16_t* Uq = (const bf16_t*)(ws + AR_U) + UC_CQ; const bf16_t* Ukv = (const bf16_t*)(ws + AR_U) + UC_CKV; const bf16_t* Wq = W + WO_UQ; const bf16_t* Wkv = W + WO_UKV;
          const bf16_t* Km = (const bf16_t*)(ws + WS_KMEM); const bf16_t* Vm = (const bf16_t*)(ws + WS_VMEM); const bf16_t* Wmq = W + WO_MQ; const bf16_t* Wmo = W + WO_MO;
          const float* pq = (const float*)(ws + WS_PQ); const float* pkv = (const float*)(ws + WS_PKV);
          auto tf = [=](int it) {
              if (it < 256) return Tile256{Ukv, Wkv, pkv, NIN, 128, 128, (it >> 2) * 256, (it & 3) * 256, 2, 0, 1.0f / 128.0f};
              if (it < 448) { const int j = it - 256; return Tile256{Uq, Wq, pq, NIN, 256, 256, (j / 3) * 256, (j % 3) * 256, 4, 1, 1.0f / 256.0f}; }
              if (it < 480) { const int j = it - 448, b = j >> 4, h = (j >> 2) & 3, nt = j & 3; return Tile256{Km + h * 256, Wmq + h * 256, nullptr, 1024, 1024, 256, b * 256, nt * 256, 0, 2 | (b << 2) | (h << 3), 0.f}; }
              const int j = it - 480, b = j >> 4, h = (j >> 2) & 3, mt = j & 3; return Tile256{Wmo + h * 256, Vm + (size_t)b * 256 * 1024 + h * 256, nullptr, 1024, 1024, 256, mt * 256, 0, 0, 3 | (b << 2) | (h << 3), 0.f}; };
          gemm256_stream(tf, pb, PG, 512, smem_full, e); }
    } break;
#endif
#if !defined(ONLY) || ONLY == 2
    case 2: {
        carries(P, bid);
        unsigned* ctr = (unsigned*)ws + CW_QUEUE + (l * 8 + (pb & 7)) * 64 + rep * 16;
        for (;;) {
            __syncthreads();
            if (threadIdx.x == 0) *sh_item = atomicAdd(ctr, 1u);
            __syncthreads();
            const unsigned j2 = *sh_item;
            if (j2 >= 64u) break;
            const int pi = 31 - (int)(j2 & 31u), qb = 2 * pi + 1 - vb;
            attn_item((const bf16_t*)(ws + AR_Q), (const bf16_t*)(ws + AR_K), (const bf16_t*)(ws + AR_V), (bf16_t*)(ws + AR_YMLA), (pb & 7) * 2 + (int)(j2 >> 5), qb, 2 * (2 * pi + 2), smem_full, vb);
        }
    } break;
#endif
#if !defined(ONLY) || ONLY == 3
    case 3: {
        for (int it = bid; it < 256 + 1024; it += G) { if (it < 256) ssd_z_item(P, it); else rowfin_item(P, it - 256); }
    } break;
#endif
#if !defined(ONLY) || ONLY == 4
    case 4: {
        EpiResid e{l == 0 ? P.in[0] : P.out, P.out, XB, (float*)(ws + WS_PART)};
        { const bf16_t* Ay = (const bf16_t*)(ws + AR_YMIX); const bf16_t* Wo = W + WO_OUT;
          auto tf = [=](int it) { const int xcd = it & 7, idx = it >> 3, mt = xcd * 8 + (idx >> 2), nt = idx & 3; return Tile256{Ay, Wo, nullptr, 1024, 1024, 1024, mt * 256, nt * 256, 0, 0, 0.f}; };
          gemm256_stream(tf, pb, PG, 256, smem_full, e); }
    } break;
#endif
#if !defined(ONLY) || ONLY == 5
    case 5: {
        { EpiSoftmax256 e{(bf16_t*)(ws + AR_P), (float*)(smem_full + 2 * 65536 + 1024)}; const bf16_t* Wq = (const bf16_t*)(ws + WS_WQKT); const float* part = (const float*)(ws + WS_PART);
          auto tf = [=](int it) { const int xcd = it & 7, idx = it >> 3, mt = xcd * 8 + (idx >> 2), hh = idx & 3; return Tile256{XB, Wq + (size_t)(mt >> 5) * 1048576, part, 1024, 1024, 1024, mt * 256, hh * 256, 16, 0, 1.0f / 1024.0f}; };
          gemm256_stream(tf, pb, PG, 256, smem_full, e); }
    } break;
#endif
#if !defined(ONLY) || ONLY == 6
    case 6: {
        EpiResid e{P.out, P.out, XB, (float*)(ws + WS_PART)};
        { const bf16_t* Ap = (const bf16_t*)(ws + AR_P); const bf16_t* Vw = (const bf16_t*)(ws + WS_VWOT);
          auto tf = [=](int it) { const int xcd = it & 7, idx = it >> 3, mt = xcd * 8 + (idx >> 2), nt = idx & 3; return Tile256{Ap, Vw + (size_t)(mt >> 5) * 1048576, nullptr, 1024, 1024, 1024, mt * 256, nt * 256, 0, 0, 0.f}; };
          gemm256_stream(tf, pb, PG, 256, smem_full, e); }
    } break;
#endif
#if !defined(ONLY) || ONLY == 7
    case 7: {
        EpiRelu2 e{(bf16_t*)(ws + AR_H)};
        { const bf16_t* W1 = W + WO_1; const float* part = (const float*)(ws + WS_PART);
          auto tf = [=](int it) { const int rnd = it >> 8, w = it & 255, xcd = w & 7, idx = w >> 3, mt = rnd * 16 + (xcd >> 1) * 4 + (idx >> 3), nt = (xcd & 1) * 8 + (idx & 7); return Tile256{XB, W1, part, 1024, 1024, 1024, mt * 256, nt * 256, 16, 0, 1.0f / 1024.0f}; };
          gemm256_stream(tf, pb, PG, 1024, smem_full, e); }
    } break;
#endif
#if !defined(ONLY) || ONLY == 8
    case 8: {
        EpiResid e{P.out, P.out, XB, (float*)(ws + WS_PART)};
        { const bf16_t* Ah = (const bf16_t*)(ws + AR_H); const bf16_t* W2 = W + WO_2;
          auto tf = [=](int it) { const int xcd = it & 7, idx = it >> 3, mt = xcd * 8 + (idx >> 2), nt = idx & 3; return Tile256{Ah, W2, nullptr, 4096, 4096, 4096, mt * 256, nt * 256, 0, 0, 0.f}; };
          gemm256_stream(tf, pb, PG, 256, smem_full, e); }
        if (l + 1 < NL) { __syncthreads(); convert_layer_weights(P, l + 1, (float*)smem); }
    } break;
#endif
    }
}

__global__ void __launch_bounds__(512, 2) hymba_mega(Params P, int ph_lo, int ph_hi, int coop) {
    extern __shared__ __attribute__((aligned(16))) char smem[];
    __shared__ unsigned sh_item;
    if (coop) {
        if (threadIdx.x == 0) *(uint4*)(smem + XB_LDS_OFF) = make_uint4(0u, 0u, 0u, 0u);
        __syncthreads();
        (void)xcd_barrier_post((unsigned*)P.ws, (volatile unsigned*)(smem + XB_LDS_OFF));
    }
    for (int ph = ph_lo; ph < ph_hi; ++ph) {
        run_phase(P, ph, smem, &sh_item);
#ifdef REP_ST
        if (ph >= 1 && ph < NPHASE - 1 && (ph - 1) % 9 == REP_ST) { xcd_barrier((unsigned*)P.ws); run_phase(P, ph, smem, &sh_item, 1); }
#endif
        if (coop && ph + 1 < ph_hi) {
            if (ph == ph_lo) cg::this_grid().sync();
            else { xcd_barrier((unsigned*)P.ws);
#ifdef DBL_BAR
                xcd_barrier((unsigned*)P.ws); xcd_barrier((unsigned*)P.ws);
#endif
            }
        }
    }
}

extern "C" void kernel_launch(void* const* d_in, const int* in_sizes, int n_in, void* d_out, int out_size, void* d_ws, size_t ws_size, hipStream_t stream) {
    static int grid = 0;
    if (grid == 0) {
        if (n_in != 35 || out_size != T * DM || ws_size < WS_END) { fprintf(stderr, "kernel_launch: unexpected shapes (n_in %d out %d ws %zu need %zu)\n", n_in, out_size, ws_size, (size_t)WS_END); grid = -1; return; }
        int dev = 0, cus = 0, per_cu = 0;
        hipGetDevice(&dev); hipDeviceGetAttribute(&cus, hipDeviceAttributeMultiprocessorCount, dev);
        if (hipFuncSetAttribute((const void*)hymba_mega, hipFuncAttributeMaxDynamicSharedMemorySize, LDS_BYTES) != hipSuccess) { fprintf(stderr, "kernel_launch: hipFuncSetAttribute failed\n"); grid = -1; return; }
        (void)hipOccupancyMaxActiveBlocksPerMultiprocessor(&per_cu, (const void*)hymba_mega, 512, LDS_BYTES);
        if (per_cu < 1) { fprintf(stderr, "kernel_launch: occupancy query failed\n"); grid = -1; return; }
        if (per_cu > 1) per_cu = 1;
        grid = cus * per_cu;
    }
    if (grid < 0) return;
    hipMemsetAsync((char*)d_ws + WS_CTL, 0, 65536, stream);
    Params p{};
    for (int i = 0; i < 35; ++i) p.in[i] = (const float*)d_in[i];
    p.out = (float*)d_out; p.ws = (unsigned char*)d_ws;
#if MK_MULTI
    for (int ph = 0; ph < NPHASE; ++ph) hipLaunchKernelGGL(hymba_mega, dim3(grid), dim3(512), LDS_BYTES, stream, p, ph, ph + 1, 0);
#else
    int lo = 0, hi = NPHASE, coop = 1;
    void* args[] = {&p, &lo, &hi, &coop};
    hipError_t e = hipLaunchCooperativeKernel((const void*)hymba_mega, dim3(grid), dim3(512), args, LDS_BYTES, stream);
    if (e != hipSuccess) fprintf(stderr, "cooperative launch failed: %s (grid %d)\n", hipGetErrorString(e), grid);
#endif
}
```

```cpp
#include <hip/hip_runtime.h>
#include <hip/hip_cooperative_groups.h>
#include <stdint.h>
#include <stdio.h>
namespace cg = cooperative_groups;

#ifndef MK_MULTI
#define MK_MULTI 0
#endif

#define DI __device__ __forceinline__
#define LAS __attribute__((address_space(3)))
typedef unsigned short bf16_t;
typedef short bf16x8 __attribute__((ext_vector_type(8)));
typedef short s16x4 __attribute__((ext_vector_type(4)));
typedef float f32x16 __attribute__((ext_vector_type(16)));
typedef float f32x4 __attribute__((ext_vector_type(4)));
typedef unsigned u32x4 __attribute__((ext_vector_type(4)));
typedef unsigned u32x2 __attribute__((ext_vector_type(2)));
#define MFMA(a, b, c) __builtin_amdgcn_mfma_f32_32x32x16_bf16((a), (b), (c), 0, 0, 0)

constexpr int T = 16384, SEQ = 8192, DM = 1024, NL = 4;
constexpr int NIN = 1792;
constexpr float EPS = 1e-6f;
constexpr float LOG2E = 1.4426950408889634f;
constexpr int VB_LDS = 78848;
constexpr int XB_LDS_OFF = 2 * VB_LDS;
constexpr int LDS_BYTES = XB_LDS_OFF + 16;
constexpr int NPHASE = 2 + 9 * NL;

constexpr int UC_CQ = 0, UC_CKV = 256, UC_KR = 384, UC_DT = 416, UC_Z = 512, UC_XS = 768, UC_BS = 1024, UC_CS = 1152, UC_XR = 1280, UC_GATE = 1536;

constexpr size_t WO_IN = 0;
constexpr size_t WO_UQ = WO_IN + (size_t)NIN * 1024;
constexpr size_t WO_UKV = WO_UQ + 768 * 256;
constexpr size_t WO_OUT = WO_UKV + 1024 * 128;
constexpr size_t WO_MQ = WO_OUT + 1048576;
constexpr size_t WO_MK = WO_MQ + 1048576;
constexpr size_t WO_MV = WO_MK + 1048576;
constexpr size_t WO_MO = WO_MV + 1048576;
constexpr size_t WO_1 = WO_MO + 1048576;
constexpr size_t WO_2 = WO_1 + 4194304;
constexpr size_t WO_A = WO_2 + 4194304;
constexpr size_t WO_I = WO_A + 16384;
constexpr size_t WB_ELEMS = WO_I + 16384;

constexpr size_t al256(size_t x) { return (x + 255) & ~(size_t)255; }
constexpr size_t WS_CTL = 0;
constexpr size_t WS_WB0 = 65536;
constexpr size_t WS_WB1 = WS_WB0 + al256(WB_ELEMS * 2);
constexpr size_t WS_XB = WS_WB1 + al256(WB_ELEMS * 2);
constexpr size_t WS_MEMB = WS_XB + (size_t)T * 1024 * 2;
constexpr size_t WS_COS = WS_MEMB + 512 * 1024 * 2;
constexpr size_t WS_SIN = WS_COS + (size_t)T * 16 * 4;
constexpr size_t WS_KMEM = WS_SIN + (size_t)T * 16 * 4;
constexpr size_t WS_VMEM = WS_KMEM + 512 * 1024 * 2;
constexpr size_t WS_WQKT = WS_VMEM + 512 * 1024 * 2;
constexpr size_t WS_VWOT = WS_WQKT + 2 * 1048576 * 2;
constexpr size_t WS_DTRAW = WS_VWOT + 2 * 1048576 * 2;
constexpr size_t WS_ACUM = WS_DTRAW + (size_t)T * 16;
constexpr size_t WS_ATOT = WS_ACUM + (size_t)T * 16;
constexpr size_t WS_HEND = WS_ATOT + 4096;
constexpr size_t WS_AEND = WS_HEND + 131072;
constexpr size_t WS_HIN = WS_AEND + 131072;
constexpr size_t WS_PART = WS_HIN + 131072;
constexpr size_t WS_PQ = WS_PART + (size_t)(T + 512) * 64;
constexpr size_t WS_PKV = WS_PQ + (size_t)T * 16;
constexpr size_t WS_ARENA = WS_PKV + (size_t)T * 8;
constexpr size_t AR_U = WS_ARENA;
constexpr size_t AR_Q = AR_U + (size_t)T * NIN * 2;
constexpr size_t AR_K = AR_Q + (size_t)16 * 8192 * 96 * 2;
constexpr size_t AR_V = AR_K + (size_t)16 * 8192 * 96 * 2;
constexpr size_t AR_YMLA = AR_V + (size_t)16 * 8192 * 64 * 2;
constexpr size_t AR_YLOC = AR_YMLA + (size_t)T * 512 * 2;
constexpr size_t AR_STATES = AR_YLOC + (size_t)T * 256 * 2;
constexpr size_t AR_SIN = AR_STATES + (size_t)2 * 64 * 4 * 4096 * 4;
constexpr size_t AR_CC = AR_SIN + (size_t)2 * 64 * 4 * 4096 * 2;
constexpr size_t AR_HLOC = AR_CC + (size_t)T * 128 * 2;
constexpr size_t AR_ACP = AR_HLOC + (size_t)T * 256 * 2;
constexpr size_t WS_END = AR_ACP + (size_t)T * 256 * 2;
constexpr size_t AR_YMIX = AR_Q;
constexpr size_t AR_P = AR_U;
constexpr size_t AR_H = WS_ARENA;
static_assert(AR_H + (size_t)T * 4096 * 2 <= WS_END, "H overlay");
static_assert(AR_YMIX + (size_t)T * 1024 * 2 <= AR_V, "ymix overlay");

#define XB_TMO      128
#define XB_XCNT(j)  (256  + 64 * (j))
#define XB_XSUB(j)  (1280 + 64 * (j))
#define XB_XGEN(j)  (2304 + 64 * (j))
#define XB_TOP      3328
#define XB_TOPGEN   3392
#define XCD_BAR_WORDS 3456
#define XB_SPIN_CAP (1u << 20)
constexpr int CW_QUEUE = 4096;

struct Params {
    const float* in[35];
    float* out;
    unsigned char* ws;
};

struct Ctx { const float* const* in; float* out; unsigned char* ws; };
DI int VBID() { int z_; asm volatile("s_mov_b32 %0, 0" : "=s"(z_)); return (int)blockIdx.x * 2 + (int)(threadIdx.x >> 8) + z_; }
DI int VGRID() { return (int)gridDim.x * 2; }

typedef __bf16 bf16x2_t __attribute__((ext_vector_type(2)));
DI unsigned pk2(float lo, float hi) { const bf16x2_t v = {(__bf16)lo, (__bf16)hi}; return __builtin_bit_cast(unsigned, v); }
DI float bflo(unsigned u) { return __uint_as_float(u << 16); }
DI float bfhi(unsigned u) { return __uint_as_float(u & 0xffff0000u); }
DI float sigmoidf_(float x) { return __builtin_amdgcn_rcpf(1.0f + __expf(-x)); }
DI float softplus_fast(float x) { const float y = __expf(x); const float ser = y * (1.0f - y * (0.5f - y * (0.33333334f - 0.25f * y))); const float lg = __logf(1.0f + y); return x > 15.f ? x : (y < 0.03f ? ser : lg); }
DI float neg_expm1_fast(float x) { const float ser = -x * (1.0f + x * (0.5f + x * (0.16666667f + x * (0.041666668f + x * 0.008333334f)))); const float ex = 1.0f - __expf(x); return x > -0.1f ? ser : ex; }
DI float siluf_(float x) { return x * sigmoidf_(x); }
DI float softplusf_(float x) { return x > 20.f ? x : log1pf(__expf(x)); }
DI float gelu_tanh_(float x) { const float y = 0.7978845608028654f * (x + 0.044715f * x * x * x); const float t = 1.0f - 2.0f / (__expf(2.0f * y) + 1.0f); return 0.5f * x * (1.0f + t); }
DI int crow(int r, int hi) { return (r & 3) + 8 * (r >> 2) + 4 * hi; }
typedef short v4i16_t __attribute__((ext_vector_type(4)));
DI s16x4 tr_read(const char* p) { return __builtin_bit_cast(s16x4, __builtin_amdgcn_ds_read_tr16_b64_v4i16((LAS v4i16_t*)(uintptr_t)(unsigned)(uintptr_t)p)); }
DI bf16x8 cat8(s16x4 lo, s16x4 hi) { return (bf16x8){lo[0], lo[1], lo[2], lo[3], hi[0], hi[1], hi[2], hi[3]}; }

DI void store_pair16(bf16_t* blk, int hi, int k, u32x2 a, u32x2 b) {
    const auto r0 = __builtin_amdgcn_permlane32_swap(a[0], b[0], false, false);
    const auto r1 = __builtin_amdgcn_permlane32_swap(a[1], b[1], false, false);
    *(u32x4*)(blk + 8 * k + 8 * hi) = (u32x4){r0[0], r1[0], r0[1], r1[1]};
}

DI unsigned xb_ld(unsigned* p) { return __hip_atomic_load(p, __ATOMIC_RELAXED, __HIP_MEMORY_SCOPE_AGENT); }
DI unsigned xb_add(unsigned* p, unsigned v) { return __hip_atomic_fetch_add(p, v, __ATOMIC_RELAXED, __HIP_MEMORY_SCOPE_AGENT); }
DI unsigned xb_xcc_id() { return (unsigned)__builtin_amdgcn_s_getreg((3 << 11) | 20) & 0xFu; }
#define XB_SPIN(cond, bar) do { unsigned _sp = 0; while (cond) { __builtin_amdgcn_s_sleep(1); \
    if ((++_sp & 255u) == 0u) { if (xb_ld(&(bar)[XB_TMO])) break; if (_sp > XB_SPIN_CAP) { atomicAdd(&(bar)[XB_TMO], 1u); break; } } } } while (0)
struct XcdBarrier { unsigned* bar; unsigned x; volatile unsigned* st; };
DI XcdBarrier xcd_barrier_post(unsigned* bar, volatile unsigned* st) {
    XcdBarrier b; b.bar = bar; b.x = xb_xcc_id(); b.st = st;
    if (threadIdx.x == 0) (void)xb_add(&bar[XB_XCNT(b.x)], 1u);
    return b;
}
DI void xcd_barrier_complete(unsigned* bar, unsigned x, unsigned& nloc, unsigned& nx) {
    const unsigned G = gridDim.x;
    unsigned sum, cnt, mine, sp = 0u;
    for (;;) {
        sum = 0u; cnt = 0u; mine = 0u;
#pragma unroll
        for (unsigned j = 0; j < 16; ++j) { const unsigned c = xb_ld(&bar[XB_XCNT(j)]); sum += c; cnt += (c > 0u) ? 1u : 0u; mine = (j == x) ? c : mine; }
        if (sum == G) break;
        __builtin_amdgcn_s_sleep(1);
        if ((++sp & 255u) == 0u) { if (xb_ld(&bar[XB_TMO])) break; if (sp > XB_SPIN_CAP) { atomicAdd(&bar[XB_TMO], 1u); break; } }
    }
    nloc = mine > 0u ? mine : 1u; nx = cnt > 0u ? cnt : 1u;
}
DI void xcd_barrier(unsigned* bar_in) {
    extern __shared__ __attribute__((aligned(16))) char dyn_lds_[];
    XcdBarrier b; b.bar = bar_in; b.st = (volatile unsigned*)(dyn_lds_ + XB_LDS_OFF); b.x = xb_xcc_id();
    asm volatile("s_waitcnt vmcnt(0)" ::: "memory");
    __syncthreads();
    if (threadIdx.x == 0) {
        int z_; asm volatile("s_mov_b32 %0, 0" : "=s"(z_));
        unsigned* bar = b.bar + z_;
        __builtin_amdgcn_s_waitcnt(0);
        unsigned nloc = b.st[0], nx = b.st[1];
        if (nloc == 0u) { xcd_barrier_complete(bar, b.x, nloc, nx); b.st[0] = nloc; b.st[1] = nx; }
        const unsigned old = xb_add(&bar[XB_XSUB(b.x)], 1u);
        const unsigned gen = old / nloc;
        if (old + 1u == (gen + 1u) * nloc) {
            __builtin_amdgcn_fence(__ATOMIC_RELEASE, "agent");
            asm volatile("s_waitcnt vmcnt(0)" ::: "memory");
            const unsigned og = xb_add(&bar[XB_TOP], 1u);
            const unsigned tg = og / nx;
            if (og + 1u == (tg + 1u) * nx) xb_add(&bar[XB_TOPGEN], 1u);
            else XB_SPIN(xb_ld(&bar[XB_TOPGEN]) == tg, bar);
            __builtin_amdgcn_fence(__ATOMIC_ACQUIRE, "agent");
            xb_add(&bar[XB_XGEN(b.x)], 1u);
            asm volatile("s_waitcnt vmcnt(0)" ::: "memory");
        } else {
            XB_SPIN(xb_ld(&bar[XB_XGEN(b.x)]) == gen, bar);
            __builtin_amdgcn_fence(__ATOMIC_ACQUIRE, "agent");
            asm volatile("s_waitcnt vmcnt(0)" ::: "memory");
        }
    }
    __syncthreads();
}

template <int WAVES_M, int WAVES_N, int MB, int NB, int NORM_A  , class Epi>
DI void gemm_tile(const bf16_t* __restrict__ A, int lda, const bf16_t* __restrict__ Bt, int ldb, int K, int m0, int n0, char* smem, const Epi& epi, const float* part = nullptr) {
    constexpr int BM = WAVES_M * MB * 32, BN = WAVES_N * NB * 32, LA = BM / 32, LB = BN / 32, RS = 144;
    char* As = smem; char* Bs = smem + BM * RS; float* rsc = (float*)(smem + (BM + BN) * RS);
    int tid_ = threadIdx.x & 255; asm volatile("" : "+v"(tid_));
    const int tid = tid_, lane = tid & 63, wid = tid >> 6, r32 = lane & 31, hi = lane >> 5;
    const int wm = wid / WAVES_N, wn = wid % WAVES_N;
    const int lrow = tid >> 3, lkc = tid & 7;
    const bf16_t* Ap = A + (size_t)(m0 + lrow) * lda + lkc * 8;
    const bf16_t* Bp = Bt + (size_t)(n0 + lrow) * ldb + lkc * 8;
    u32x4 ra[LA], rb[LB]; float ss[LA];
    f32x16 acc[NB][MB];
#pragma unroll
    for (int i = 0; i < LA; ++i) ss[i] = 0.f;
#pragma unroll
    for (int nb = 0; nb < NB; ++nb)
#pragma unroll
        for (int mb = 0; mb < MB; ++mb)
#pragma unroll
            for (int r = 0; r < 16; ++r) acc[nb][mb][r] = 0.f;
#pragma unroll
    for (int i = 0; i < LA; ++i) ra[i] = *(const u32x4*)(Ap + (size_t)i * 32 * lda);
#pragma unroll
    for (int i = 0; i < LB; ++i) rb[i] = *(const u32x4*)(Bp + (size_t)i * 32 * ldb);
    const int nk = K >> 6;
    for (int kt = 0; kt < nk; ++kt) {
        __syncthreads();
#pragma unroll
        for (int i = 0; i < LA; ++i) *(u32x4*)(As + (lrow + 32 * i) * RS + lkc * 16) = ra[i];
#pragma unroll
        for (int i = 0; i < LB; ++i) *(u32x4*)(Bs + (lrow + 32 * i) * RS + lkc * 16) = rb[i];
        if (NORM_A == 1) {
#pragma unroll
            for (int i = 0; i < LA; ++i)
#pragma unroll
                for (int j = 0; j < 4; ++j) { const float a = bflo(ra[i][j]), b = bfhi(ra[i][j]); ss[i] += a * a + b * b; }
        }
        __syncthreads();
        if (kt + 1 < nk) {
            Ap += 64; Bp += 64;
#pragma unroll
            for (int i = 0; i < LA; ++i) ra[i] = *(const u32x4*)(Ap + (size_t)i * 32 * lda);
#pragma unroll
            for (int i = 0; i < LB; ++i) rb[i] = *(const u32x4*)(Bp + (size_t)i * 32 * ldb);
        }
#pragma unroll
        for (int s = 0; s < 4; ++s) {
            bf16x8 af[MB], bfr[NB];
#pragma unroll
            for (int mb = 0; mb < MB; ++mb) af[mb] = *(const bf16x8*)(As + (wm * MB * 32 + mb * 32 + r32) * RS + s * 32 + hi * 16);
#pragma unroll
            for (int nb = 0; nb < NB; ++nb) bfr[nb] = *(const bf16x8*)(Bs + (wn * NB * 32 + nb * 32 + r32) * RS + s * 32 + hi * 16);
#pragma unroll
            for (int nb = 0; nb < NB; ++nb)
#pragma unroll
                for (int mb = 0; mb < MB; ++mb) acc[nb][mb] = MFMA(bfr[nb], af[mb], acc[nb][mb]);
        }
    }
    if (NORM_A == 1) {
#pragma unroll
        for (int i = 0; i < LA; ++i) {
            float s = ss[i]; s += __shfl_xor(s, 1); s += __shfl_xor(s, 2); s += __shfl_xor(s, 4);
            if (lkc == 0) rsc[lrow + 32 * i] = rsqrtf(s / (float)K + EPS);
        }
        __syncthreads();
    }
    if (NORM_A == 2) {
        if (tid < BM) { const float* pp = part + (size_t)(m0 + tid) * 16; const f32x4 a = *(const f32x4*)pp, b = *(const f32x4*)(pp + 4), c = *(const f32x4*)(pp + 8), d = *(const f32x4*)(pp + 12);
            rsc[tid] = rsqrtf((((a[0] + a[1]) + (a[2] + a[3])) + ((b[0] + b[1]) + (b[2] + b[3])) + ((c[0] + c[1]) + (c[2] + c[3])) + ((d[0] + d[1]) + (d[2] + d[3]))) * (1.0f / 1024.0f) + EPS); }
        __syncthreads();
    }
    epi.template run<NB, MB>(acc, m0 + wm * MB * 32, n0 + wn * NB * 32, r32, hi, rsc + wm * MB * 32);
}

DI void glds16(const void* g, unsigned lds_addr) {
    unsigned sv;
    asm volatile("s_mov_b32 %0, m0\n\ts_mov_b32 m0, %2\n\ts_nop 0\n\tglobal_load_lds_dwordx4 %1, off\n\ts_mov_b32 m0, %0" : "=&s"(sv) : "v"(g), "s"(lds_addr) : "memory");
}
template <class E, class = void> struct IsStaged { static constexpr bool v = false; };
template <class E> struct IsStaged<E, decltype((void)E::STAGED)> { static constexpr bool v = E::STAGED; };
struct Tile256 { const bf16_t* A; const bf16_t* Bt; const float* part; int lda, ldb, K, m0, n0, npart, tag; float invk; };
template <class Epi, class TileFn>
DI void gemm256_stream(const TileFn& tf, int it0, int step, int ntiles, char* smem, const Epi& epi) {
    constexpr int MB = 4, NB = 2, BM = 256, STG = 65536, NSEG = 8;
    int tid_ = threadIdx.x; asm volatile("" : "+v"(tid_));
    const int tid = tid_, lane = tid & 63, wid = tid >> 6, r32 = lane & 31, hi = lane >> 5;
    const int wm = wid >> 2, wn = wid & 3;
    const int lr = lane >> 3, cc = lane & 7;
    const unsigned lds0 = (unsigned)(uintptr_t)smem;
    float* rsc = (float*)(smem + 2 * STG);
    int aoff[MB], boff[NB], asw[MB], bsw[NB];
#pragma unroll
    for (int mb = 0; mb < MB; ++mb) { const int r = wm * 128 + mb * 32 + r32; aoff[mb] = r * 128; asw[mb] = (r >> 1) & 7; }
#pragma unroll
    for (int nb = 0; nb < NB; ++nb) { const int r = wn * 64 + nb * 32 + r32; boff[nb] = (BM + r) * 128; bsw[nb] = (r >> 1) & 7; }
#define SRC_OF(T_, j_) ((j_) < 4 ? (T_).A + (size_t)((T_).m0 + 8 * (wid + 8 * (j_)) + lr) * (T_).lda + ((cc ^ (((8 * (wid + 8 * (j_)) + lr) >> 1) & 7)) * 8) \
                                 : (T_).Bt + (size_t)((T_).n0 + 8 * (wid + 8 * (j_)) + lr - BM) * (T_).ldb + ((cc ^ (((8 * (wid + 8 * (j_)) + lr - BM) >> 1) & 7)) * 8))
    bool primed = false;
    for (int it = it0; it < ntiles; it += step) {
        const Tile256 t = tf(it);
        const int nk = t.K >> 6;
        const bf16_t* src[NSEG];
#pragma unroll
        for (int j = 0; j < NSEG; ++j) src[j] = SRC_OF(t, j);
        f32x16 acc[NB][MB];
#pragma unroll
        for (int nb = 0; nb < NB; ++nb)
#pragma unroll
            for (int mb = 0; mb < MB; ++mb)
#pragma unroll
                for (int r = 0; r < 16; ++r) acc[nb][mb][r] = 0.f;
        if (!primed) {
            __syncthreads();
#pragma unroll
            for (int j = 0; j < NSEG; ++j) glds16(src[j], (unsigned)__builtin_amdgcn_readfirstlane((int)(lds0 + (wid + 8 * j) * 1024)));
        }
        float sq = 0.f;
        for (int kt = 0; kt < nk; ++kt) {
            asm volatile("s_waitcnt vmcnt(0)\n\ts_barrier" ::: "memory");
            if (kt == nk - 1 && t.part && tid < BM) {
                const float* pp = t.part + (size_t)(t.m0 + tid) * t.npart;
                for (int i = 0; i < t.npart; i += 2) sq += pp[i] + pp[i + 1]; }
            if (kt + 1 < nk) {
#pragma unroll
                for (int j = 0; j < NSEG; ++j) glds16(src[j] + (size_t)(kt + 1) * 64, (unsigned)__builtin_amdgcn_readfirstlane((int)(lds0 + ((kt + 1) & 1) * STG + (wid + 8 * j) * 1024)));
            } else if (it + step < ntiles) {
                const Tile256 tn = tf(it + step);
#pragma unroll
                for (int j = 0; j < NSEG; ++j) glds16(SRC_OF(tn, j), (unsigned)__builtin_amdgcn_readfirstlane((int)(lds0 + (wid + 8 * j) * 1024)));
                primed = true;
            }
            const char* st = smem + (kt & 1) * STG;
#pragma unroll
            for (int s = 0; s < 4; ++s) {
                bf16x8 af[MB], bfr[NB];
#pragma unroll
                for (int mb = 0; mb < MB; ++mb) af[mb] = *(const bf16x8*)(st + aoff[mb] + (((2 * s + hi) ^ asw[mb]) * 16));
#pragma unroll
                for (int nb = 0; nb < NB; ++nb) bfr[nb] = *(const bf16x8*)(st + boff[nb] + (((2 * s + hi) ^ bsw[nb]) * 16));
#pragma unroll
                for (int nb = 0; nb < NB; ++nb)
#pragma unroll
                    for (int mb = 0; mb < MB; ++mb) acc[nb][mb] = MFMA(bfr[nb], af[mb], acc[nb][mb]);
            }
        }
        if (t.part) {
            if (tid < BM) rsc[tid] = rsqrtf(sq * t.invk + EPS);
            __syncthreads();
        }
        if constexpr (IsStaged<Epi>::v) epi.template run_staged<NB, MB>(acc, t.m0, t.n0, wm, wn, r32, hi, lane, wid, smem + STG);
        else epi.template run<NB, MB>(acc, t.m0 + wm * 128, t.n0 + wn * 64, r32, hi, rsc + wm * 128, t.tag);
        if (t.part) __syncthreads();
    }
#undef SRC_OF
}

struct EpiP1 {
    bf16_t* U; float* dtraw; float* pq; float* pkv;
    template <int NB, int MB> DI void run(f32x16 (&acc)[NB][MB], int mb0, int nb0, int r32, int hi, const float* rs, int tag = 0) const {
#pragma unroll
        for (int mb = 0; mb < MB; ++mb) { const int row = mb0 + mb * 32 + r32; const float sc = rs[mb * 32 + r32]; float ssq = 0.f;
#pragma unroll
            for (int nb = 0; nb < NB; ++nb) { const int cb = nb0 + nb * 32; u32x2 w[4];
#pragma unroll
                for (int g = 0; g < 4; ++g) {
                    const float v0 = acc[nb][mb][4 * g] * sc, v1 = acc[nb][mb][4 * g + 1] * sc, v2 = acc[nb][mb][4 * g + 2] * sc, v3 = acc[nb][mb][4 * g + 3] * sc;
                    w[g] = (u32x2){pk2(v0, v1), pk2(v2, v3)}; ssq += (v0 * v0 + v1 * v1) + (v2 * v2 + v3 * v3);
                    if (cb + 8 * g + 4 * hi == UC_DT) *(f32x4*)(dtraw + (size_t)row * 4) = (f32x4){v0, v1, v2, v3}; }
                bf16_t* blk = U + (size_t)row * NIN + cb;
                store_pair16(blk, hi, 0, w[0], w[1]); store_pair16(blk, hi, 2, w[2], w[3]); }
            if (nb0 < UC_KR) { ssq += __shfl_xor(ssq, 32);
                if (hi == 0) { if (nb0 < UC_CKV) pq[(size_t)row * 4 + (nb0 >> 6)] = ssq; else pkv[(size_t)row * 2 + ((nb0 - UC_CKV) >> 6)] = ssq; } } }
    }
};
struct EpiP1KV {
    EpiP1 p1; bf16_t* kmem; bf16_t* vmem;
    template <int NB, int MB> DI void run(f32x16 (&acc)[NB][MB], int mb0, int nb0, int r32, int hi, const float* rs, int tag = 0) const {
        if (mb0 < T) { p1.template run<NB, MB>(acc, mb0, nb0, r32, hi, rs); return; }
        bf16_t* O = (nb0 >> 10) ? vmem : kmem;
#pragma unroll
        for (int mb = 0; mb < MB; ++mb) { const int row = mb0 - T + mb * 32 + r32; const float sc = rs[mb * 32 + r32];
#pragma unroll
            for (int nb = 0; nb < NB; ++nb) { u32x2 w[4];
#pragma unroll
                for (int g = 0; g < 4; ++g) w[g] = (u32x2){pk2(acc[nb][mb][4 * g] * sc, acc[nb][mb][4 * g + 1] * sc), pk2(acc[nb][mb][4 * g + 2] * sc, acc[nb][mb][4 * g + 3] * sc)};
                bf16_t* blk = O + (size_t)row * 1024 + (nb0 & 1023) + nb * 32;
                store_pair16(blk, hi, 0, w[0], w[1]); store_pair16(blk, hi, 2, w[2], w[3]); } }
    }
};
template <bool USE_RS> struct EpiPlain {
    bf16_t* O; int ld; int row_off, col_off; float scale;
    template <int NB, int MB> DI void run(f32x16 (&acc)[NB][MB], int mb0, int nb0, int r32, int hi, const float* rs, int tag = 0) const {
#pragma unroll
        for (int mb = 0; mb < MB; ++mb) { const int row = mb0 + mb * 32 + r32 + row_off; const float sc = USE_RS ? rs[mb * 32 + r32] * scale : scale;
#pragma unroll
            for (int nb = 0; nb < NB; ++nb)
#pragma unroll
                for (int g = 0; g < 4; ++g) { const int col = nb0 + nb * 32 + 8 * g + 4 * hi + col_off;
                    *(u32x2*)(O + (size_t)row * ld + col) = (u32x2){pk2(acc[nb][mb][4 * g] * sc, acc[nb][mb][4 * g + 1] * sc), pk2(acc[nb][mb][4 * g + 2] * sc, acc[nb][mb][4 * g + 3] * sc)}; } }
    }
};
struct EpiRelu2 {
    bf16_t* H;
    template <int NB, int MB> DI void run(f32x16 (&acc)[NB][MB], int mb0, int nb0, int r32, int hi, const float* rs, int tag = 0) const {
#pragma unroll
        for (int mb = 0; mb < MB; ++mb) { const int row = mb0 + mb * 32 + r32; const float sc = rs[mb * 32 + r32];
#pragma unroll
            for (int nb = 0; nb < NB; ++nb) { u32x2 w[4];
#pragma unroll
                for (int g = 0; g < 4; ++g) { float v[4];
#pragma unroll
                    for (int j = 0; j < 4; ++j) { const float t = fmaxf(acc[nb][mb][4 * g + j] * sc, 0.f); v[j] = t * t; }
                    w[g] = (u32x2){pk2(v[0], v[1]), pk2(v[2], v[3])}; }
                bf16_t* blk = H + (size_t)row * 4096 + nb0 + nb * 32;
                store_pair16(blk, hi, 0, w[0], w[1]); store_pair16(blk, hi, 2, w[2], w[3]); } }
    }
};
struct EpiResid {
    static constexpr bool STAGED = true;
    const float* res; float* out; bf16_t* xb; float* part;
    template <int NB, int MB> DI void run_staged(f32x16 (&acc)[NB][MB], int m0, int n0, int wm, int wn, int r32, int hi, int lane, int wid, char* stage) const {
        asm volatile("s_waitcnt lgkmcnt(0)\n\ts_barrier" ::: "memory");
#pragma unroll 1
        for (int p = 0; p < 4; ++p) {
            const int c = lane & 15; f32x4 rr[4];
#pragma unroll
            for (int q = 0; q < 4; ++q) { const int r = wid * 32 + q * 4 + (lane >> 4); rr[q] = *(const f32x4*)(res + (size_t)(m0 + r) * DM + n0 + 64 * p + 4 * c); }
            if (wn == p) {
#pragma unroll
                for (int mb = 0; mb < MB; ++mb) { const int r = wm * 128 + mb * 32 + r32;
#pragma unroll
                    for (int nb = 0; nb < NB; ++nb)
#pragma unroll
                        for (int g = 0; g < 4; ++g) { const int cc = nb * 8 + 2 * g + hi;
                            *(f32x4*)(stage + r * 256 + ((cc ^ (r & 15)) * 16)) = (f32x4){acc[nb][mb][4 * g], acc[nb][mb][4 * g + 1], acc[nb][mb][4 * g + 2], acc[nb][mb][4 * g + 3]}; } }
            }
            asm volatile("s_waitcnt lgkmcnt(0)\n\ts_barrier" ::: "memory");
#pragma unroll 1
            for (int hq = 0; hq < 2; ++hq) {
                if (hq) {
#pragma unroll
                    for (int q = 0; q < 4; ++q) { const int r = wid * 32 + (4 + q) * 4 + (lane >> 4); rr[q] = *(const f32x4*)(res + (size_t)(m0 + r) * DM + n0 + 64 * p + 4 * c); }
                }
#pragma unroll
                for (int q = 0; q < 4; ++q) { const int r = wid * 32 + (4 * hq + q) * 4 + (lane >> 4); const size_t o = (size_t)(m0 + r) * DM + n0 + 64 * p + 4 * c;
                    f32x4 v = *(const f32x4*)(stage + r * 256 + ((c ^ (r & 15)) * 16));
                    v[0] += rr[q][0]; v[1] += rr[q][1]; v[2] += rr[q][2]; v[3] += rr[q][3];
                    *(f32x4*)(out + o) = v; *(u32x2*)(xb + o) = (u32x2){pk2(v[0], v[1]), pk2(v[2], v[3])};
                    float ssq = (v[0] * v[0] + v[1] * v[1]) + (v[2] * v[2] + v[3] * v[3]);
                    ssq += __shfl_xor(ssq, 1); ssq += __shfl_xor(ssq, 2); ssq += __shfl_xor(ssq, 4); ssq += __shfl_xor(ssq, 8);
                    if (c == 0) part[(size_t)(m0 + r) * 16 + (n0 >> 6) + p] = ssq; }
            }
            asm volatile("s_waitcnt lgkmcnt(0)\n\ts_barrier" ::: "memory");
        }
    }
    template <int NB, int MB> DI void run(f32x16 (&acc)[NB][MB], int mb0, int nb0, int r32, int hi, const float*, int tag = 0) const {
#pragma unroll
        for (int mb = 0; mb < MB; ++mb) { const int row = mb0 + mb * 32 + r32; float ssq = 0.f;
#pragma unroll
            for (int nb = 0; nb < NB; ++nb)
                { u32x2 w[4];
#pragma unroll
                for (int g = 0; g < 4; ++g) { const int col = nb0 + nb * 32 + 8 * g + 4 * hi; const size_t o = (size_t)row * DM + col;
                    f32x4 v = *(const f32x4*)(res + o);
                    v[0] += acc[nb][mb][4 * g]; v[1] += acc[nb][mb][4 * g + 1]; v[2] += acc[nb][mb][4 * g + 2]; v[3] += acc[nb][mb][4 * g + 3];
                    *(f32x4*)(out + o) = v; ssq += (v[0] * v[0] + v[1] * v[1]) + (v[2] * v[2] + v[3] * v[3]);
                    w[g] = (u32x2){pk2(v[0], v[1]), pk2(v[2], v[3])}; }
                bf16_t* blk = xb + (size_t)row * DM + nb0 + nb * 32;
                store_pair16(blk, hi, 0, w[0], w[1]); store_pair16(blk, hi, 2, w[2], w[3]); }
            ssq += __shfl_xor(ssq, 32);
            if (hi == 0) part[(size_t)row * 16 + (nb0 >> 6)] = ssq; }
    }
};
struct EpiSoftmax {
    bf16_t* P; float* xch;
    template <int NB, int MB> DI void run(f32x16 (&acc)[NB][MB], int mb0, int nb0, int r32, int hi, const float* rs, int tag = 0) const {
        const int row = mb0 + r32; const float sc = rs[r32]; const int wm = (mb0 >> 5) & 1, wn = (nb0 >> 7) & 1;
        float m = -3.0e38f;
#pragma unroll
        for (int nb = 0; nb < NB; ++nb)
#pragma unroll
            for (int r = 0; r < 16; ++r) { acc[nb][0][r] *= sc; m = fmaxf(m, acc[nb][0][r]); }
        m = fmaxf(m, __shfl_xor(m, 32));
        if (hi == 0) xch[(wm * 2 + wn) * 32 + r32] = m;
        __syncthreads();
        m = fmaxf(m, xch[(wm * 2 + (wn ^ 1)) * 32 + r32]);
        float s = 0.f;
#pragma unroll
        for (int nb = 0; nb < NB; ++nb)
#pragma unroll
            for (int r = 0; r < 16; ++r) { const float p = __builtin_amdgcn_exp2f(acc[nb][0][r] - m); acc[nb][0][r] = p; s += p; }
        s += __shfl_xor(s, 32);
        if (hi == 0) xch[128 + (wm * 2 + wn) * 32 + r32] = s;
        __syncthreads();
        s += xch[128 + (wm * 2 + (wn ^ 1)) * 32 + r32];
        const float inv = 1.0f / s;
#pragma unroll
        for (int nb = 0; nb < NB; ++nb)
#pragma unroll
            for (int g = 0; g < 4; ++g) { const int col = nb0 + nb * 32 + 8 * g + 4 * hi;
                *(u32x2*)(P + (size_t)row * DM + col) = (u32x2){pk2(acc[nb][0][4 * g] * inv, acc[nb][0][4 * g + 1] * inv), pk2(acc[nb][0][4 * g + 2] * inv, acc[nb][0][4 * g + 3] * inv)}; }
    }
};
struct EpiSoftmax256 {
    bf16_t* P; float* xch;
    template <int NB, int MB> DI void run(f32x16 (&acc)[NB][MB], int mb0, int nb0, int r32, int hi, const float* rs, int tag = 0) const {
        const int wn = (nb0 >> 6) & 3, lr0 = (mb0 & 255) + r32;
#pragma unroll
        for (int mb = 0; mb < MB; ++mb) { const float sc = rs[mb * 32 + r32]; float m = -3.0e38f;
#pragma unroll
            for (int nb = 0; nb < NB; ++nb)
#pragma unroll
                for (int r = 0; r < 16; ++r) { acc[nb][mb][r] *= sc; m = fmaxf(m, acc[nb][mb][r]); }
            m = fmaxf(m, __shfl_xor(m, 32));
            if (hi == 0) xch[(lr0 + mb * 32) * 4 + wn] = m; }
        __syncthreads();
#pragma unroll
        for (int mb = 0; mb < MB; ++mb) { const f32x4 mm = *(const f32x4*)(xch + (lr0 + mb * 32) * 4); const float m = fmaxf(fmaxf(mm[0], mm[1]), fmaxf(mm[2], mm[3])); float sm = 0.f;
#pragma unroll
            for (int nb = 0; nb < NB; ++nb)
#pragma unroll
                for (int r = 0; r < 16; ++r) { const float p = __builtin_amdgcn_exp2f(acc[nb][mb][r] - m); acc[nb][mb][r] = p; sm += p; }
            sm += __shfl_xor(sm, 32);
            if (hi == 0) xch[1024 + (lr0 + mb * 32) * 4 + wn] = sm; }
        __syncthreads();
#pragma unroll
        for (int mb = 0; mb < MB; ++mb) { const f32x4 sv = *(const f32x4*)(xch + 1024 + (lr0 + mb * 32) * 4); const float inv = __builtin_amdgcn_rcpf((sv[0] + sv[1]) + (sv[2] + sv[3]));
            const int row = mb0 + mb * 32 + r32;
#pragma unroll
            for (int nb = 0; nb < NB; ++nb) { u32x2 w[4];
#pragma unroll
                for (int g = 0; g < 4; ++g) w[g] = (u32x2){pk2(acc[nb][mb][4 * g] * inv, acc[nb][mb][4 * g + 1] * inv), pk2(acc[nb][mb][4 * g + 2] * inv, acc[nb][mb][4 * g + 3] * inv)};
                bf16_t* blk = P + (size_t)row * DM + nb0 + nb * 32;
                store_pair16(blk, hi, 0, w[0], w[1]); store_pair16(blk, hi, 2, w[2], w[3]); } }
    }
};
constexpr float QSCALE = 0.10206207261596575f * LOG2E;
struct EpiQ {
    bf16_t* Q; const float* cs; const float* sn;
    template <int NB, int MB> DI void run(f32x16 (&acc)[NB][MB], int mb0, int nb0, int r32, int hi, const float* rs, int tag = 0) const {
#pragma unroll
        for (int mb = 0; mb < MB; ++mb) { const int row = mb0 + mb * 32 + r32; const float sc = rs[mb * 32 + r32] * QSCALE; const int b = row >> 13, s = row & 8191;
#pragma unroll
            for (int nb = 0; nb < NB; ++nb) { const int cb = nb0 + nb * 32; const int h = cb / 96, d0 = cb - h * 96;
                float v[16];
#pragma unroll
                for (int r = 0; r < 16; ++r) v[r] = acc[nb][mb][r] * sc;
                if (d0 == 64) {
#pragma unroll
                    for (int g = 0; g < 2; ++g) { const f32x4 c = *(const f32x4*)(cs + (size_t)row * 16 + 8 * g + 4 * hi), sv = *(const f32x4*)(sn + (size_t)row * 16 + 8 * g + 4 * hi);
#pragma unroll
                        for (int j = 0; j < 4; ++j) { const float x1 = v[4 * g + j], x2 = v[4 * (g + 2) + j]; v[4 * g + j] = x1 * c[j] - x2 * sv[j]; v[4 * (g + 2) + j] = x2 * c[j] + x1 * sv[j]; } }
                }
                bf16_t* qp = Q + ((size_t)(b * 8 + h) * SEQ + s) * 96 + d0 + 4 * hi;
#pragma unroll
                for (int g = 0; g < 4; ++g) *(u32x2*)(qp + 8 * g) = (u32x2){pk2(v[4 * g], v[4 * g + 1]), pk2(v[4 * g + 2], v[4 * g + 3])}; } }
    }
};
struct EpiKV {
    bf16_t* Kimg; bf16_t* Vimg; const bf16_t* U; const float* cs; const float* sn;
    template <int NB, int MB> DI void run(f32x16 (&acc)[NB][MB], int mb0, int nb0, int r32, int hi, const float* rs, int tag = 0) const {
        const int h = nb0 >> 7, isv = (nb0 >> 6) & 1;
#pragma unroll
        for (int mb = 0; mb < MB; ++mb) { const int row = mb0 + mb * 32 + r32; const float sc = rs[mb * 32 + r32]; const int b = row >> 13, s = row & 8191, tile = s >> 6, rin = s & 63;
            const size_t tb = (size_t)(b * 8 + h) * 128 + tile;
#pragma unroll
            for (int nb = 0; nb < NB; ++nb)
#pragma unroll
                for (int g = 0; g < 4; ++g) { const u32x2 w = (u32x2){pk2(acc[nb][mb][4 * g] * sc, acc[nb][mb][4 * g + 1] * sc), pk2(acc[nb][mb][4 * g + 2] * sc, acc[nb][mb][4 * g + 3] * sc)};
                    if (!isv) *(u32x2*)(Kimg + (tb * 12 + nb * 4 + g) * 512 + rin * 8 + 4 * hi) = w;
                    else *(u32x2*)(Vimg + (tb * 2 + nb) * 2048 + rin * 32 + 8 * g + 4 * hi) = w; }
            if (!isv) {
                const u32x4 a = *(const u32x4*)(U + (size_t)row * NIN + UC_KR + 8 * hi), bq = *(const u32x4*)(U + (size_t)row * NIN + UC_KR + 16 + 8 * hi);
                unsigned w1[4], w2[4];
#pragma unroll
                for (int p = 0; p < 2; ++p) {
                    const f32x4 c = *(const f32x4*)(cs + (size_t)row * 16 + 8 * hi + 4 * p), sv = *(const f32x4*)(sn + (size_t)row * 16 + 8 * hi + 4 * p);
                    const float x1a = bflo(a[2 * p]), x1b = bfhi(a[2 * p]), x1c = bflo(a[2 * p + 1]), x1d = bfhi(a[2 * p + 1]);
                    const float x2a = bflo(bq[2 * p]), x2b = bfhi(bq[2 * p]), x2c = bflo(bq[2 * p + 1]), x2d = bfhi(bq[2 * p + 1]);
                    w1[2 * p] = pk2(x1a * c[0] - x2a * sv[0], x1b * c[1] - x2b * sv[1]); w1[2 * p + 1] = pk2(x1c * c[2] - x2c * sv[2], x1d * c[3] - x2d * sv[3]);
                    w2[2 * p] = pk2(x2a * c[0] + x1a * sv[0], x2b * c[1] + x1b * sv[1]); w2[2 * p + 1] = pk2(x2c * c[2] + x1c * sv[2], x2d * c[3] + x1d * sv[3]);
                }
                *(u32x4*)(Kimg + (tb * 12 + 8 + hi) * 512 + rin * 8) = (u32x4){w1[0], w1[1], w1[2], w1[3]};
                *(u32x4*)(Kimg + (tb * 12 + 10 + hi) * 512 + rin * 8) = (u32x4){w2[0], w2[1], w2[2], w2[3]};
            } }
    }
};

struct EpiStage1 {
    EpiKV kv; EpiQ q; bf16_t* wqkt; bf16_t* vwot;
    template <int NB, int MB> DI void run(f32x16 (&acc)[NB][MB], int mb0, int nb0, int r32, int hi, const float* rs, int tag = 0) const {
        const int kind = tag & 3, b = (tag >> 2) & 1, h = (tag >> 3) & 3;
        if (kind == 0) kv.template run<NB, MB>(acc, mb0, nb0, r32, hi, rs);
        else if (kind == 1) q.template run<NB, MB>(acc, mb0, nb0, r32, hi, rs);
        else if (kind == 2) { EpiPlain<false> e{wqkt + (size_t)b * 1048576, 1024, h * 256 - b * 256, 0, 0.0625f * LOG2E}; e.template run<NB, MB>(acc, mb0, nb0, r32, hi, rs); }
        else { EpiPlain<false> e{vwot + (size_t)b * 1048576, 1024, 0, h * 256, 1.0f}; e.template run<NB, MB>(acc, mb0, nb0, r32, hi, rs); }
    }
};

DI void convT_tiles(const float* __restrict__ src, int srcld, int K, int N, bf16_t* __restrict__ dst, int dstld, const float* __restrict__ gain, float* tl, int& base) {
    int tid_ = threadIdx.x & 255; asm volatile("" : "+v"(tid_));
    const int G = VGRID(), tid = tid_; const int tn = (N + 63) >> 6, tiles = (K >> 6) * tn;
    int start = (VBID() - base) % G; if (start < 0) start += G;
    const int niter = (tiles + G - 1) / G;
    for (int itr = 0; itr < niter; ++itr) {
        const int t = start + itr * G; const bool valid = t < tiles;
        const int k0 = valid ? (t / tn) * 64 : 0, n0 = valid ? (t % tn) * 64 : 0;
        __syncthreads();
        if (valid) {
#pragma unroll
        for (int i = 0; i < 4; ++i) { const int k = (tid >> 4) + 16 * i, nn = (tid & 15) * 4; const float g = gain ? gain[k0 + k] : 1.0f;
            f32x4 v = (f32x4){0.f, 0.f, 0.f, 0.f};
            if (n0 + nn + 3 < N) v = *(const f32x4*)(src + (size_t)(k0 + k) * srcld + n0 + nn);
            tl[k * 65 + nn] = v[0] * g; tl[k * 65 + nn + 1] = v[1] * g; tl[k * 65 + nn + 2] = v[2] * g; tl[k * 65 + nn + 3] = v[3] * g; }
        }
        __syncthreads();
        const int n = tid >> 2, ks = (tid & 3) * 16;
        if (valid && n0 + n < N) { unsigned w[8];
#pragma unroll
            for (int q = 0; q < 8; ++q) w[q] = pk2(tl[(ks + 2 * q) * 65 + n], tl[(ks + 2 * q + 1) * 65 + n]);
            bf16_t* d = dst + (size_t)(n0 + n) * dstld + k0 + ks;
            *(u32x4*)d = (u32x4){w[0], w[1], w[2], w[3]}; *(u32x4*)(d + 8) = (u32x4){w[4], w[5], w[6], w[7]}; }
    }
    base = (base + tiles) % G;
}
DI void convert_layer_weights(const Ctx& P, int l, float* tl) {
    bf16_t* W = (bf16_t*)(P.ws + ((l & 1) ? WS_WB1 : WS_WB0));
    int base = 0;
    const float* w_in = P.in[4] + (size_t)l * 1024 * 1700; const float* g_mix = P.in[3] + l * 1024;
    const int seg_src[10] = {0, 256, 384, 1184, 416, 672, 928, 1056, 1188, 1444};
    const int seg_w[10] = {256, 128, 32, 4, 256, 256, 128, 128, 256, 256};
    const int seg_dst[10] = {UC_CQ, UC_CKV, UC_KR, UC_DT, UC_Z, UC_XS, UC_BS, UC_CS, UC_XR, UC_GATE};
#pragma unroll
    for (int s = 0; s < 10; ++s) convT_tiles(w_in + seg_src[s], 1700, 1024, seg_w[s], W + WO_IN + (size_t)seg_dst[s] * 1024, 1024, g_mix, tl, base);
    {
        const size_t n = (size_t)92 * 1024 / 8; u32x4* z = (u32x4*)(W + WO_IN + (size_t)420 * 1024);
        int t_ = threadIdx.x & 255; asm volatile("" : "+v"(t_));
        for (size_t i = (size_t)VBID() * 256 + t_; i < n; i += (size_t)VGRID() * 256) z[i] = (u32x4){0u, 0u, 0u, 0u};
    }
    convT_tiles(P.in[7] + (size_t)l * 256 * 768, 768, 256, 768, W + WO_UQ, 256, P.in[5] + l * 256, tl, base);
    convT_tiles(P.in[8] + (size_t)l * 128 * 1024, 1024, 128, 1024, W + WO_UKV, 128, P.in[6] + l * 128, tl, base);
    convT_tiles(P.in[24] + (size_t)l * 1048576, 1024, 512, 1024, W + WO_OUT, 1024, P.in[9] + l * 512, tl, base);
    convT_tiles(P.in[24] + (size_t)l * 1048576 + (size_t)512 * 1024, 1024, 256, 1024, W + WO_OUT + 512, 1024, P.in[15] + l * 256, tl, base);
    convT_tiles(P.in[24] + (size_t)l * 1048576 + (size_t)768 * 1024, 1024, 256, 1024, W + WO_OUT + 768, 1024, P.in[23] + l * 256, tl, base);
    convT_tiles(P.in[28] + (size_t)l * 1048576, 1024, 1024, 1024, W + WO_MK, 1024, P.in[26] + l * 1024, tl, base);
    convT_tiles(P.in[29] + (size_t)l * 1048576, 1024, 1024, 1024, W + WO_MV, 1024, P.in[26] + l * 1024, tl, base);
    convT_tiles(P.in[30] + (size_t)l * 1048576, 1024, 1024, 1024, W + WO_MO, 1024, nullptr, tl, base);
    convT_tiles(P.in[32] + (size_t)l * 4194304, 4096, 1024, 4096, W + WO_1, 1024, P.in[31] + l * 1024, tl, base);
    convT_tiles(P.in[33] + (size_t)l * 4194304, 1024, 4096, 1024, W + WO_2, 4096, nullptr, tl, base);
    for (int n = 0; n < 4; ++n) {
        convT_tiles(P.in[18] + (size_t)(l * 4 + n) * 4096, 64, 64, 64, W + WO_A + n * 4096, 64, nullptr, tl, base);
        convT_tiles(P.in[20] + (size_t)(l * 4 + n) * 4096, 64, 64, 64, W + WO_I + n * 4096, 64, nullptr, tl, base);
    }
    {
        const float* src = P.in[27] + (size_t)l * 1048576; const float* g = P.in[25] + l * 1024; bf16_t* d = W + WO_MQ;
        int t_ = threadIdx.x & 255; asm volatile("" : "+v"(t_));
        for (size_t i = (size_t)VBID() * 256 + t_; i < 131072; i += (size_t)VGRID() * 256) {
            const float gg = g[i >> 7]; const f32x4 a = *(const f32x4*)(src + i * 8), b = *(const f32x4*)(src + i * 8 + 4);
            *(u32x4*)(d + i * 8) = (u32x4){pk2(a[0] * gg, a[1] * gg), pk2(a[2] * gg, a[3] * gg), pk2(b[0] * gg, b[1] * gg), pk2(b[2] * gg, b[3] * gg)}; }
    }
}
DI void phase_prologue(const Ctx& P, char* smem) {
    convert_layer_weights(P, 0, (float*)smem);
    int t_ = threadIdx.x & 255; asm volatile("" : "+v"(t_));
    const size_t gt = (size_t)VBID() * 256 + t_, gs = (size_t)VGRID() * 256;
    {   const float* x = P.in[0]; bf16_t* xb = (bf16_t*)(P.ws + WS_XB); float* part = (float*)(P.ws + WS_PART);
        const int lane = t_ & 63, wid = t_ >> 6;
        for (int row = VBID() * 4 + wid; row < T; row += VGRID() * 4) { float ss = 0.f;
#pragma unroll
            for (int i = 0; i < 4; ++i) { const size_t o = (size_t)row * DM + i * 256 + lane * 4; const f32x4 a = *(const f32x4*)(x + o);
                ss += (a[0] * a[0] + a[1] * a[1]) + (a[2] * a[2] + a[3] * a[3]); *(u32x2*)(xb + o) = (u32x2){pk2(a[0], a[1]), pk2(a[2], a[3])}; }
#pragma unroll
            for (int d = 1; d < 64; d <<= 1) ss += __shfl_xor(ss, d);
            if (lane < 16) part[(size_t)row * 16 + lane] = lane == 0 ? ss : 0.f; } }
    {   const float* x = P.in[1]; bf16_t* xb = (bf16_t*)(P.ws + WS_MEMB); float* part = (float*)(P.ws + WS_PART) + (size_t)T * 16;
        const int lane = t_ & 63, wid = t_ >> 6;
        for (int row = VBID() * 4 + wid; row < 512; row += VGRID() * 4) { float ss = 0.f;
#pragma unroll
            for (int i = 0; i < 4; ++i) { const size_t o = (size_t)row * DM + i * 256 + lane * 4; const f32x4 a = *(const f32x4*)(x + o);
                ss += (a[0] * a[0] + a[1] * a[1]) + (a[2] * a[2] + a[3] * a[3]); *(u32x2*)(xb + o) = (u32x2){pk2(a[0], a[1]), pk2(a[2], a[3])}; }
#pragma unroll
            for (int d = 1; d < 64; d <<= 1) ss += __shfl_xor(ss, d);
            if (lane < 16) part[(size_t)row * 16 + lane] = lane == 0 ? ss : 0.f; } }
    {   const int* pos = (const int*)P.in[2]; float* cs = (float*)(P.ws + WS_COS); float* sn = (float*)(P.ws + WS_SIN);
        for (size_t i = gt; i < (size_t)T * 16; i += gs) { const int tok = (int)(i >> 4), f = (int)(i & 15);
            const float inv = exp2f(-(float)f * (0.0625f * 13.287712379549449f));       const float ang = (float)pos[tok] * inv;
            double a = (double)ang; a -= 6.283185307179586 * rint(a * 0.15915494309189535);
            const float ar = (float)a; cs[i] = __cosf(ar); sn[i] = __sinf(ar); } }
}

DI void attn_item(const bf16_t* __restrict__ Q, const bf16_t* __restrict__ Kimg, const bf16_t* __restrict__ Vimg, bf16_t* __restrict__ Y, int bh, int qblk, int NTC, char* smem, int vb) {
    int tid_ = threadIdx.x & 255; asm volatile("" : "+v"(tid_));
    const int tid = tid_, lane = tid & 63, wid = tid >> 6, r32 = lane & 31, hi = lane >> 5;
    char* Kb = smem; char* Vb = smem + 36864; float* wsf = (float*)(smem + 61440 + vb * 17408) + wid * 64; bf16_t* stg = (bf16_t*)(smem + 61440 + vb * 17408 + 1024) + wid * 2048;
    const int gw = vb * 4 + wid;
    const int q0 = qblk * 128, NT = 2 * (qblk + 1);
    const int qrow = q0 + wid * 32 + r32;
    bf16x8 qr[6];
    { const bf16_t* qp = Q + ((size_t)bh * SEQ + qrow) * 96 + 8 * hi;
#pragma unroll
      for (int d0 = 0; d0 < 6; ++d0) qr[d0] = *(const bf16x8*)(qp + 16 * d0); }
    const bf16_t* kg = Kimg + (size_t)bh * 128 * 6144 + gw * 512 + lane * 8;
    const bf16_t* vg = Vimg + (size_t)bh * 128 * 4096 + gw * 512 + lane * 8;
    const unsigned ldsK = (unsigned)(uintptr_t)Kb + gw * 1024, ldsV = (unsigned)(uintptr_t)Vb + gw * 1024;
#define ATT_ISSUE(tt, st_) do { \
        glds16(kg + (size_t)(tt) * 6144, (unsigned)__builtin_amdgcn_readfirstlane((int)(ldsK + (st_) * 12288))); \
        if (gw < 4) glds16(kg + (size_t)(tt) * 6144 + 4096, (unsigned)__builtin_amdgcn_readfirstlane((int)(ldsK + (st_) * 12288 + 8192))); \
        glds16(vg + (size_t)(tt) * 4096, (unsigned)__builtin_amdgcn_readfirstlane((int)(ldsV + (st_) * 8192))); } while (0)
    __syncthreads();
    ATT_ISSUE(0, 0); ATT_ISSUE(1, 1);
    int sc = 0, s1 = 1, sn = 2;
    f32x16 o0, o1;
#pragma unroll
    for (int r = 0; r < 16; ++r) { o0[r] = 0.f; o1[r] = 0.f; }
    f32x16 ol;
#pragma unroll
    for (int r = 0; r < 16; ++r) ol[r] = 0.f;
    const bf16x8 ones = (bf16x8){0x3F80, 0x3F80, 0x3F80, 0x3F80, 0x3F80, 0x3F80, 0x3F80, 0x3F80};
    f32x16 negm;
#pragma unroll
    for (int r = 0; r < 16; ++r) negm[r] = 0.f;
    const char* vrd0 = Vb + ((lane >> 4) & 1) * 32 + (lane & 3) * 8 + (4 * hi + ((lane & 15) >> 2)) * 64;
#define ATT_QK(S0_, S1_, stg_) do { const char* kb_ = Kb + (stg_) * 12288 + r32 * 16; \
        { const bf16x8 k0 = *(const bf16x8*)(kb_ + hi * 1024), k1 = *(const bf16x8*)(kb_ + hi * 1024 + 512); S0_ = MFMA(k0, qr[0], negm); S1_ = MFMA(k1, qr[0], negm); } \
        _Pragma("unroll") for (int d0 = 1; d0 < 6; ++d0) { const bf16x8 k0 = *(const bf16x8*)(kb_ + (2 * d0 + hi) * 1024), k1 = *(const bf16x8*)(kb_ + (2 * d0 + hi) * 1024 + 512); \
            S0_ = MFMA(k0, qr[d0], S0_); S1_ = MFMA(k1, qr[d0], S1_); } } while (0)
#define MX3_(a, b, c) __builtin_fmaxf(__builtin_fmaxf((a), (b)), (c))
#define ATT_STEP(A0, A1, B0, B1, tt_) do { const int t = (tt_); \
        if (t + 1 < NTC) asm volatile("s_waitcnt vmcnt(0)\n\ts_barrier" ::: "memory");       \
        if (t + 2 < NTC) ATT_ISSUE(t + 2, sn); \
        const bool actN = (t + 1 < NT) && !(t + 1 == NT - 1 && wid < 2);                       \
        if (actN) ATT_QK(B0, B1, s1); \
        const bool actT = (t < NT) && !(t == NT - 1 && wid < 2); \
        if (actT) { \
            if (t >= NT - 2) { const int kbase = t * 64 + 4 * hi; \
                _Pragma("unroll") for (int r = 0; r < 16; ++r) { const int kv = kbase + (r & 3) + 8 * (r >> 2); if (kv > qrow) A0[r] = -INFINITY; if (kv + 32 > qrow) A1[r] = -INFINITY; } } \
            float ra_ = MX3_(A0[0], A0[1], A1[0]), rb_ = MX3_(A0[2], A0[3], A1[1]); ra_ = MX3_(ra_, A1[2], A1[3]); \
            _Pragma("unroll") for (int r = 4; r < 16; r += 4) { ra_ = MX3_(ra_, A0[r], A0[r + 1]); rb_ = MX3_(rb_, A0[r + 2], A0[r + 3]); ra_ = MX3_(ra_, A1[r], A1[r + 1]); rb_ = MX3_(rb_, A1[r + 2], A1[r + 3]); } \
            float rm = fmaxf(ra_, rb_); rm = fmaxf(rm, __shfl_xor(rm, 32));                    \
            const bool first = (t == 0);                                                       \
            if (first || __any(rm > 8.0f)) { \
                const float dl = first ? rm : fmaxf(rm, 0.f); const float f = __builtin_amdgcn_exp2f(-dl); \
                if (hi == 0) wsf[r32] = f; \
                asm volatile("s_waitcnt lgkmcnt(0)" ::: "memory"); \
                _Pragma("unroll") for (int g = 0; g < 4; ++g) { const f32x4 fv = *(const f32x4*)(wsf + 8 * g + 4 * hi); \
                    _Pragma("unroll") for (int j = 0; j < 4; ++j) { o0[4 * g + j] *= fv[j]; o1[4 * g + j] *= fv[j]; ol[4 * g + j] *= fv[j]; } } \
                const float nm = negm[0] - dl; \
                _Pragma("unroll") for (int r = 0; r < 16; ++r) { A0[r] -= dl; A1[r] -= dl; negm[r] = nm; } \
                if (actN) { _Pragma("unroll") for (int r = 0; r < 16; ++r) { B0[r] -= dl; B1[r] -= dl; } }     \
            } \
            _Pragma("unroll") for (int r = 0; r < 16; ++r) { A0[r] = __builtin_amdgcn_exp2f(A0[r]); A1[r] = __builtin_amdgcn_exp2f(A1[r]); } \
            bf16x8 pw[4]; \
            { u32x4 w; \
              w = (u32x4){pk2(A0[0], A0[1]), pk2(A0[2], A0[3]), pk2(A0[4], A0[5]), pk2(A0[6], A0[7])}; pw[0] = __builtin_bit_cast(bf16x8, w); \
              w = (u32x4){pk2(A0[8], A0[9]), pk2(A0[10], A0[11]), pk2(A0[12], A0[13]), pk2(A0[14], A0[15])}; pw[1] = __builtin_bit_cast(bf16x8, w); \
              w = (u32x4){pk2(A1[0], A1[1]), pk2(A1[2], A1[3]), pk2(A1[4], A1[5]), pk2(A1[6], A1[7])}; pw[2] = __builtin_bit_cast(bf16x8, w); \
              w = (u32x4){pk2(A1[8], A1[9]), pk2(A1[10], A1[11]), pk2(A1[12], A1[13]), pk2(A1[14], A1[15])}; pw[3] = __builtin_bit_cast(bf16x8, w); } \
            const char* vp = vrd0 + sc * 8192; \
            _Pragma("unroll") for (int s = 0; s < 4; ++s) { \
                const bf16x8 v0 = cat8(tr_read(vp + s * 1024), tr_read(vp + s * 1024 + 512)); \
                const bf16x8 v1 = cat8(tr_read(vp + 4096 + s * 1024), tr_read(vp + 4096 + s * 1024 + 512)); \
                o0 = MFMA(pw[s], v0, o0); o1 = MFMA(pw[s], v1, o1); ol = MFMA(pw[s], ones, ol); } \
        } \
        { const int o_ = sc; sc = s1; s1 = sn; sn = o_; } } while (0)
    f32x16 sa0, sa1, sb0, sb1;
    asm volatile("s_waitcnt vmcnt(0)\n\ts_barrier" ::: "memory");
    ATT_QK(sa0, sa1, 0);
    for (int t2 = 0; t2 < NTC; t2 += 2) {
        ATT_STEP(sa0, sa1, sb0, sb1, t2);
        ATT_STEP(sb0, sb1, sa0, sa1, t2 + 1);
    }
#undef ATT_STEP
#undef ATT_QK
#undef MX3_
#undef ATT_ISSUE
#pragma unroll
    for (int g = 0; g < 4; ++g)
#pragma unroll
        for (int j = 0; j < 4; ++j) { const float inv = 1.0f / ol[4 * g + j]; const int orow = 8 * g + 4 * hi + j;
            stg[orow * 64 + r32] = (bf16_t)(pk2(o0[4 * g + j] * inv, 0.f) & 0xffffu); stg[orow * 64 + 32 + r32] = (bf16_t)(pk2(o1[4 * g + j] * inv, 0.f) & 0xffffu); }
    asm volatile("s_waitcnt lgkmcnt(0)" ::: "memory");
    const int b = bh >> 3, h = bh & 7;
    bf16_t* yp = Y + ((size_t)b * SEQ + q0 + wid * 32) * 512 + h * 64;
#pragma unroll
    for (int i = 0; i < 4; ++i) { const int row = i * 8 + (lane >> 3), ch = lane & 7; *(u32x4*)(yp + (size_t)row * 512 + ch * 8) = *(const u32x4*)(stg + row * 64 + ch * 8); }
}

template <int CW, int N8, bool ACT> DI void conv_row(const bf16_t* __restrict__ U, int tok, int tin, int col, const float* __restrict__ cw, const float* __restrict__ cb, int ch, float (&o)[8 * N8]) {
#pragma unroll
    for (int q = 0; q < N8; ++q) {
        float a[8];
        const f32x4 b0 = *(const f32x4*)(cb + ch + 8 * q), b1 = *(const f32x4*)(cb + ch + 8 * q + 4);
#pragma unroll
        for (int j = 0; j < 4; ++j) { a[j] = b0[j]; a[4 + j] = b1[j]; }
#pragma unroll
        for (int k = 0; k < 4; ++k) {
            if (tin - 3 + k >= 0) {
                const u32x4 u = *(const u32x4*)(U + (size_t)(tok - 3 + k) * NIN + col + 8 * q);
                const f32x4 w0 = *(const f32x4*)(cw + (size_t)k * CW + ch + 8 * q), w1 = *(const f32x4*)(cw + (size_t)k * CW + ch + 8 * q + 4);
                a[0] += w0[0] * bflo(u[0]); a[1] += w0[1] * bfhi(u[0]); a[2] += w0[2] * bflo(u[1]); a[3] += w0[3] * bfhi(u[1]);
                a[4] += w1[0] * bflo(u[2]); a[5] += w1[1] * bfhi(u[2]); a[6] += w1[2] * bflo(u[3]); a[7] += w1[3] * bfhi(u[3]);
            }
        }
#pragma unroll
        for (int j = 0; j < 8; ++j) o[8 * q + j] = ACT ? siluf_(a[j]) : a[j];
    }
}
DI void ssd_local_item(const Ctx& P, int l, int item, char* smem) {
    int tid_ = threadIdx.x & 255; asm volatile("" : "+v"(tid_));
    const int tid = tid_, lane = tid & 63, wid = tid >> 6, r32 = lane & 31, hi = lane >> 5;
    const int h = item & 3, c = (item >> 2) & 63, b = item >> 8, g = h >> 1;
    const int tok0 = b * SEQ + c * 128, tin0 = c * 128;
    const bf16_t* U = (const bf16_t*)(P.ws + AR_U);
    const float* cw = P.in[10] + (size_t)l * 4 * 512; const float* cb = P.in[11] + l * 512;
    char* Btr = smem; char* Xtr = smem + 16384; float* acs = (float*)(smem + 32768); float* dts = acs + 128; float* wts = dts + 128; float* tot = wts + 128;
    __syncthreads();
    if (tid < 128) {
        const float dtr = ((const float*)(P.ws + WS_DTRAW))[(size_t)(tok0 + tid) * 4 + h];
        const float dt = softplus_fast(dtr + P.in[12][l * 4 + h]);
        float v = -__expf(P.in[13][l * 4 + h]) * dt;
#pragma unroll
        for (int d = 1; d < 64; d <<= 1) { const float u = __shfl_up(v, d); if (lane >= d) v += u; }
        dts[tid] = dt; acs[tid] = v;
        if (tid == 63) tot[0] = v;
    }
    __syncthreads();
    if (tid >= 64 && tid < 128) acs[tid] += tot[0];
    __syncthreads();
    if (tid < 128) {
        const float ac = acs[tid], ae = acs[127];
        wts[tid] = __expf(ae - ac);
        ((float*)(P.ws + WS_ACUM))[(size_t)(tok0 + tid) * 4 + h] = ac;
        if (tid == 127) ((float*)(P.ws + WS_ATOT))[(b * 4 + h) * 64 + c] = ae;
    }
    {
        const int row = tid >> 1, half = tid & 1; float o[32];
        conv_row<512, 4, true>(U, tok0 + row, tin0 + row, UC_BS + g * 64 + half * 32, cw, cb, 256 + g * 64 + half * 32, o);
#pragma unroll
        for (int q = 0; q < 4; ++q) *(u32x4*)(Btr + half * 8192 + row * 64 + q * 16) = (u32x4){pk2(o[8 * q], o[8 * q + 1]), pk2(o[8 * q + 2], o[8 * q + 3]), pk2(o[8 * q + 4], o[8 * q + 5]), pk2(o[8 * q + 6], o[8 * q + 7])};
        conv_row<512, 4, true>(U, tok0 + row, tin0 + row, UC_XS + h * 64 + half * 32, cw, cb, h * 64 + half * 32, o);
        const float dt = dts[row];
#pragma unroll
        for (int q = 0; q < 4; ++q) *(u32x4*)(Xtr + half * 8192 + row * 64 + q * 16) = (u32x4){pk2(o[8 * q] * dt, o[8 * q + 1] * dt), pk2(o[8 * q + 2] * dt, o[8 * q + 3] * dt), pk2(o[8 * q + 4] * dt, o[8 * q + 5] * dt), pk2(o[8 * q + 6] * dt, o[8 * q + 7] * dt)};
    }
    bf16x8 cf[4];
    {
        const int row = wid * 32 + r32;
#pragma unroll
        for (int d0 = 0; d0 < 4; ++d0) { float o[8];
            conv_row<512, 1, true>(U, tok0 + row, tin0 + row, UC_CS + g * 64 + 16 * d0 + 8 * hi, cw, cb, 384 + g * 64 + 16 * d0 + 8 * hi, o);
            const u32x4 w = (u32x4){pk2(o[0], o[1]), pk2(o[2], o[3]), pk2(o[4], o[5]), pk2(o[6], o[7])};
            cf[d0] = __builtin_bit_cast(bf16x8, w);
            if ((h & 1) == 0) *(u32x4*)((bf16_t*)(P.ws + AR_CC) + (size_t)(tok0 + row) * 128 + g * 64 + 16 * d0 + 8 * hi) = w; }
    }
    __syncthreads();
    f32x16 y0, y1;
#pragma unroll
    for (int r = 0; r < 16; ++r) { y0[r] = 0.f; y1[r] = 0.f; }
    const int lrow = wid * 32 + r32; const float acl = acs[lrow];
    const char* xrd = Xtr + ((lane >> 4) & 1) * 32 + (lane & 3) * 8 + (4 * hi + ((lane & 15) >> 2)) * 64;
    for (int sb = 0; sb <= wid; ++sb) {
        f32x16 gt;
#pragma unroll
        for (int r = 0; r < 16; ++r) gt[r] = 0.f;
#pragma unroll
        for (int d0 = 0; d0 < 4; ++d0) { const bf16x8 bfg = *(const bf16x8*)(Btr + (d0 >> 1) * 8192 + (sb * 32 + r32) * 64 + (d0 & 1) * 32 + hi * 16); gt = MFMA(bfg, cf[d0], gt); }
#pragma unroll
        for (int q = 0; q < 4; ++q) { const f32x4 av = *(const f32x4*)(acs + sb * 32 + 8 * q + 4 * hi);
#pragma unroll
            for (int j = 0; j < 4; ++j) { const int s = sb * 32 + 8 * q + 4 * hi + j; gt[4 * q + j] = (s <= lrow) ? gt[4 * q + j] * __expf(acl - av[j]) : 0.f; } }
        u32x4 w0 = (u32x4){pk2(gt[0], gt[1]), pk2(gt[2], gt[3]), pk2(gt[4], gt[5]), pk2(gt[6], gt[7])};
        u32x4 w1 = (u32x4){pk2(gt[8], gt[9]), pk2(gt[10], gt[11]), pk2(gt[12], gt[13]), pk2(gt[14], gt[15])};
        const bf16x8 p0 = __builtin_bit_cast(bf16x8, w0), p1 = __builtin_bit_cast(bf16x8, w1);
        const char* xp = xrd + sb * 2048;
        { const bf16x8 xa = cat8(tr_read(xp), tr_read(xp + 512)); y0 = MFMA(xa, p0, y0); }
        { const bf16x8 xa = cat8(tr_read(xp + 1024), tr_read(xp + 1024 + 512)); y0 = MFMA(xa, p1, y0); }
        { const bf16x8 xa = cat8(tr_read(xp + 8192), tr_read(xp + 8192 + 512)); y1 = MFMA(xa, p0, y1); }
        { const bf16x8 xa = cat8(tr_read(xp + 8192 + 1024), tr_read(xp + 8192 + 1024 + 512)); y1 = MFMA(xa, p1, y1); }
    }
    {
        const float dsk = P.in[14][l * 4 + h], idt = 1.0f / dts[lrow];
        bf16_t* yl = (bf16_t*)(P.ws + AR_YLOC) + (size_t)(tok0 + lrow) * 256 + h * 64;
#pragma unroll
        for (int pb = 0; pb < 2; ++pb)
#pragma unroll
            for (int q = 0; q < 4; ++q) { const u32x2 xv = *(const u32x2*)(Xtr + pb * 8192 + lrow * 64 + (8 * q + 4 * hi) * 2);
                const float f = dsk * idt; const f32x16& yy = pb ? y1 : y0;
                const float v0 = yy[4 * q] + f * bflo(xv[0]), v1 = yy[4 * q + 1] + f * bfhi(xv[0]), v2 = yy[4 * q + 2] + f * bflo(xv[1]), v3 = yy[4 * q + 3] + f * bfhi(xv[1]);
                *(u32x2*)(yl + pb * 32 + 8 * q + 4 * hi) = (u32x2){pk2(v0, v1), pk2(v2, v3)}; }
    }
    {
        const int pbk = wid >> 1, nbk = wid & 1;
        f32x16 st;
#pragma unroll
        for (int r = 0; r < 16; ++r) st[r] = 0.f;
        const int trow = 4 * hi + ((lane & 15) >> 2), tcol = ((lane >> 4) & 1) * 32 + (lane & 3) * 8;
#pragma unroll
        for (int ks = 0; ks < 8; ++ks) {
            const s16x4 xl = tr_read(Xtr + pbk * 8192 + (16 * ks + trow) * 64 + tcol), xh = tr_read(Xtr + pbk * 8192 + (16 * ks + 8 + trow) * 64 + tcol);
            const s16x4 bl = tr_read(Btr + nbk * 8192 + (16 * ks + trow) * 64 + tcol), bh2 = tr_read(Btr + nbk * 8192 + (16 * ks + 8 + trow) * 64 + tcol);
            const f32x4 wl = *(const f32x4*)(wts + 16 * ks + 4 * hi), wh = *(const f32x4*)(wts + 16 * ks + 8 + 4 * hi);
            float xf[8];
#pragma unroll
            for (int j = 0; j < 4; ++j) { xf[j] = __uint_as_float(((unsigned)(unsigned short)xl[j]) << 16) * wl[j]; xf[4 + j] = __uint_as_float(((unsigned)(unsigned short)xh[j]) << 16) * wh[j]; }
            const u32x4 xw = (u32x4){pk2(xf[0], xf[1]), pk2(xf[2], xf[3]), pk2(xf[4], xf[5]), pk2(xf[6], xf[7])};
            st = MFMA(__builtin_bit_cast(bf16x8, xw), cat8(bl, bh2), st);
        }
        float* sp = (float*)(P.ws + AR_STATES) + ((size_t)((b * 64 + c) * 4 + h) * 64 + pbk * 32) * 64 + nbk * 32 + r32;
#pragma unroll
        for (int r = 0; r < 16; ++r) sp[(size_t)crow(r, hi) * 64] = st[r];
    }
}

DI void lru_local_item(const Ctx& P, int l, int item, char* smem) {
    int tid_ = threadIdx.x & 255; asm volatile("" : "+v"(tid_));
    const int tid = tid_, lane = tid & 63, wid = tid >> 6, r32 = lane & 31, hi = lane >> 5;
    const int nb = item & 3, c = (item >> 2) & 63, b = item >> 8;
    const int tok0 = b * SEQ + c * 128, tin0 = c * 128;
    const bf16_t* U = (const bf16_t*)(P.ws + AR_U);
    const bf16_t* W = (const bf16_t*)(P.ws + ((l & 1) ? WS_WB1 : WS_WB0));
    float* xc = (float*)smem;
    float* totA = (float*)(smem + 34816); float* totH = totA + 256;
    __syncthreads();
    {
        const int row = tid >> 1, half = tid & 1; float o[32];
        conv_row<256, 4, false>(U, tok0 + row, tin0 + row, UC_XR + nb * 64 + half * 32, P.in[16] + (size_t)l * 4 * 256, P.in[17] + l * 256, nb * 64 + half * 32, o);
#pragma unroll
        for (int q = 0; q < 8; ++q) *(f32x4*)(xc + row * 68 + half * 32 + 4 * q) = (f32x4){o[4 * q], o[4 * q + 1], o[4 * q + 2], o[4 * q + 3]};
    }
    __syncthreads();
    const int row = wid * 32 + r32;
    bf16x8 xf[4];
#pragma unroll
    for (int d0 = 0; d0 < 4; ++d0) {
        const f32x4 a = *(const f32x4*)(xc + row * 68 + 16 * d0 + 8 * hi), bq = *(const f32x4*)(xc + row * 68 + 16 * d0 + 8 * hi + 4);
        const u32x4 xw = (u32x4){pk2(a[0], a[1]), pk2(a[2], a[3]), pk2(bq[0], bq[1]), pk2(bq[2], bq[3])};
        xf[d0] = __builtin_bit_cast(bf16x8, xw);
    }
    float Av[32], Hv[32];
    const float* ba = P.in[19] + l * 256 + nb * 64; const float* bi = P.in[21] + l * 256 + nb * 64; const float* lam = P.in[22] + l * 256 + nb * 64;
#pragma unroll
    for (int e = 0; e < 2; ++e) {
        f32x16 ar, ai;
#pragma unroll
        for (int r = 0; r < 16; ++r) { ar[r] = 0.f; ai[r] = 0.f; }
#pragma unroll
        for (int d0 = 0; d0 < 4; ++d0) {
            const bf16x8 wa = *(const bf16x8*)(W + WO_A + nb * 4096 + (e * 32 + r32) * 64 + 16 * d0 + 8 * hi);
            const bf16x8 wi = *(const bf16x8*)(W + WO_I + nb * 4096 + (e * 32 + r32) * 64 + 16 * d0 + 8 * hi);
            ar = MFMA(wa, xf[d0], ar); ai = MFMA(wi, xf[d0], ai);
        }
#pragma unroll
        for (int q = 0; q < 4; ++q) { const int ch = e * 32 + 8 * q + 4 * hi;
            const f32x4 bav = *(const f32x4*)(ba + ch), biv = *(const f32x4*)(bi + ch), lv = *(const f32x4*)(lam + ch), xv = *(const f32x4*)(xc + row * 68 + ch);
#pragma unroll
            for (int j = 0; j < 4; ++j) {
                const float rg = sigmoidf_(ar[4 * q + j] + bav[j]), ig = sigmoidf_(ai[4 * q + j] + biv[j]);
                const float la = -8.0f * rg * softplus_fast(-lv[j]);
                Av[e * 16 + 4 * q + j] = __expf(la);
                Hv[e * 16 + 4 * q + j] = __builtin_amdgcn_sqrtf(neg_expm1_fast(2.0f * la)) * (ig * xv[j]);
            } }
        asm volatile("" ::: "memory");
    }
#pragma unroll
    for (int d = 1; d < 32; d <<= 1) {
#pragma unroll
        for (int i = 0; i < 32; ++i) { const float ap = __shfl_up(Av[i], d, 32), hp = __shfl_up(Hv[i], d, 32); if (r32 >= d) { Hv[i] = Av[i] * hp + Hv[i]; Av[i] = Av[i] * ap; }
            if ((i & 7) == 7) __builtin_amdgcn_sched_barrier(0); }
    }
    if (r32 == 31) {
#pragma unroll
        for (int e = 0; e < 2; ++e)
#pragma unroll
            for (int q = 0; q < 4; ++q)
#pragma unroll
                for (int j = 0; j < 4; ++j) { const int ch = e * 32 + 8 * q + 4 * hi + j; totA[wid * 64 + ch] = Av[e * 16 + 4 * q + j]; totH[wid * 64 + ch] = Hv[e * 16 + 4 * q + j]; }
    }
    __syncthreads();
    float* carA = totH + 256 + wid * 64; float* carH = carA + 256;
    { float Ac = 1.f, Hc = 0.f;
      for (int w = 0; w < wid; ++w) { const float a2 = totA[w * 64 + lane], h2 = totH[w * 64 + lane]; Hc = a2 * Hc + h2; Ac = Ac * a2; }
      carA[lane] = Ac; carH[lane] = Hc; }
    asm volatile("s_waitcnt lgkmcnt(0)" ::: "memory");
    {
        bf16_t* hl = (bf16_t*)(P.ws + AR_HLOC) + (size_t)(tok0 + row) * 256 + nb * 64; bf16_t* ac = (bf16_t*)(P.ws + AR_ACP) + (size_t)(tok0 + row) * 256 + nb * 64;
#pragma unroll
        for (int e = 0; e < 2; ++e)
#pragma unroll
            for (int q = 0; q < 4; ++q) { const int ch = e * 32 + 8 * q + 4 * hi; float av[4], hv[4];
                const f32x4 ca = *(const f32x4*)(carA + ch), chv = *(const f32x4*)(carH + ch);
#pragma unroll
                for (int j = 0; j < 4; ++j) { const int i = e * 16 + 4 * q + j; hv[j] = Av[i] * chv[j] + Hv[i]; av[j] = Av[i] * ca[j]; }
                *(u32x2*)(hl + ch) = (u32x2){pk2(hv[0], hv[1]), pk2(hv[2], hv[3])};
                *(u32x2*)(ac + ch) = (u32x2){pk2(av[0], av[1]), pk2(av[2], av[3])};
                if (wid == 3 && r32 == 31) { float* he = (float*)(P.ws + WS_HEND) + (size_t)(b * 64 + c) * 256 + nb * 64 + ch; float* ae = (float*)(P.ws + WS_AEND) + (size_t)(b * 64 + c) * 256 + nb * 64 + ch;
                    *(f32x4*)he = (f32x4){hv[0], hv[1], hv[2], hv[3]}; *(f32x4*)ae = (f32x4){av[0], av[1], av[2], av[3]}; } }
    }
}

DI void carries(const Ctx& P, int bid) {
    int tid_ = threadIdx.x & 255; asm volatile("" : "+v"(tid_));
    const int tid = tid_;
    if (bid < 128) {
        const int idx = bid * 256 + tid;
        const int b = idx >> 14, h = (idx >> 12) & 3, e = idx & 4095;
        const float* st = (const float*)(P.ws + AR_STATES) + ((size_t)(b * 64) * 4 + h) * 4096 + e;
        bf16_t* so = (bf16_t*)(P.ws + AR_SIN) + ((size_t)(b * 64) * 4 + h) * 4096 + e;
        const float* at = (const float*)(P.ws + WS_ATOT) + (b * 4 + h) * 64;
        float S = 0.f;
        for (int c0 = 0; c0 < 64; c0 += 8) {
            float v[8], a[8];
#pragma unroll
            for (int j = 0; j < 8; ++j) { v[j] = st[(size_t)(c0 + j) * 16384]; a[j] = __expf(at[c0 + j]); }
#pragma unroll
            for (int j = 0; j < 8; ++j) { so[(size_t)(c0 + j) * 16384] = (bf16_t)(pk2(S, 0.f) & 0xffffu); S = a[j] * S + v[j]; }
        }
    } else if (bid < 130) {
        const int idx = (bid - 128) * 256 + tid;
        const int b = idx >> 8, ch = idx & 255;
        const float* he = (const float*)(P.ws + WS_HEND) + (size_t)b * 64 * 256 + ch; const float* ae = (const float*)(P.ws + WS_AEND) + (size_t)b * 64 * 256 + ch;
        float* hin = (float*)(P.ws + WS_HIN) + (size_t)b * 64 * 256 + ch;
        float Hc = 0.f;
        for (int c = 0; c < 64; ++c) { hin[c * 256] = Hc; Hc = ae[c * 256] * Hc + he[c * 256]; }
    }
}

DI void ssd_z_item(const Ctx& P, int item) {
    int tid_ = threadIdx.x & 255; asm volatile("" : "+v"(tid_));
    const int tid = tid_, lane = tid & 63, wid = tid >> 6, r32 = lane & 31, hi = lane >> 5;
    const int g = item & 1, c = (item >> 1) & 63, b = item >> 7;
    const int tok = b * SEQ + c * 128 + wid * 32 + r32;
    const bf16_t* Cc = (const bf16_t*)(P.ws + AR_CC) + (size_t)tok * 128 + g * 64 + 8 * hi;
    bf16x8 cf[4];
#pragma unroll
    for (int d0 = 0; d0 < 4; ++d0) cf[d0] = *(const bf16x8*)(Cc + 16 * d0);
    f32x16 acc[2][2];
#pragma unroll
    for (int hh = 0; hh < 2; ++hh)
#pragma unroll
        for (int pb = 0; pb < 2; ++pb) {
#pragma unroll
            for (int r = 0; r < 16; ++r) acc[hh][pb][r] = 0.f;
            const bf16_t* sp = (const bf16_t*)(P.ws + AR_SIN) + ((size_t)((b * 64 + c) * 4 + 2 * g + hh) * 64 + pb * 32 + r32) * 64 + 8 * hi;
#pragma unroll
            for (int d0 = 0; d0 < 4; ++d0) { const bf16x8 sf = *(const bf16x8*)(sp + 16 * d0); acc[hh][pb] = MFMA(sf, cf[d0], acc[hh][pb]); }
        }
    const f32x4 acv = *(const f32x4*)((const float*)(P.ws + WS_ACUM) + (size_t)tok * 4);
    const bf16_t* yl = (const bf16_t*)(P.ws + AR_YLOC) + (size_t)tok * 256 + g * 128;
    const bf16_t* zp = (const bf16_t*)(P.ws + AR_U) + (size_t)tok * NIN + UC_Z + g * 128;
    float ss = 0.f;
#pragma unroll
    for (int hh = 0; hh < 2; ++hh) { const float ea = __expf(acv[2 * g + hh]);
#pragma unroll
        for (int pb = 0; pb < 2; ++pb)
#pragma unroll
            for (int q = 0; q < 4; ++q) { const int col = hh * 64 + pb * 32 + 8 * q + 4 * hi;
                const u32x2 yv = *(const u32x2*)(yl + col), zv = *(const u32x2*)(zp + col);
                const float yy[4] = {bflo(yv[0]), bfhi(yv[0]), bflo(yv[1]), bfhi(yv[1])}, zz[4] = {bflo(zv[0]), bfhi(zv[0]), bflo(zv[1]), bfhi(zv[1])};
#pragma unroll
                for (int j = 0; j < 4; ++j) { const float v = (acc[hh][pb][4 * q + j] * ea + yy[j]) * siluf_(zz[j]); acc[hh][pb][4 * q + j] = v; ss += v * v; } } }
    ss += __shfl_xor(ss, 32);
    const float rs = rsqrtf(ss * (1.0f / 128.0f) + EPS);
    bf16_t* ym = (bf16_t*)(P.ws + AR_YMIX) + (size_t)tok * 1024 + 512 + g * 128;
#pragma unroll
    for (int hh = 0; hh < 2; ++hh)
#pragma unroll
        for (int pb = 0; pb < 2; ++pb)
#pragma unroll
            for (int q = 0; q < 4; ++q) { const int col = hh * 64 + pb * 32 + 8 * q + 4 * hi;
                *(u32x2*)(ym + col) = (u32x2){pk2(acc[hh][pb][4 * q] * rs, acc[hh][pb][4 * q + 1] * rs), pk2(acc[hh][pb][4 * q + 2] * rs, acc[hh][pb][4 * q + 3] * rs)}; }
}
DI void rowfin_item(const Ctx& P, int item) {
    int tid_ = threadIdx.x & 255; asm volatile("" : "+v"(tid_));
    const int lane = tid_ & 63, wid = tid_ >> 6;
#pragma unroll
    for (int u = 0; u < 4; ++u) {
    const int tok = item * 16 + wid * 4 + u;
    bf16_t* ym = (bf16_t*)(P.ws + AR_YMIX) + (size_t)tok * 1024;
    {
        const u32x4 v = *(const u32x4*)((const bf16_t*)(P.ws + AR_YMLA) + (size_t)tok * 512 + lane * 8);
        float f[8] = {bflo(v[0]), bfhi(v[0]), bflo(v[1]), bfhi(v[1]), bflo(v[2]), bfhi(v[2]), bflo(v[3]), bfhi(v[3])};
        float ss = 0.f;
#pragma unroll
        for (int j = 0; j < 8; ++j) ss += f[j] * f[j];
#pragma unroll
        for (int d = 1; d < 64; d <<= 1) ss += __shfl_xor(ss, d);
        const float rs = rsqrtf(ss * (1.0f / 512.0f) + EPS);
        *(u32x4*)(ym + lane * 8) = (u32x4){pk2(f[0] * rs, f[1] * rs), pk2(f[2] * rs, f[3] * rs), pk2(f[4] * rs, f[5] * rs), pk2(f[6] * rs, f[7] * rs)};
    }
    {
        const int b = tok >> 13, c = (tok & 8191) >> 7, ch = lane * 4;
        const u32x2 hv = *(const u32x2*)((const bf16_t*)(P.ws + AR_HLOC) + (size_t)tok * 256 + ch), av = *(const u32x2*)((const bf16_t*)(P.ws + AR_ACP) + (size_t)tok * 256 + ch);
        const u32x2 gv = *(const u32x2*)((const bf16_t*)(P.ws + AR_U) + (size_t)tok * NIN + UC_GATE + ch);
        const f32x4 hin = *(const f32x4*)((const float*)(P.ws + WS_HIN) + (size_t)(b * 64 + c) * 256 + ch);
        const float hl[4] = {bflo(hv[0]), bfhi(hv[0]), bflo(hv[1]), bfhi(hv[1])}, aa[4] = {bflo(av[0]), bfhi(av[0]), bflo(av[1]), bfhi(av[1])}, gg[4] = {bflo(gv[0]), bfhi(gv[0]), bflo(gv[1]), bfhi(gv[1])};
        float y[4], ss = 0.f;
#pragma unroll
        for (int j = 0; j < 4; ++j) { y[j] = (hl[j] + aa[j] * hin[j]) * gelu_tanh_(gg[j]); ss += y[j] * y[j]; }
#pragma unroll
        for (int d = 1; d < 64; d <<= 1) ss += __shfl_xor(ss, d);
        const float rs = rsqrtf(ss * (1.0f / 256.0f) + EPS);
        *(u32x2*)(ym + 768 + ch) = (u32x2){pk2(y[0] * rs, y[1] * rs), pk2(y[2] * rs, y[3] * rs)};
    }
    }
}

DI void run_phase(const Params& PP, int ph, char* smem, unsigned* sh_item, int rep = 0) {
    int z_; asm volatile("s_mov_b32 %0, 0" : "=s"(z_));
    Ctx P; P.in = PP.in + z_; P.out = PP.out + z_; P.ws = PP.ws + z_;
    const int vb = __builtin_amdgcn_readfirstlane((int)(threadIdx.x >> 8));
    const int bid = (int)blockIdx.x * 2 + vb + z_;
    const int G = (int)gridDim.x * 2;
    const int pb = (int)blockIdx.x + z_, PG = (int)gridDim.x;
    char* const smem_full = smem; smem = smem + vb * VB_LDS;
    unsigned char* ws = P.ws;
    bf16_t* XB = (bf16_t*)(ws + WS_XB);
#if !defined(ONLY) || ONLY == 9
    if (ph == 0) { phase_prologue(P, smem); return; }
#endif
    if (ph == NPHASE - 1) {
        int t_ = threadIdx.x & 255; asm volatile("" : "+v"(t_));
        const int lane = t_ & 63, wid = t_ >> 6; const float* g = P.in[34];
        for (int row = bid * 4 + wid; row < T; row += G * 4) {
            float* xr = P.out + (size_t)row * DM; f32x4 v[4]; float ss = 0.f;
#pragma unroll
            for (int i = 0; i < 4; ++i) { v[i] = *(const f32x4*)(xr + i * 256 + lane * 4); ss += v[i][0] * v[i][0] + v[i][1] * v[i][1] + v[i][2] * v[i][2] + v[i][3] * v[i][3]; }
#pragma unroll
            for (int d = 1; d < 64; d <<= 1) ss += __shfl_xor(ss, d);
            const float rs = rsqrtf(ss * (1.0f / 1024.0f) + EPS);
#pragma unroll
            for (int i = 0; i < 4; ++i) { const f32x4 gv = *(const f32x4*)(g + i * 256 + lane * 4); *(f32x4*)(xr + i * 256 + lane * 4) = (f32x4){v[i][0] * rs * gv[0], v[i][1] * rs * gv[1], v[i][2] * rs * gv[2], v[i][3] * rs * gv[3]}; }
        }
        return;
    }
    const int l = (ph - 1) / 9, st = (ph - 1) % 9;
    const bf16_t* W = (const bf16_t*)(ws + ((l & 1) ? WS_WB1 : WS_WB0));
    switch (st) {
#if !defined(ONLY) || ONLY == 0
    case 0: {
        { EpiP1KV e{EpiP1{(bf16_t*)(ws + AR_U), (float*)(ws + WS_DTRAW), (float*)(ws + WS_PQ), (float*)(ws + WS_PKV)}, (bf16_t*)(ws + WS_KMEM), (bf16_t*)(ws + WS_VMEM)};
          const bf16_t* Wi = W + WO_IN; const bf16_t* Wk = W + WO_MK; const bf16_t* Am = (const bf16_t*)(ws + WS_MEMB) - (size_t)T * 1024; const float* part = (const float*)(ws + WS_PART);
          auto tf = [=](int it) { const int xcd = it & 7, idx = it >> 3;
                                  if (idx < 56) return Tile256{XB, Wi, part, 1024, 1024, 1024, (xcd * 8 + idx / 7) * 256, (idx % 7) * 256, 16, 0, 1.0f / 1024.0f};
                                  const int j = xcd * 2 + (idx - 56); return Tile256{Am, Wk, part, 1024, 1024, 1024, T + ((j >> 2) & 1) * 256, (j >> 3) * 1024 + (j & 3) * 256, 16, 0, 1.0f / 1024.0f}; };
          gemm256_stream(tf, pb, PG, 464, smem_full, e); }
    } break;
#endif
#if !defined(ONLY) || ONLY == 1
    case 1: {
        {
            const int tv = (pb >> 1) * 2 + vb, tvn = (PG >> 1) * 2;
            for (int k = tv; k < 512; k += tvn) { if (pb & 1) lru_local_item(P, l, k, smem); else ssd_local_item(P, l, k, smem); }
        }
        __syncthreads();
        { EpiStage1 e{EpiKV{(bf16_t*)(ws + AR_K), (bf16_t*)(ws + AR_V), (const bf16_t*)(ws + AR_U), (const float*)(ws + WS_COS), (const float*)(ws + WS_SIN)},
                      EpiQ{(bf16_t*)(ws + AR_Q), (const float*)(ws + WS_COS), (const float*)(ws + WS_SIN)}, (bf16_t*)(ws + WS_WQKT), (bf16_t*)(ws + WS_VWOT)};
          const bf16_t* Uq = (const bf16_t*)(ws + AR_U) + UC_CQ; const bf16_t* Ukv = (const bf16_t*)(ws + AR_U) + UC_CKV; const bf16_t* Wq = W + WO_UQ; const bf16_t* Wkv = W + WO_UKV;
          const bf16_t* Km = (const bf16_t*)(ws + WS_KMEM); const bf16_t* Vm = (const bf16_t*)(ws + WS_VMEM); const bf16_t* Wmq = W + WO_MQ; const bf16_t* Wmo = W + WO_MO;
          const float* pq = (const float*)(ws + WS_PQ); const float* pkv = (const float*)(ws + WS_PKV);
          auto tf = [=](int it) {
              if (it < 256) return Tile256{Ukv, Wkv, pkv, NIN, 128, 128, (it >> 2) * 256, (it & 3) * 256, 2, 0, 1.0f / 128.0f};
              if (it < 448) { const int j = it - 256; return Tile256{Uq, Wq, pq, NIN, 256, 256, (j / 3) * 256, (j % 3) * 256, 4, 1, 1.0f / 256.0f}; }
              if (it < 480) { const int j = it - 448, b = j >> 4, h = (j >> 2) & 3, nt = j & 3; return Tile256{Km + h * 256, Wmq + h * 256, nullptr, 1024, 1024, 256, b * 256, nt * 256, 0, 2 | (b << 2) | (h << 3), 0.f}; }
              const int j = it - 480, b = j >> 4, h = (j >> 2) & 3, mt = j & 3; return Tile256{Wmo + h * 256, Vm + (size_t)b * 256 * 1024 + h * 256, nullptr, 1024, 1024, 256, mt * 256, 0, 0, 3 | (b << 2) | (h << 3), 0.f}; };
          gemm256_stream(tf, pb, PG, 512, smem_full, e); }
    } break;
#endif
#if !defined(ONLY) || ONLY == 2
    case 2: {
        carries(P, bid);
        unsigned* ctr = (unsigned*)ws + CW_QUEUE + (l * 8 + (pb & 7)) * 64 + rep * 16;
        for (;;) {
            __syncthreads();
            if (threadIdx.x == 0) *sh_item = atomicAdd(ctr, 1u);
            __syncthreads();
            const unsigned j2 = *sh_item;
            if (j2 >= 64u) break;
            const int pi = 31 - (int)(j2 & 31u), qb = 2 * pi + 1 - vb;
            attn_item((const bf16_t*)(ws + AR_Q), (const bf16_t*)(ws + AR_K), (const bf16_t*)(ws + AR_V), (bf16_t*)(ws + AR_YMLA), (pb & 7) * 2 + (int)(j2 >> 5), qb, 2 * (2 * pi + 2), smem_full, vb);
        }
    } break;
#endif
#if !defined(ONLY) || ONLY == 3
    case 3: {
        for (int it = bid; it < 256 + 1024; it += G) { if (it < 256) ssd_z_item(P, it); else rowfin_item(P, it - 256); }
    } break;
#endif
#if !defined(ONLY) || ONLY == 4
    case 4: {
        EpiResid e{l == 0 ? P.in[0] : P.out, P.out, XB, (float*)(ws + WS_PART)};
        { const bf16_t* Ay = (const bf16_t*)(ws + AR_YMIX); const bf16_t* Wo = W + WO_OUT;
          auto tf = [=](int it) { const int xcd = it & 7, idx = it >> 3, mt = xcd * 8 + (idx >> 2), nt = idx & 3; return Tile256{Ay, Wo, nullptr, 1024, 1024, 1024, mt * 256, nt * 256, 0, 0, 0.f}; };
          gemm256_stream(tf, pb, PG, 256, smem_full, e); }
    } break;
#endif
#if !defined(ONLY) || ONLY == 5
    case 5: {
        { EpiSoftmax256 e{(bf16_t*)(ws + AR_P), (float*)(smem_full + 2 * 65536 + 1024)}; const bf16_t* Wq = (const bf16_t*)(ws + WS_WQKT); const float* part = (const float*)(ws + WS_PART);
          auto tf = [=](int it) { const int xcd = it & 7, idx = it >> 3, mt = xcd * 8 + (idx >> 2), hh = idx & 3; return Tile256{XB, Wq + (size_t)(mt >> 5) * 1048576, part, 1024, 1024, 1024, mt * 256, hh * 256, 16, 0, 1.0f / 1024.0f}; };
          gemm256_stream(tf, pb, PG, 256, smem_full, e); }
    } break;
#endif
#if !defined(ONLY) || ONLY == 6
    case 6: {
        EpiResid e{P.out, P.out, XB, (float*)(ws + WS_PART)};
        { const bf16_t* Ap = (const bf16_t*)(ws + AR_P); const bf16_t* Vw = (const bf16_t*)(ws + WS_VWOT);
          auto tf = [=](int it) { const int xcd = it & 7, idx = it >> 3, mt = xcd * 8 + (idx >> 2), nt = idx & 3; return Tile256{Ap, Vw + (size_t)(mt >> 5) * 1048576, nullptr, 1024, 1024, 1024, mt * 256, nt * 256, 0, 0, 0.f}; };
          gemm256_stream(tf, pb, PG, 256, smem_full, e); }
    } break;
#endif
#if !defined(ONLY) || ONLY == 7
    case 7: {
        EpiRelu2 e{(bf16_t*)(ws + AR_H)};
        { const bf16_t* W1 = W + WO_1; const float* part = (const float*)(ws + WS_PART);
          auto tf = [=](int it) { const int rnd = it >> 8, w = it & 255, xcd = w & 7, idx = w >> 3, mt = rnd * 16 + (xcd >> 1) * 4 + (idx >> 3), nt = (xcd & 1) * 8 + (idx & 7); return Tile256{XB, W1, part, 1024, 1024, 1024, mt * 256, nt * 256, 16, 0, 1.0f / 1024.0f}; };
          gemm256_stream(tf, pb, PG, 1024, smem_full, e); }
    } break;
#endif
#if !defined(ONLY) || ONLY == 8
    case 8: {
        EpiResid e{P.out, P.out, XB, (float*)(ws + WS_PART)};
        { const bf16_t* Ah = (const bf16_t*)(ws + AR_H); const bf16_t* W2 = W + WO_2;
          auto tf = [=](int it) { const int xcd = it & 7, idx = it >> 3, mt = xcd * 8 + (idx >> 2), nt = idx & 3; return Tile256{Ah, W2, nullptr, 4096, 4096, 4096, mt * 256, nt * 256, 0, 0, 0.f}; };
          gemm256_stream(tf, pb, PG, 256, smem_full, e); }
        if (l + 1 < NL) { __syncthreads(); convert_layer_weights(P, l + 1, (float*)smem); }
    } break;
#endif
    }
}

__global__ void __launch_bounds__(512, 2) hymba_mega(Params P, int ph_lo, int ph_hi, int coop) {
    extern __shared__ __attribute__((aligned(16))) char smem[];
    __shared__ unsigned sh_item;
    if (coop) {
        if (threadIdx.x == 0) *(uint4*)(smem + XB_LDS_OFF) = make_uint4(0u, 0u, 0u, 0u);
        __syncthreads();
        (void)xcd_barrier_post((unsigned*)P.ws, (volatile unsigned*)(smem + XB_LDS_OFF));
    }
    for (int ph = ph_lo; ph < ph_hi; ++ph) {
        run_phase(P, ph, smem, &sh_item);
#ifdef REP_ST
        if (ph >= 1 && ph < NPHASE - 1 && (ph - 1) % 9 == REP_ST) { xcd_barrier((unsigned*)P.ws); run_phase(P, ph, smem, &sh_item, 1); }
#endif
        if (coop && ph + 1 < ph_hi) {
            if (ph == ph_lo) cg::this_grid().sync();
            else { xcd_barrier((unsigned*)P.ws);
#ifdef DBL_BAR
                xcd_barrier((unsigned*)P.ws); xcd_barrier((unsigned*)P.ws);
#endif
            }
        }
    }
}

extern "C" void kernel_launch(void* const* d_in, const int* in_sizes, int n_in, void* d_out, int out_size, void* d_ws, size_t ws_size, hipStream_t stream) {
    static int grid = 0;
    if (grid == 0) {
        if (n_in != 35 || out_size != T * DM || ws_size < WS_END) { fprintf(stderr, "kernel_launch: unexpected shapes (n_in %d out %d ws %zu need %zu)\n", n_in, out_size, ws_size, (size_t)WS_END); grid = -1; return; }
        int dev = 0, cus = 0, per_cu = 0;
        hipGetDevice(&dev); hipDeviceGetAttribute(&cus, hipDeviceAttributeMultiprocessorCount, dev);
        if (hipFuncSetAttribute((const void*)hymba_mega, hipFuncAttributeMaxDynamicSharedMemorySize, LDS_BYTES) != hipSuccess) { fprintf(stderr, "kernel_launch: hipFuncSetAttribute failed\n"); grid = -1; return; }
        (void)hipOccupancyMaxActiveBlocksPerMultiprocessor(&per_cu, (const void*)hymba_mega, 512, LDS_BYTES);
        if (per_cu < 1) { fprintf(stderr, "kernel_launch: occupancy query failed\n"); grid = -1; return; }
        if (per_cu > 1) per_cu = 1;
        grid = cus * per_cu;
    }
    if (grid < 0) return;
    hipMemsetAsync((char*)d_ws + WS_CTL, 0, 65536, stream);
    Params p{};
    for (int i = 0; i < 35; ++i) p.in[i] = (const float*)d_in[i];
    p.out = (float*)d_out; p.ws = (unsigned char*)d_ws;
#if MK_MULTI
    for (int ph = 0; ph < NPHASE; ++ph) hipLaunchKernelGGL(hymba_mega, dim3(grid), dim3(512), LDS_BYTES, stream, p, ph, ph + 1, 0);
#else
    int lo = 0, hi = NPHASE, coop = 1;
    void* args[] = {&p, &lo, &hi, &coop};
    hipError_t e = hipLaunchCooperativeKernel((const void*)hymba_mega, dim3(grid), dim3(512), args, LDS_BYTES, stream);
    if (e != hipSuccess) fprintf(stderr, "cooperative launch failed: %s (grid %d)\n", hipGetErrorString(e), grid);
#endif
}
```

```cpp
#include <hip/hip_runtime.h>
#include <hip/hip_cooperative_groups.h>
#include <stdint.h>
#include <stdio.h>
namespace cg = cooperative_groups;

#ifndef MK_MULTI
#define MK_MULTI 0
#endif

#define DI __device__ __forceinline__
#define LAS __attribute__((address_space(3)))
typedef unsigned short bf16_t;
typedef short bf16x8 __attribute__((ext_vector_type(8)));
typedef short s16x4 __attribute__((ext_vector_type(4)));
typedef float f32x16 __attribute__((ext_vector_type(16)));
typedef float f32x4 __attribute__((ext_vector_type(4)));
typedef unsigned u32x4 __attribute__((ext_vector_type(4)));
typedef unsigned u32x2 __attribute__((ext_vector_type(2)));
#define MFMA(a, b, c) __builtin_amdgcn_mfma_f32_32x32x16_bf16((a), (b), (c), 0, 0, 0)

constexpr int T = 16384, SEQ = 8192, DM = 1024, NL = 4;
constexpr int NIN = 1792;
constexpr float EPS = 1e-6f;
constexpr float LOG2E = 1.4426950408889634f;
constexpr int VB_LDS = 78848;
constexpr int XB_LDS_OFF = 2 * VB_LDS;
constexpr int LDS_BYTES = XB_LDS_OFF + 16;
constexpr int NPHASE = 2 + 9 * NL;

constexpr int UC_CQ = 0, UC_CKV = 256, UC_KR = 384, UC_DT = 416, UC_Z = 512, UC_XS = 768, UC_BS = 1024, UC_CS = 1152, UC_XR = 1280, UC_GATE = 1536;

constexpr size_t WO_IN = 0;
constexpr size_t WO_UQ = WO_IN + (size_t)NIN * 1024;
constexpr size_t WO_UKV = WO_UQ + 768 * 256;
constexpr size_t WO_OUT = WO_UKV + 1024 * 128;
constexpr size_t WO_MQ = WO_OUT + 1048576;
constexpr size_t WO_MK = WO_MQ + 1048576;
constexpr size_t WO_MV = WO_MK + 1048576;
constexpr size_t WO_MO = WO_MV + 1048576;
constexpr size_t WO_1 = WO_MO + 1048576;
constexpr size_t WO_2 = WO_1 + 4194304;
constexpr size_t WO_A = WO_2 + 4194304;
constexpr size_t WO_I = WO_A + 16384;
constexpr size_t WB_ELEMS = WO_I + 16384;

constexpr size_t al256(size_t x) { return (x + 255) & ~(size_t)255; }
constexpr size_t WS_CTL = 0;
constexpr size_t WS_WB0 = 65536;
constexpr size_t WS_WB1 = WS_WB0 + al256(WB_ELEMS * 2);
constexpr size_t WS_XB = WS_WB1 + al256(WB_ELEMS * 2);
constexpr size_t WS_MEMB = WS_XB + (size_t)T * 1024 * 2;
constexpr size_t WS_COS = WS_MEMB + 512 * 1024 * 2;
constexpr size_t WS_SIN = WS_COS + (size_t)T * 16 * 4;
constexpr size_t WS_KMEM = WS_SIN + (size_t)T * 16 * 4;
constexpr size_t WS_VMEM = WS_KMEM + 512 * 1024 * 2;
constexpr size_t WS_WQKT = WS_VMEM + 512 * 1024 * 2;
constexpr size_t WS_VWOT = WS_WQKT + 2 * 1048576 * 2;
constexpr size_t WS_DTRAW = WS_VWOT + 2 * 1048576 * 2;
constexpr size_t WS_ACUM = WS_DTRAW + (size_t)T * 16;
constexpr size_t WS_ATOT = WS_ACUM + (size_t)T * 16;
constexpr size_t WS_HEND = WS_ATOT + 4096;
constexpr size_t WS_AEND = WS_HEND + 131072;
constexpr size_t WS_HIN = WS_AEND + 131072;
constexpr size_t WS_PART = WS_HIN + 131072;
constexpr size_t WS_PQ = WS_PART + (size_t)(T + 512) * 64;
constexpr size_t WS_PKV = WS_PQ + (size_t)T * 16;
constexpr size_t WS_ARENA = WS_PKV + (size_t)T * 8;
constexpr size_t AR_U = WS_ARENA;
constexpr size_t AR_Q = AR_U + (size_t)T * NIN * 2;
constexpr size_t AR_K = AR_Q + (size_t)16 * 8192 * 96 * 2;
constexpr size_t AR_V = AR_K + (size_t)16 * 8192 * 96 * 2;
constexpr size_t AR_YMLA = AR_V + (size_t)16 * 8192 * 64 * 2;
constexpr size_t AR_YLOC = AR_YMLA + (size_t)T * 512 * 2;
constexpr size_t AR_STATES = AR_YLOC + (size_t)T * 256 * 2;
constexpr size_t AR_SIN = AR_STATES + (size_t)2 * 64 * 4 * 4096 * 4;
constexpr size_t AR_CC = AR_SIN + (size_t)2 * 64 * 4 * 4096 * 2;
constexpr size_t AR_HLOC = AR_CC + (size_t)T * 128 * 2;
constexpr size_t AR_ACP = AR_HLOC + (size_t)T * 256 * 2;
constexpr size_t WS_END = AR_ACP + (size_t)T * 256 * 2;
constexpr size_t AR_YMIX = AR_Q;
constexpr size_t AR_P = AR_U;
constexpr size_t AR_H = WS_ARENA;
static_assert(AR_H + (size_t)T * 4096 * 2 <= WS_END, "H overlay");
static_assert(AR_YMIX + (size_t)T * 1024 * 2 <= AR_V, "ymix overlay");

#define XB_TMO      128
#define XB_XCNT(j)  (256  + 64 * (j))
#define XB_XSUB(j)  (1280 + 64 * (j))
#define XB_XGEN(j)  (2304 + 64 * (j))
#define XB_TOP      3328
#define XB_TOPGEN   3392
#define XCD_BAR_WORDS 3456
#define XB_SPIN_CAP (1u << 20)
constexpr int CW_QUEUE = 4096;

struct Params {
    const float* in[35];
    float* out;
    unsigned char* ws;
};

struct Ctx { const float* const* in; float* out; unsigned char* ws; };
DI int VBID() { int z_; asm volatile("s_mov_b32 %0, 0" : "=s"(z_)); return (int)blockIdx.x * 2 + (int)(threadIdx.x >> 8) + z_; }
DI int VGRID() { return (int)gridDim.x * 2; }

typedef __bf16 bf16x2_t __attribute__((ext_vector_type(2)));
DI unsigned pk2(float lo, float hi) { const bf16x2_t v = {(__bf16)lo, (__bf16)hi}; return __builtin_bit_cast(unsigned, v); }
DI float bflo(unsigned u) { return __uint_as_float(u << 16); }
DI float bfhi(unsigned u) { return __uint_as_float(u & 0xffff0000u); }
DI float sigmoidf_(float x) { return __builtin_amdgcn_rcpf(1.0f + __expf(-x)); }
DI float softplus_fast(float x) { const float y = __expf(x); const float ser = y * (1.0f - y * (0.5f - y * (0.33333334f - 0.25f * y))); const float lg = __logf(1.0f + y); return x > 15.f ? x : (y < 0.03f ? ser : lg); }
DI float neg_expm1_fast(float x) { const float ser = -x * (1.0f + x * (0.5f + x * (0.16666667f + x * (0.041666668f + x * 0.008333334f)))); const float ex = 1.0f - __expf(x); return x > -0.1f ? ser : ex; }
DI float siluf_(float x) { return x * sigmoidf_(x); }
DI float softplusf_(float x) { return x > 20.f ? x : log1pf(__expf(x)); }
DI float gelu_tanh_(float x) { const float y = 0.7978845608028654f * (x + 0.044715f * x * x * x); const float t = 1.0f - 2.0f / (__expf(2.0f * y) + 1.0f); return 0.5f * x * (1.0f + t); }
DI int crow(int r, int hi) { return (r & 3) + 8 * (r >> 2) + 4 * hi; }
typedef short v4i16_t __attribute__((ext_vector_type(4)));
DI s16x4 tr_read(const char* p) { return __builtin_bit_cast(s16x4, __builtin_amdgcn_ds_read_tr16_b64_v4i16((LAS v4i16_t*)(uintptr_t)(unsigned)(uintptr_t)p)); }
DI bf16x8 cat8(s16x4 lo, s16x4 hi) { return (bf16x8){lo[0], lo[1], lo[2], lo[3], hi[0], hi[1], hi[2], hi[3]}; }

DI void store_pair16(bf16_t* blk, int hi, int k, u32x2 a, u32x2 b) {
    const auto r0 = __builtin_amdgcn_permlane32_swap(a[0], b[0], false, false);
    const auto r1 = __builtin_amdgcn_permlane32_swap(a[1], b[1], false, false);
    *(u32x4*)(blk + 8 * k + 8 * hi) = (u32x4){r0[0], r1[0], r0[1], r1[1]};
}

DI unsigned xb_ld(unsigned* p) { return __hip_atomic_load(p, __ATOMIC_RELAXED, __HIP_MEMORY_SCOPE_AGENT); }
DI unsigned xb_add(unsigned* p, unsigned v) { return __hip_atomic_fetch_add(p, v, __ATOMIC_RELAXED, __HIP_MEMORY_SCOPE_AGENT); }
DI unsigned xb_xcc_id() { return (unsigned)__builtin_amdgcn_s_getreg((3 << 11) | 20) & 0xFu; }
#define XB_SPIN(cond, bar) do { unsigned _sp = 0; while (cond) { __builtin_amdgcn_s_sleep(1); \
    if ((++_sp & 255u) == 0u) { if (xb_ld(&(bar)[XB_TMO])) break; if (_sp > XB_SPIN_CAP) { atomicAdd(&(bar)[XB_TMO], 1u); break; } } } } while (0)
struct XcdBarrier { unsigned* bar; unsigned x; volatile unsigned* st; };
DI XcdBarrier xcd_barrier_post(unsigned* bar, volatile unsigned* st) {
    XcdBarrier b; b.bar = bar; b.x = xb_xcc_id(); b.st = st;
    if (threadIdx.x == 0) (void)xb_add(&bar[XB_XCNT(b.x)], 1u);
    return b;
}
DI void xcd_barrier_complete(unsigned* bar, unsigned x, unsigned& nloc, unsigned& nx) {
    const unsigned G = gridDim.x;
    unsigned sum, cnt, mine, sp = 0u;
    for (;;) {
        sum = 0u; cnt = 0u; mine = 0u;
#pragma unroll
        for (unsigned j = 0; j < 16; ++j) { const unsigned c = xb_ld(&bar[XB_XCNT(j)]); sum += c; cnt += (c > 0u) ? 1u : 0u; mine = (j == x) ? c : mine; }
        if (sum == G) break;
        __builtin_amdgcn_s_sleep(1);
        if ((++sp & 255u) == 0u) { if (xb_ld(&bar[XB_TMO])) break; if (sp > XB_SPIN_CAP) { atomicAdd(&bar[XB_TMO], 1u); break; } }
    }
    nloc = mine > 0u ? mine : 1u; nx = cnt > 0u ? cnt : 1u;
}
DI void xcd_barrier(unsigned* bar_in) {
    extern __shared__ __attribute__((aligned(16))) char dyn_lds_[];
    XcdBarrier b; b.bar = bar_in; b.st = (volatile unsigned*)(dyn_lds_ + XB_LDS_OFF); b.x = xb_xcc_id();
    asm volatile("s_waitcnt vmcnt(0)" ::: "memory");
    __syncthreads();
    if (threadIdx.x == 0) {
        int z_; asm volatile("s_mov_b32 %0, 0" : "=s"(z_));
        unsigned* bar = b.bar + z_;
        __builtin_amdgcn_s_waitcnt(0);
        unsigned nloc = b.st[0], nx = b.st[1];
        if (nloc == 0u) { xcd_barrier_complete(bar, b.x, nloc, nx); b.st[0] = nloc; b.st[1] = nx; }
        const unsigned old = xb_add(&bar[XB_XSUB(b.x)], 1u);
        const unsigned gen = old / nloc;
        if (old + 1u == (gen + 1u) * nloc) {
            __builtin_amdgcn_fence(__ATOMIC_RELEASE, "agent");
            asm volatile("s_waitcnt vmcnt(0)" ::: "memory");
            const unsigned og = xb_add(&bar[XB_TOP], 1u);
            const unsigned tg = og / nx;
            if (og + 1u == (tg + 1u) * nx) xb_add(&bar[XB_TOPGEN], 1u);
            else XB_SPIN(xb_ld(&bar[XB_TOPGEN]) == tg, bar);
            __builtin_amdgcn_fence(__ATOMIC_ACQUIRE, "agent");
            xb_add(&bar[XB_XGEN(b.x)], 1u);
            asm volatile("s_waitcnt vmcnt(0)" ::: "memory");
        } else {
            XB_SPIN(xb_ld(&bar[XB_XGEN(b.x)]) == gen, bar);
            __builtin_amdgcn_fence(__ATOMIC_ACQUIRE, "agent");
            asm volatile("s_waitcnt vmcnt(0)" ::: "memory");
        }
    }
    __syncthreads();
}

template <int WAVES_M, int WAVES_N, int MB, int NB, int NORM_A  , class Epi>
DI void gemm_tile(const bf16_t* __restrict__ A, int lda, const bf16_t* __restrict__ Bt, int ldb, int K, int m0, int n0, char* smem, const Epi& epi, const float* part = nullptr) {
    constexpr int BM = WAVES_M * MB * 32, BN = WAVES_N * NB * 32, LA = BM / 32, LB = BN / 32, RS = 144;
    char* As = smem; char* Bs = smem + BM * RS; float* rsc = (float*)(smem + (BM + BN) * RS);
    int tid_ = threadIdx.x & 255; asm volatile("" : "+v"(tid_));
    const int tid = tid_, lane = tid & 63, wid = tid >> 6, r32 = lane & 31, hi = lane >> 5;
    const int wm = wid / WAVES_N, wn = wid % WAVES_N;
    const int lrow = tid >> 3, lkc = tid & 7;
    const bf16_t* Ap = A + (size_t)(m0 + lrow) * lda + lkc * 8;
    const bf16_t* Bp = Bt + (size_t)(n0 + lrow) * ldb + lkc * 8;
    u32x4 ra[LA], rb[LB]; float ss[LA];
    f32x16 acc[NB][MB];
#pragma unroll
    for (int i = 0; i < LA; ++i) ss[i] = 0.f;
#pragma unroll
    for (int nb = 0; nb < NB; ++nb)
#pragma unroll
        for (int mb = 0; mb < MB; ++mb)
#pragma unroll
            for (int r = 0; r < 16; ++r) acc[nb][mb][r] = 0.f;
#pragma unroll
    for (int i = 0; i < LA; ++i) ra[i] = *(const u32x4*)(Ap + (size_t)i * 32 * lda);
#pragma unroll
    for (int i = 0; i < LB; ++i) rb[i] = *(const u32x4*)(Bp + (size_t)i * 32 * ldb);
    const int nk = K >> 6;
    for (int kt = 0; kt < nk; ++kt) {
        __syncthreads();
#pragma unroll
        for (int i = 0; i < LA; ++i) *(u32x4*)(As + (lrow + 32 * i) * RS + lkc * 16) = ra[i];
#pragma unroll
        for (int i = 0; i < LB; ++i) *(u32x4*)(Bs + (lrow + 32 * i) * RS + lkc * 16) = rb[i];
        if (NORM_A == 1) {
#pragma unroll
            for (int i = 0; i < LA; ++i)
#pragma unroll
                for (int j = 0; j < 4; ++j) { const float a = bflo(ra[i][j]), b = bfhi(ra[i][j]); ss[i] += a * a + b * b; }
        }
        __syncthreads();
        if (kt + 1 < nk) {
            Ap += 64; Bp += 64;
#pragma unroll
            for (int i = 0; i < LA; ++i) ra[i] = *(const u32x4*)(Ap + (size_t)i * 32 * lda);
#pragma unroll
            for (int i = 0; i < LB; ++i) rb[i] = *(const u32x4*)(Bp + (size_t)i * 32 * ldb);
        }
#pragma unroll
        for (int s = 0; s < 4; ++s) {
            bf16x8 af[MB], bfr[NB];
#pragma unroll
            for (int mb = 0; mb < MB; ++mb) af[mb] = *(const bf16x8*)(As + (wm * MB * 32 + mb * 32 + r32) * RS + s * 32 + hi * 16);
#pragma unroll
            for (int nb = 0; nb < NB; ++nb) bfr[nb] = *(const bf16x8*)(Bs + (wn * NB * 32 + nb * 32 + r32) * RS + s * 32 + hi * 16);
#pragma unroll
            for (int nb = 0; nb < NB; ++nb)
#pragma unroll
                for (int mb = 0; mb < MB; ++mb) acc[nb][mb] = MFMA(bfr[nb], af[mb], acc[nb][mb]);
        }
    }
    if (NORM_A == 1) {
#pragma unroll
        for (int i = 0; i < LA; ++i) {
            float s = ss[i]; s += __shfl_xor(s, 1); s += __shfl_xor(s, 2); s += __shfl_xor(s, 4);
            if (lkc == 0) rsc[lrow + 32 * i] = rsqrtf(s / (float)K + EPS);
        }
        __syncthreads();
    }
    if (NORM_A == 2) {
        if (tid < BM) { const float* pp = part + (size_t)(m0 + tid) * 16; const f32x4 a = *(const f32x4*)pp, b = *(const f32x4*)(pp + 4), c = *(const f32x4*)(pp + 8), d = *(const f32x4*)(pp + 12);
            rsc[tid] = rsqrtf((((a[0] + a[1]) + (a[2] + a[3])) + ((b[0] + b[1]) + (b[2] + b[3])) + ((c[0] + c[1]) + (c[2] + c[3])) + ((d[0] + d[1]) + (d[2] + d[3]))) * (1.0f / 1024.0f) + EPS); }
        __syncthreads();
    }
    epi.template run<NB, MB>(acc, m0 + wm * MB * 32, n0 + wn * NB * 32, r32, hi, rsc + wm * MB * 32);
}

DI void glds16(const void* g, unsigned lds_addr) {
    unsigned sv;
    asm volatile("s_mov_b32 %0, m0\n\ts_mov_b32 m0, %2\n\ts_nop 0\n\tglobal_load_lds_dwordx4 %1, off\n\ts_mov_b32 m0, %0" : "=&s"(sv) : "v"(g), "s"(lds_addr) : "memory");
}
template <class E, class = void> struct IsStaged { static constexpr bool v = false; };
template <class E> struct IsStaged<E, decltype((void)E::STAGED)> { static constexpr bool v = E::STAGED; };
struct Tile256 { const bf16_t* A; const bf16_t* Bt; const float* part; int lda, ldb, K, m0, n0, npart, tag; float invk; };
template <class Epi, class TileFn>
DI void gemm256_stream(const TileFn& tf, int it0, int step, int ntiles, char* smem, const Epi& epi) {
    constexpr int MB = 4, NB = 2, BM = 256, STG = 65536, NSEG = 8;
    int tid_ = threadIdx.x; asm volatile("" : "+v"(tid_));
    const int tid = tid_, lane = tid & 63, wid = tid >> 6, r32 = lane & 31, hi = lane >> 5;
    const int wm = wid >> 2, wn = wid & 3;
    const int lr = lane >> 3, cc = lane & 7;
    const unsigned lds0 = (unsigned)(uintptr_t)smem;
    float* rsc = (float*)(smem + 2 * STG);
    int aoff[MB], boff[NB], asw[MB], bsw[NB];
#pragma unroll
    for (int mb = 0; mb < MB; ++mb) { const int r = wm * 128 + mb * 32 + r32; aoff[mb] = r * 128; asw[mb] = (r >> 1) & 7; }
#pragma unroll
    for (int nb = 0; nb < NB; ++nb) { const int r = wn * 64 + nb * 32 + r32; boff[nb] = (BM + r) * 128; bsw[nb] = (r >> 1) & 7; }
#define SRC_OF(T_, j_) ((j_) < 4 ? (T_).A + (size_t)((T_).m0 + 8 * (wid + 8 * (j_)) + lr) * (T_).lda + ((cc ^ (((8 * (wid + 8 * (j_)) + lr) >> 1) & 7)) * 8) \
                                 : (T_).Bt + (size_t)((T_).n0 + 8 * (wid + 8 * (j_)) + lr - BM) * (T_).ldb + ((cc ^ (((8 * (wid + 8 * (j_)) + lr - BM) >> 1) & 7)) * 8))
    bool primed = false;
    for (int it = it0; it < ntiles; it += step) {
        const Tile256 t = tf(it);
        const int nk = t.K >> 6;
        const bf16_t* src[NSEG];
#pragma unroll
        for (int j = 0; j < NSEG; ++j) src[j] = SRC_OF(t, j);
        f32x16 acc[NB][MB];
#pragma unroll
        for (int nb = 0; nb < NB; ++nb)
#pragma unroll
            for (int mb = 0; mb < MB; ++mb)
#pragma unroll
                for (int r = 0; r < 16; ++r) acc[nb][mb][r] = 0.f;
        if (!primed) {
            __syncthreads();
#pragma unroll
            for (int j = 0; j < NSEG; ++j) glds16(src[j], (unsigned)__builtin_amdgcn_readfirstlane((int)(lds0 + (wid + 8 * j) * 1024)));
        }
        float sq = 0.f;
        for (int kt = 0; kt < nk; ++kt) {
            asm volatile("s_waitcnt vmcnt(0)\n\ts_barrier" ::: "memory");
            if (kt == nk - 1 && t.part && tid < BM) {
                const float* pp = t.part + (size_t)(t.m0 + tid) * t.npart;
                for (int i = 0; i < t.npart; i += 2) sq += pp[i] + pp[i + 1]; }
            if (kt + 1 < nk) {
#pragma unroll
                for (int j = 0; j < NSEG; ++j) glds16(src[j] + (size_t)(kt + 1) * 64, (unsigned)__builtin_amdgcn_readfirstlane((int)(lds0 + ((kt + 1) & 1) * STG + (wid + 8 * j) * 1024)));
            } else if (it + step < ntiles) {
                const Tile256 tn = tf(it + step);
#pragma unroll
                for (int j = 0; j < NSEG; ++j) glds16(SRC_OF(tn, j), (unsigned)__builtin_amdgcn_readfirstlane((int)(lds0 + (wid + 8 * j) * 1024)));
                primed = true;
            }
            const char* st = smem + (kt & 1) * STG;
#pragma unroll
            for (int s = 0; s < 4; ++s) {
                bf16x8 af[MB], bfr[NB];
#pragma unroll
                for (int mb = 0; mb < MB; ++mb) af[mb] = *(const bf16x8*)(st + aoff[mb] + (((2 * s + hi) ^ asw[mb]) * 16));
#pragma unroll
                for (int nb = 0; nb < NB; ++nb) bfr[nb] = *(const bf16x8*)(st + boff[nb] + (((2 * s + hi) ^ bsw[nb]) * 16));
#pragma unroll
                for (int nb = 0; nb < NB; ++nb)
#pragma unroll
                    for (int mb = 0; mb < MB; ++mb) acc[nb][mb] = MFMA(bfr[nb], af[mb], acc[nb][mb]);
            }
        }
        if (t.part) {
            if (tid < BM) rsc[tid] = rsqrtf(sq * t.invk + EPS);
            __syncthreads();
        }
        if constexpr (IsStaged<Epi>::v) epi.template run_staged<NB, MB>(acc, t.m0, t.n0, wm, wn, r32, hi, lane, wid, smem + STG);
        else epi.template run<NB, MB>(acc, t.m0 + wm * 128, t.n0 + wn * 64, r32, hi, rsc + wm * 128, t.tag);
        if (t.part) __syncthreads();
    }
#undef SRC_OF
}

struct EpiP1 {
    bf16_t* U; float* dtraw; float* pq; float* pkv;
    template <int NB, int MB> DI void run(f32x16 (&acc)[NB][MB], int mb0, int nb0, int r32, int hi, const float* rs, int tag = 0) const {
#pragma unroll
        for (int mb = 0; mb < MB; ++mb) { const int row = mb0 + mb * 32 + r32; const float sc = rs[mb * 32 + r32]; float ssq = 0.f;
#pragma unroll
            for (int nb = 0; nb < NB; ++nb) { const int cb = nb0 + nb * 32; u32x2 w[4];
#pragma unroll
                for (int g = 0; g < 4; ++g) {
                    const float v0 = acc[nb][mb][4 * g] * sc, v1 = acc[nb][mb][4 * g + 1] * sc, v2 = acc[nb][mb][4 * g + 2] * sc, v3 = acc[nb][mb][4 * g + 3] * sc;
                    w[g] = (u32x2){pk2(v0, v1), pk2(v2, v3)}; ssq += (v0 * v0 + v1 * v1) + (v2 * v2 + v3 * v3);
                    if (cb + 8 * g + 4 * hi == UC_DT) *(f32x4*)(dtraw + (size_t)row * 4) = (f32x4){v0, v1, v2, v3}; }
                bf16_t* blk = U + (size_t)row * NIN + cb;
                store_pair16(blk, hi, 0, w[0], w[1]); store_pair16(blk, hi, 2, w[2], w[3]); }
            if (nb0 < UC_KR) { ssq += __shfl_xor(ssq, 32);
                if (hi == 0) { if (nb0 < UC_CKV) pq[(size_t)row * 4 + (nb0 >> 6)] = ssq; else pkv[(size_t)row * 2 + ((nb0 - UC_CKV) >> 6)] = ssq; } } }
    }
};
struct EpiP1KV {
    EpiP1 p1; bf16_t* kmem; bf16_t* vmem;
    template <int NB, int MB> DI void run(f32x16 (&acc)[NB][MB], int mb0, int nb0, int r32, int hi, const float* rs, int tag = 0) const {
        if (mb0 < T) { p1.template run<NB, MB>(acc, mb0, nb0, r32, hi, rs); return; }
        bf16_t* O = (nb0 >> 10) ? vmem : kmem;
#pragma unroll
        for (int mb = 0; mb < MB; ++mb) { const int row = mb0 - T + mb * 32 + r32; const float sc = rs[mb * 32 + r32];
#pragma unroll
            for (int nb = 0; nb < NB; ++nb) { u32x2 w[4];
#pragma unroll
                for (int g = 0; g < 4; ++g) w[g] = (u32x2){pk2(acc[nb][mb][4 * g] * sc, acc[nb][mb][4 * g + 1] * sc), pk2(acc[nb][mb][4 * g + 2] * sc, acc[nb][mb][4 * g + 3] * sc)};
                bf16_t* blk = O + (size_t)row * 1024 + (nb0 & 1023) + nb * 32;
                store_pair16(blk, hi, 0, w[0], w[1]); store_pair16(blk, hi, 2, w[2], w[3]); } }
    }
};
template <bool USE_RS> struct EpiPlain {
    bf16_t* O; int ld; int row_off, col_off; float scale;
    template <int NB, int MB> DI void run(f32x16 (&acc)[NB][MB], int mb0, int nb0, int r32, int hi, const float* rs, int tag = 0) const {
#pragma unroll
        for (int mb = 0; mb < MB; ++mb) { const int row = mb0 + mb * 32 + r32 + row_off; const float sc = USE_RS ? rs[mb * 32 + r32] * scale : scale;
#pragma unroll
            for (int nb = 0; nb < NB; ++nb)
#pragma unroll
                for (int g = 0; g < 4; ++g) { const int col = nb0 + nb * 32 + 8 * g + 4 * hi + col_off;
                    *(u32x2*)(O + (size_t)row * ld + col) = (u32x2){pk2(acc[nb][mb][4 * g] * sc, acc[nb][mb][4 * g + 1] * sc), pk2(acc[nb][mb][4 * g + 2] * sc, acc[nb][mb][4 * g + 3] * sc)}; } }
    }
};
struct EpiRelu2 {
    bf16_t* H;
    template <int NB, int MB> DI void run(f32x16 (&acc)[NB][MB], int mb0, int nb0, int r32, int hi, const float* rs, int tag = 0) const {
#pragma unroll
        for (int mb = 0; mb < MB; ++mb) { const int row = mb0 + mb * 32 + r32; const float sc = rs[mb * 32 + r32];
#pragma unroll
            for (int nb = 0; nb < NB; ++nb) { u32x2 w[4];
#pragma unroll
                for (int g = 0; g < 4; ++g) { float v[4];
#pragma unroll
                    for (int j = 0; j < 4; ++j) { const float t = fmaxf(acc[nb][mb][4 * g + j] * sc, 0.f); v[j] = t * t; }
                    w[g] = (u32x2){pk2(v[0], v[1]), pk2(v[2], v[3])}; }
                bf16_t* blk = H + (size_t)row * 4096 + nb0 + nb * 32;
                store_pair16(blk, hi, 0, w[0], w[1]); store_pair16(blk, hi, 2, w[2], w[3]); } }
    }
};
struct EpiResid {
    static constexpr bool STAGED = true;
    const float* res; float* out; bf16_t* xb; float* part;
    template <int NB, int MB> DI void run_staged(f32x16 (&acc)[NB][MB], int m0, int n0, int wm, int wn, int r32, int hi, int lane, int wid, char* stage) const {
        asm volatile("s_waitcnt lgkmcnt(0)\n\ts_barrier" ::: "memory");
#pragma unroll 1
        for (int p = 0; p < 4; ++p) {
            const int c = lane & 15; f32x4 rr[4];
#pragma unroll
            for (int q = 0; q < 4; ++q) { const int r = wid * 32 + q * 4 + (lane >> 4); rr[q] = *(const f32x4*)(res + (size_t)(m0 + r) * DM + n0 + 64 * p + 4 * c); }
            if (wn == p) {
#pragma unroll
                for (int mb = 0; mb < MB; ++mb) { const int r = wm * 128 + mb * 32 + r32;
#pragma unroll
                    for (int nb = 0; nb < NB; ++nb)
#pragma unroll
                        for (int g = 0; g < 4; ++g) { const int cc = nb * 8 + 2 * g + hi;
                            *(f32x4*)(stage + r * 256 + ((cc ^ (r & 15)) * 16)) = (f32x4){acc[nb][mb][4 * g], acc[nb][mb][4 * g + 1], acc[nb][mb][4 * g + 2], acc[nb][mb][4 * g + 3]}; } }
            }
            asm volatile("s_waitcnt lgkmcnt(0)\n\ts_barrier" ::: "memory");
#pragma unroll 1
            for (int hq = 0; hq < 2; ++hq) {
                if (hq) {
#pragma unroll
                    for (int q = 0; q < 4; ++q) { const int r = wid * 32 + (4 + q) * 4 + (lane >> 4); rr[q] = *(const f32x4*)(res + (size_t)(m0 + r) * DM + n0 + 64 * p + 4 * c); }
                }
#pragma unroll
                for (int q = 0; q < 4; ++q) { const int r = wid * 32 + (4 * hq + q) * 4 + (lane >> 4); const size_t o = (size_t)(m0 + r) * DM + n0 + 64 * p + 4 * c;
                    f32x4 v = *(const f32x4*)(stage + r * 256 + ((c ^ (r & 15)) * 16));
                    v[0] += rr[q][0]; v[1] += rr[q][1]; v[2] += rr[q][2]; v[3] += rr[q][3];
                    *(f32x4*)(out + o) = v; *(u32x2*)(xb + o) = (u32x2){pk2(v[0], v[1]), pk2(v[2], v[3])};
                    float ssq = (v[0] * v[0] + v[1] * v[1]) + (v[2] * v[2] + v[3] * v[3]);
                    ssq += __shfl_xor(ssq, 1); ssq += __shfl_xor(ssq, 2); ssq += __shfl_xor(ssq, 4); ssq += __shfl_xor(ssq, 8);
                    if (c == 0) part[(size_t)(m0 + r) * 16 + (n0 >> 6) + p] = ssq; }
            }
            asm volatile("s_waitcnt lgkmcnt(0)\n\ts_barrier" ::: "memory");
        }
    }
    template <int NB, int MB> DI void run(f32x16 (&acc)[NB][MB], int mb0, int nb0, int r32, int hi, const float*, int tag = 0) const {
#pragma unroll
        for (int mb = 0; mb < MB; ++mb) { const int row = mb0 + mb * 32 + r32; float ssq = 0.f;
#pragma unroll
            for (int nb = 0; nb < NB; ++nb)
                { u32x2 w[4];
#pragma unroll
                for (int g = 0; g < 4; ++g) { const int col = nb0 + nb * 32 + 8 * g + 4 * hi; const size_t o = (size_t)row * DM + col;
                    f32x4 v = *(const f32x4*)(res + o);
                    v[0] += acc[nb][mb][4 * g]; v[1] += acc[nb][mb][4 * g + 1]; v[2] += acc[nb][mb][4 * g + 2]; v[3] += acc[nb][mb][4 * g + 3];
                    *(f32x4*)(out + o) = v; ssq += (v[0] * v[0] + v[1] * v[1]) + (v[2] * v[2] + v[3] * v[3]);
                    w[g] = (u32x2){pk2(v[0], v[1]), pk2(v[2], v[3])}; }
                bf16_t* blk = xb + (size_t)row * DM + nb0 + nb * 32;
                store_pair16(blk, hi, 0, w[0], w[1]); store_pair16(blk, hi, 2, w[2], w[3]); }
            ssq += __shfl_xor(ssq, 32);
            if (hi == 0) part[(size_t)row * 16 + (nb0 >> 6)] = ssq; }
    }
};
struct EpiSoftmax {
    bf16_t* P; float* xch;
    template <int NB, int MB> DI void run(f32x16 (&acc)[NB][MB], int mb0, int nb0, int r32, int hi, const float* rs, int tag = 0) const {
        const int row = mb0 + r32; const float sc = rs[r32]; const int wm = (mb0 >> 5) & 1, wn = (nb0 >> 7) & 1;
        float m = -3.0e38f;
#pragma unroll
        for (int nb = 0; nb < NB; ++nb)
#pragma unroll
            for (int r = 0; r < 16; ++r) { acc[nb][0][r] *= sc; m = fmaxf(m, acc[nb][0][r]); }
        m = fmaxf(m, __shfl_xor(m, 32));
        if (hi == 0) xch[(wm * 2 + wn) * 32 + r32] = m;
        __syncthreads();
        m = fmaxf(m, xch[(wm * 2 + (wn ^ 1)) * 32 + r32]);
        float s = 0.f;
#pragma unroll
        for (int nb = 0; nb < NB; ++nb)
#pragma unroll
            for (int r = 0; r < 16; ++r) { const float p = __builtin_amdgcn_exp2f(acc[nb][0][r] - m); acc[nb][0][r] = p; s += p; }
        s += __shfl_xor(s, 32);
        if (hi == 0) xch[128 + (wm * 2 + wn) * 32 + r32] = s;
        __syncthreads();
        s += xch[128 + (wm * 2 + (wn ^ 1)) * 32 + r32];
        const float inv = 1.0f / s;
#pragma unroll
        for (int nb = 0; nb < NB; ++nb)
#pragma unroll
            for (int g = 0; g < 4; ++g) { const int col = nb0 + nb * 32 + 8 * g + 4 * hi;
                *(u32x2*)(P + (size_t)row * DM + col) = (u32x2){pk2(acc[nb][0][4 * g] * inv, acc[nb][0][4 * g + 1] * inv), pk2(acc[nb][0][4 * g + 2] * inv, acc[nb][0][4 * g + 3] * inv)}; }
    }
};
struct EpiSoftmax256 {
    bf16_t* P; float* xch;
    template <int NB, int MB> DI void run(f32x16 (&acc)[NB][MB], int mb0, int nb0, int r32, int hi, const float* rs, int tag = 0) const {
        const int wn = (nb0 >> 6) & 3, lr0 = (mb0 & 255) + r32;
#pragma unroll
        for (int mb = 0; mb < MB; ++mb) { const float sc = rs[mb * 32 + r32]; float m = -3.0e38f;
#pragma unroll
            for (int nb = 0; nb < NB; ++nb)
#pragma unroll
                for (int r = 0; r < 16; ++r) { acc[nb][mb][r] *= sc; m = fmaxf(m, acc[nb][mb][r]); }
            m = fmaxf(m, __shfl_xor(m, 32));
            if (hi == 0) xch[(lr0 + mb * 32) * 4 + wn] = m; }
        __syncthreads();
#pragma unroll
        for (int mb = 0; mb < MB; ++mb) { const f32x4 mm = *(const f32x4*)(xch + (lr0 + mb * 32) * 4); const float m = fmaxf(fmaxf(mm[0], mm[1]), fmaxf(mm[2], mm[3])); float sm = 0.f;
#pragma unroll
            for (int nb = 0; nb < NB; ++nb)
#pragma unroll
                for (int r = 0; r < 16; ++r) { const float p = __builtin_amdgcn_exp2f(acc[nb][mb][r] - m); acc[nb][mb][r] = p; sm += p; }
            sm += __shfl_xor(sm, 32);
            if (hi == 0) xch[1024 + (lr0 + mb * 32) * 4 + wn] = sm; }
        __syncthreads();
#pragma unroll
        for (int mb = 0; mb < MB; ++mb) { const f32x4 sv = *(const f32x4*)(xch + 1024 + (lr0 + mb * 32) * 4); const float inv = __builtin_amdgcn_rcpf((sv[0] + sv[1]) + (sv[2] + sv[3]));
            const int row = mb0 + mb * 32 + r32;
#pragma unroll
            for (int nb = 0; nb < NB; ++nb) { u32x2 w[4];
#pragma unroll
                for (int g = 0; g < 4; ++g) w[g] = (u32x2){pk2(acc[nb][mb][4 * g] * inv, acc[nb][mb][4 * g + 1] * inv), pk2(acc[nb][mb][4 * g + 2] * inv, acc[nb][mb][4 * g + 3] * inv)};
                bf16_t* blk = P + (size_t)row * DM + nb0 + nb * 32;
                store_pair16(blk, hi, 0, w[0], w[1]); store_pair16(blk, hi, 2, w[2], w[3]); } }
    }
};
constexpr float QSCALE = 0.10206207261596575f * LOG2E;
struct EpiQ {
    bf16_t* Q; const float* cs; const float* sn;
    template <int NB, int MB> DI void run(f32x16 (&acc)[NB][MB], int mb0, int nb0, int r32, int hi, const float* rs, int tag = 0) const {
#pragma unroll
        for (int mb = 0; mb < MB; ++mb) { const int row = mb0 + mb * 32 + r32; const float sc = rs[mb * 32 + r32] * QSCALE; const int b = row >> 13, s = row & 8191;
#pragma unroll
            for (int nb = 0; nb < NB; ++nb) { const int cb = nb0 + nb * 32; const int h = cb / 96, d0 = cb - h * 96;
                float v[16];
#pragma unroll
                for (int r = 0; r < 16; ++r) v[r] = acc[nb][mb][r] * sc;
                if (d0 == 64) {
#pragma unroll
                    for (int g = 0; g < 2; ++g) { const f32x4 c = *(const f32x4*)(cs + (size_t)row * 16 + 8 * g + 4 * hi), sv = *(const f32x4*)(sn + (size_t)row * 16 + 8 * g + 4 * hi);
#pragma unroll
                        for (int j = 0; j < 4; ++j) { const float x1 = v[4 * g + j], x2 = v[4 * (g + 2) + j]; v[4 * g + j] = x1 * c[j] - x2 * sv[j]; v[4 * (g + 2) + j] = x2 * c[j] + x1 * sv[j]; } }
                }
                bf16_t* qp = Q + ((size_t)(b * 8 + h) * SEQ + s) * 96 + d0 + 4 * hi;
#pragma unroll
                for (int g = 0; g < 4; ++g) *(u32x2*)(qp + 8 * g) = (u32x2){pk2(v[4 * g], v[4 * g + 1]), pk2(v[4 * g + 2], v[4 * g + 3])}; } }
    }
};
struct EpiKV {
    bf16_t* Kimg; bf16_t* Vimg; const bf16_t* U; const float* cs; const float* sn;
    template <int NB, int MB> DI void run(f32x16 (&acc)[NB][MB], int mb0, int nb0, int r32, int hi, const float* rs, int tag = 0) const {
        const int h = nb0 >> 7, isv = (nb0 >> 6) & 1;
#pragma unroll
        for (int mb = 0; mb < MB; ++mb) { const int row = mb0 + mb * 32 + r32; const float sc = rs[mb * 32 + r32]; const int b = row >> 13, s = row & 8191, tile = s >> 6, rin = s & 63;
            const size_t tb = (size_t)(b * 8 + h) * 128 + tile;
#pragma unroll
            for (int nb = 0; nb < NB; ++nb)
#pragma unroll
                for (int g = 0; g < 4; ++g) { const u32x2 w = (u32x2){pk2(acc[nb][mb][4 * g] * sc, acc[nb][mb][4 * g + 1] * sc), pk2(acc[nb][mb][4 * g + 2] * sc, acc[nb][mb][4 * g + 3] * sc)};
                    if (!isv) *(u32x2*)(Kimg + (tb * 12 + nb * 4 + g) * 512 + rin * 8 + 4 * hi) = w;
                    else *(u32x2*)(Vimg + (tb * 2 + nb) * 2048 + rin * 32 + 8 * g + 4 * hi) = w; }
            if (!isv) {
                const u32x4 a = *(const u32x4*)(U + (size_t)row * NIN + UC_KR + 8 * hi), bq = *(const u32x4*)(U + (size_t)row * NIN + UC_KR + 16 + 8 * hi);
                unsigned w1[4], w2[4];
#pragma unroll
                for (int p = 0; p < 2; ++p) {
                    const f32x4 c = *(const f32x4*)(cs + (size_t)row * 16 + 8 * hi + 4 * p), sv = *(const f32x4*)(sn + (size_t)row * 16 + 8 * hi + 4 * p);
                    const float x1a = bflo(a[2 * p]), x1b = bfhi(a[2 * p]), x1c = bflo(a[2 * p + 1]), x1d = bfhi(a[2 * p + 1]);
                    const float x2a = bflo(bq[2 * p]), x2b = bfhi(bq[2 * p]), x2c = bflo(bq[2 * p + 1]), x2d = bfhi(bq[2 * p + 1]);
                    w1[2 * p] = pk2(x1a * c[0] - x2a * sv[0], x1b * c[1] - x2b * sv[1]); w1[2 * p + 1] = pk2(x1c * c[2] - x2c * sv[2], x1d * c[3] - x2d * sv[3]);
                    w2[2 * p] = pk2(x2a * c[0] + x1a * sv[0], x2b * c[1] + x1b * sv[1]); w2[2 * p + 1] = pk2(x2c * c[2] + x1c * sv[2], x2d * c[3] + x1d * sv[3]);
                }
                *(u32x4*)(Kimg + (tb * 12 + 8 + hi) * 512 + rin * 8) = (u32x4){w1[0], w1[1], w1[2], w1[3]};
                *(u32x4*)(Kimg + (tb * 12 + 10 + hi) * 512 + rin * 8) = (u32x4){w2[0], w2[1], w2[2], w2[3]};
            } }
    }
};

struct EpiStage1 {
    EpiKV kv; EpiQ q; bf16_t* wqkt; bf16_t* vwot;
    template <int NB, int MB> DI void run(f32x16 (&acc)[NB][MB], int mb0, int nb0, int r32, int hi, const float* rs, int tag = 0) const {
        const int kind = tag & 3, b = (tag >> 2) & 1, h = (tag >> 3) & 3;
        if (kind == 0) kv.template run<NB, MB>(acc, mb0, nb0, r32, hi, rs);
        else if (kind == 1) q.template run<NB, MB>(acc, mb0, nb0, r32, hi, rs);
        else if (kind == 2) { EpiPlain<false> e{wqkt + (size_t)b * 1048576, 1024, h * 256 - b * 256, 0, 0.0625f * LOG2E}; e.template run<NB, MB>(acc, mb0, nb0, r32, hi, rs); }
        else { EpiPlain<false> e{vwot + (size_t)b * 1048576, 1024, 0, h * 256, 1.0f}; e.template run<NB, MB>(acc, mb0, nb0, r32, hi, rs); }
    }
};

DI void convT_tiles(const float* __restrict__ src, int srcld, int K, int N, bf16_t* __restrict__ dst, int dstld, const float* __restrict__ gain, float* tl, int& base) {
    int tid_ = threadIdx.x & 255; asm volatile("" : "+v"(tid_));
    const int G = VGRID(), tid = tid_; const int tn = (N + 63) >> 6, tiles = (K >> 6) * tn;
    int start = (VBID() - base) % G; if (start < 0) start += G;
    const int niter = (tiles + G - 1) / G;
    const int kr = tid >> 4, nn = (tid & 15) * 4, n = tid >> 2, ks = (tid & 3) * 16;
    for (int itr = 0; itr < niter; itr += 2) {
        int k0[2], n0[2]; bool valid[2]; f32x4 v[2][4]; float g[2][4];
#pragma unroll
        for (int u = 0; u < 2; ++u) { const int t = start + (itr + u) * G; valid[u] = (itr + u < niter) && (t < tiles);
            k0[u] = valid[u] ? (t / tn) * 64 : 0; n0[u] = valid[u] ? (t % tn) * 64 : 0;
#pragma unroll
            for (int i = 0; i < 4; ++i) { const int k = kr + 16 * i; v[u][i] = (f32x4){0.f, 0.f, 0.f, 0.f}; g[u][i] = 1.0f;
                if (valid[u]) { if (gain) g[u][i] = gain[k0[u] + k]; if (n0[u] + nn + 3 < N) v[u][i] = *(const f32x4*)(src + (size_t)(k0[u] + k) * srcld + n0[u] + nn); } } }
        __syncthreads();
#pragma unroll
        for (int u = 0; u < 2; ++u) { float* tb = tl + u * (64 * 65);
#pragma unroll
            for (int i = 0; i < 4; ++i) { const int k = kr + 16 * i; const float gg = g[u][i];
                tb[k * 65 + nn] = v[u][i][0] * gg; tb[k * 65 + nn + 1] = v[u][i][1] * gg; tb[k * 65 + nn + 2] = v[u][i][2] * gg; tb[k * 65 + nn + 3] = v[u][i][3] * gg; } }
        __syncthreads();
#pragma unroll
        for (int u = 0; u < 2; ++u) { const float* tb = tl + u * (64 * 65);
            if (valid[u] && n0[u] + n < N) { unsigned w[8];
#pragma unroll
                for (int q = 0; q < 8; ++q) w[q] = pk2(tb[(ks + 2 * q) * 65 + n], tb[(ks + 2 * q + 1) * 65 + n]);
                bf16_t* d = dst + (size_t)(n0[u] + n) * dstld + k0[u] + ks;
                *(u32x4*)d = (u32x4){w[0], w[1], w[2], w[3]}; *(u32x4*)(d + 8) = (u32x4){w[4], w[5], w[6], w[7]}; } }
    }
    base = (base + tiles) % G;
}
DI void convert_layer_weights(const Ctx& P, int l, float* tl) {
    bf16_t* W = (bf16_t*)(P.ws + ((l & 1) ? WS_WB1 : WS_WB0));
    int base = 0;
    const float* w_in = P.in[4] + (size_t)l * 1024 * 1700; const float* g_mix = P.in[3] + l * 1024;
    const int seg_src[10] = {0, 256, 384, 1184, 416, 672, 928, 1056, 1188, 1444};
    const int seg_w[10] = {256, 128, 32, 4, 256, 256, 128, 128, 256, 256};
    const int seg_dst[10] = {UC_CQ, UC_CKV, UC_KR, UC_DT, UC_Z, UC_XS, UC_BS, UC_CS, UC_XR, UC_GATE};
#pragma unroll
    for (int s = 0; s < 10; ++s) convT_tiles(w_in + seg_src[s], 1700, 1024, seg_w[s], W + WO_IN + (size_t)seg_dst[s] * 1024, 1024, g_mix, tl, base);
    {
        const size_t n = (size_t)92 * 1024 / 8; u32x4* z = (u32x4*)(W + WO_IN + (size_t)420 * 1024);
        int t_ = threadIdx.x & 255; asm volatile("" : "+v"(t_));
        for (size_t i = (size_t)VBID() * 256 + t_; i < n; i += (size_t)VGRID() * 256) z[i] = (u32x4){0u, 0u, 0u, 0u};
    }
    convT_tiles(P.in[7] + (size_t)l * 256 * 768, 768, 256, 768, W + WO_UQ, 256, P.in[5] + l * 256, tl, base);
    convT_tiles(P.in[8] + (size_t)l * 128 * 1024, 1024, 128, 1024, W + WO_UKV, 128, P.in[6] + l * 128, tl, base);
    convT_tiles(P.in[24] + (size_t)l * 1048576, 1024, 512, 1024, W + WO_OUT, 1024, P.in[9] + l * 512, tl, base);
    convT_tiles(P.in[24] + (size_t)l * 1048576 + (size_t)512 * 1024, 1024, 256, 1024, W + WO_OUT + 512, 1024, P.in[15] + l * 256, tl, base);
    convT_tiles(P.in[24] + (size_t)l * 1048576 + (size_t)768 * 1024, 1024, 256, 1024, W + WO_OUT + 768, 1024, P.in[23] + l * 256, tl, base);
    convT_tiles(P.in[28] + (size_t)l * 1048576, 1024, 1024, 1024, W + WO_MK, 1024, P.in[26] + l * 1024, tl, base);
    convT_tiles(P.in[29] + (size_t)l * 1048576, 1024, 1024, 1024, W + WO_MV, 1024, P.in[26] + l * 1024, tl, base);
    convT_tiles(P.in[30] + (size_t)l * 1048576, 1024, 1024, 1024, W + WO_MO, 1024, nullptr, tl, base);
    convT_tiles(P.in[32] + (size_t)l * 4194304, 4096, 1024, 4096, W + WO_1, 1024, P.in[31] + l * 1024, tl, base);
    convT_tiles(P.in[33] + (size_t)l * 4194304, 1024, 4096, 1024, W + WO_2, 4096, nullptr, tl, base);
    for (int n = 0; n < 4; ++n) {
        convT_tiles(P.in[18] + (size_t)(l * 4 + n) * 4096, 64, 64, 64, W + WO_A + n * 4096, 64, nullptr, tl, base);
        convT_tiles(P.in[20] + (size_t)(l * 4 + n) * 4096, 64, 64, 64, W + WO_I + n * 4096, 64, nullptr, tl, base);
    }
    {
        const float* src = P.in[27] + (size_t)l * 1048576; const float* g = P.in[25] + l * 1024; bf16_t* d = W + WO_MQ;
        int t_ = threadIdx.x & 255; asm volatile("" : "+v"(t_));
        for (size_t i = (size_t)VBID() * 256 + t_; i < 131072; i += (size_t)VGRID() * 256) {
            const float gg = g[i >> 7]; const f32x4 a = *(const f32x4*)(src + i * 8), b = *(const f32x4*)(src + i * 8 + 4);
            *(u32x4*)(d + i * 8) = (u32x4){pk2(a[0] * gg, a[1] * gg), pk2(a[2] * gg, a[3] * gg), pk2(b[0] * gg, b[1] * gg), pk2(b[2] * gg, b[3] * gg)}; }
    }
}
DI void phase_prologue(const Ctx& P, char* smem) {
    convert_layer_weights(P, 0, (float*)smem);
    int t_ = threadIdx.x & 255; asm volatile("" : "+v"(t_));
    const size_t gt = (size_t)VBID() * 256 + t_, gs = (size_t)VGRID() * 256;
    {   const float* x = P.in[0]; bf16_t* xb = (bf16_t*)(P.ws + WS_XB); float* part = (float*)(P.ws + WS_PART);
        const int lane = t_ & 63, wid = t_ >> 6;
        for (int row = VBID() * 4 + wid; row < T; row += VGRID() * 4) { float ss = 0.f;
#pragma unroll
            for (int i = 0; i < 4; ++i) { const size_t o = (size_t)row * DM + i * 256 + lane * 4; const f32x4 a = *(const f32x4*)(x + o);
                ss += (a[0] * a[0] + a[1] * a[1]) + (a[2] * a[2] + a[3] * a[3]); *(u32x2*)(xb + o) = (u32x2){pk2(a[0], a[1]), pk2(a[2], a[3])}; }
#pragma unroll
            for (int d = 1; d < 64; d <<= 1) ss += __shfl_xor(ss, d);
            if (lane < 16) part[(size_t)row * 16 + lane] = lane == 0 ? ss : 0.f; } }
    {   const float* x = P.in[1]; bf16_t* xb = (bf16_t*)(P.ws + WS_MEMB); float* part = (float*)(P.ws + WS_PART) + (size_t)T * 16;
        const int lane = t_ & 63, wid = t_ >> 6;
        for (int row = VBID() * 4 + wid; row < 512; row += VGRID() * 4) { float ss = 0.f;
#pragma unroll
            for (int i = 0; i < 4; ++i) { const size_t o = (size_t)row * DM + i * 256 + lane * 4; const f32x4 a = *(const f32x4*)(x + o);
                ss += (a[0] * a[0] + a[1] * a[1]) + (a[2] * a[2] + a[3] * a[3]); *(u32x2*)(xb + o) = (u32x2){pk2(a[0], a[1]), pk2(a[2], a[3])}; }
#pragma unroll
            for (int d = 1; d < 64; d <<= 1) ss += __shfl_xor(ss, d);
            if (lane < 16) part[(size_t)row * 16 + lane] = lane == 0 ? ss : 0.f; } }
    {   const int* pos = (const int*)P.in[2]; float* cs = (float*)(P.ws + WS_COS); float* sn = (float*)(P.ws + WS_SIN);
        for (size_t i = gt; i < (size_t)T * 16; i += gs) { const int tok = (int)(i >> 4), f = (int)(i & 15);
            const float inv = exp2f(-(float)f * (0.0625f * 13.287712379549449f));       const float ang = (float)pos[tok] * inv;
            double a = (double)ang; a -= 6.283185307179586 * rint(a * 0.15915494309189535);
            const float ar = (float)a; cs[i] = __cosf(ar); sn[i] = __sinf(ar); } }
}

DI void attn_item(const bf16_t* __restrict__ Q, const bf16_t* __restrict__ Kimg, const bf16_t* __restrict__ Vimg, bf16_t* __restrict__ Y, int bh, int qblk, int NTC, char* smem, int vb) {
    int tid_ = threadIdx.x & 255; asm volatile("" : "+v"(tid_));
    const int tid = tid_, lane = tid & 63, wid = tid >> 6, r32 = lane & 31, hi = lane >> 5;
    char* Kb = smem; char* Vb = smem + 36864; float* wsf = (float*)(smem + 61440 + vb * 17408) + wid * 64; bf16_t* stg = (bf16_t*)(smem + 61440 + vb * 17408 + 1024) + wid * 2048;
    const int gw = vb * 4 + wid;
    const int q0 = qblk * 128, NT = 2 * (qblk + 1);
    const int qrow = q0 + wid * 32 + r32;
    bf16x8 qr[6];
    { const bf16_t* qp = Q + ((size_t)bh * SEQ + qrow) * 96 + 8 * hi;
#pragma unroll
      for (int d0 = 0; d0 < 6; ++d0) qr[d0] = *(const bf16x8*)(qp + 16 * d0); }
    const bf16_t* kg = Kimg + (size_t)bh * 128 * 6144 + gw * 512 + lane * 8;
    const bf16_t* vg = Vimg + (size_t)bh * 128 * 4096 + gw * 512 + lane * 8;
    const unsigned ldsK = (unsigned)(uintptr_t)Kb + gw * 1024, ldsV = (unsigned)(uintptr_t)Vb + gw * 1024;
#define ATT_ISSUE(tt, st_) do { \
        glds16(kg + (size_t)(tt) * 6144, (unsigned)__builtin_amdgcn_readfirstlane((int)(ldsK + (st_) * 12288))); \
        if (gw < 4) glds16(kg + (size_t)(tt) * 6144 + 4096, (unsigned)__builtin_amdgcn_readfirstlane((int)(ldsK + (st_) * 12288 + 8192))); \
        glds16(vg + (size_t)(tt) * 4096, (unsigned)__builtin_amdgcn_readfirstlane((int)(ldsV + (st_) * 8192))); } while (0)
    __syncthreads();
    ATT_ISSUE(0, 0); ATT_ISSUE(1, 1);
    int sc = 0, s1 = 1, sn = 2;
    f32x16 o0, o1;
#pragma unroll
    for (int r = 0; r < 16; ++r) { o0[r] = 0.f; o1[r] = 0.f; }
    f32x16 ol;
#pragma unroll
    for (int r = 0; r < 16; ++r) ol[r] = 0.f;
    const bf16x8 ones = (bf16x8){0x3F80, 0x3F80, 0x3F80, 0x3F80, 0x3F80, 0x3F80, 0x3F80, 0x3F80};
    f32x16 negm;
#pragma unroll
    for (int r = 0; r < 16; ++r) negm[r] = 0.f;
    const char* vrd0 = Vb + ((lane >> 4) & 1) * 32 + (lane & 3) * 8 + (4 * hi + ((lane & 15) >> 2)) * 64;
#define ATT_QK(S0_, S1_, stg_) do { const char* kb_ = Kb + (stg_) * 12288 + r32 * 16; \
        { const bf16x8 k0 = *(const bf16x8*)(kb_ + hi * 1024), k1 = *(const bf16x8*)(kb_ + hi * 1024 + 512); S0_ = MFMA(k0, qr[0], negm); S1_ = MFMA(k1, qr[0], negm); } \
        _Pragma("unroll") for (int d0 = 1; d0 < 6; ++d0) { const bf16x8 k0 = *(const bf16x8*)(kb_ + (2 * d0 + hi) * 1024), k1 = *(const bf16x8*)(kb_ + (2 * d0 + hi) * 1024 + 512); \
            S0_ = MFMA(k0, qr[d0], S0_); S1_ = MFMA(k1, qr[d0], S1_); } } while (0)
#define MX3_(a, b, c) __builtin_fmaxf(__builtin_fmaxf((a), (b)), (c))
#define ATT_STEP(A0, A1, B0, B1, tt_) do { const int t = (tt_); \
        if (t + 1 < NTC) asm volatile("s_waitcnt vmcnt(0)\n\ts_barrier" ::: "memory");       \
        if (t + 2 < NTC) ATT_ISSUE(t + 2, sn); \
        const bool actN = (t + 1 < NT) && !(t + 1 == NT - 1 && wid < 2);                       \
        if (actN) ATT_QK(B0, B1, s1); \
        const bool actT = (t < NT) && !(t == NT - 1 && wid < 2); \
        if (actT) { \
            if (t >= NT - 2) { const int kbase = t * 64 + 4 * hi; \
                _Pragma("unroll") for (int r = 0; r < 16; ++r) { const int kv = kbase + (r & 3) + 8 * (r >> 2); if (kv > qrow) A0[r] = -INFINITY; if (kv + 32 > qrow) A1[r] = -INFINITY; } } \
            float ra_ = MX3_(A0[0], A0[1], A1[0]), rb_ = MX3_(A0[2], A0[3], A1[1]); ra_ = MX3_(ra_, A1[2], A1[3]); \
            _Pragma("unroll") for (int r = 4; r < 16; r += 4) { ra_ = MX3_(ra_, A0[r], A0[r + 1]); rb_ = MX3_(rb_, A0[r + 2], A0[r + 3]); ra_ = MX3_(ra_, A1[r], A1[r + 1]); rb_ = MX3_(rb_, A1[r + 2], A1[r + 3]); } \
            float rm = fmaxf(ra_, rb_); rm = fmaxf(rm, __shfl_xor(rm, 32));                    \
            const bool first = (t == 0);                                                       \
            if (first || __any(rm > 8.0f)) { \
                const float dl = first ? rm : fmaxf(rm, 0.f); const float f = __builtin_amdgcn_exp2f(-dl); \
                if (hi == 0) wsf[r32] = f; \
                asm volatile("s_waitcnt lgkmcnt(0)" ::: "memory"); \
                _Pragma("unroll") for (int g = 0; g < 4; ++g) { const f32x4 fv = *(const f32x4*)(wsf + 8 * g + 4 * hi); \
                    _Pragma("unroll") for (int j = 0; j < 4; ++j) { o0[4 * g + j] *= fv[j]; o1[4 * g + j] *= fv[j]; ol[4 * g + j] *= fv[j]; } } \
                const float nm = negm[0] - dl; \
                _Pragma("unroll") for (int r = 0; r < 16; ++r) { A0[r] -= dl; A1[r] -= dl; negm[r] = nm; } \
                if (actN) { _Pragma("unroll") for (int r = 0; r < 16; ++r) { B0[r] -= dl; B1[r] -= dl; } }     \
            } \
            _Pragma("unroll") for (int r = 0; r < 16; ++r) { A0[r] = __builtin_amdgcn_exp2f(A0[r]); A1[r] = __builtin_amdgcn_exp2f(A1[r]); } \
            bf16x8 pw[4]; \
            { u32x4 w; \
              w = (u32x4){pk2(A0[0], A0[1]), pk2(A0[2], A0[3]), pk2(A0[4], A0[5]), pk2(A0[6], A0[7])}; pw[0] = __builtin_bit_cast(bf16x8, w); \
              w = (u32x4){pk2(A0[8], A0[9]), pk2(A0[10], A0[11]), pk2(A0[12], A0[13]), pk2(A0[14], A0[15])}; pw[1] = __builtin_bit_cast(bf16x8, w); \
              w = (u32x4){pk2(A1[0], A1[1]), pk2(A1[2], A1[3]), pk2(A1[4], A1[5]), pk2(A1[6], A1[7])}; pw[2] = __builtin_bit_cast(bf16x8, w); \
              w = (u32x4){pk2(A1[8], A1[9]), pk2(A1[10], A1[11]), pk2(A1[12], A1[13]), pk2(A1[14], A1[15])}; pw[3] = __builtin_bit_cast(bf16x8, w); } \
            const char* vp = vrd0 + sc * 8192; \
            _Pragma("unroll") for (int s = 0; s < 4; ++s) { \
                const bf16x8 v0 = cat8(tr_read(vp + s * 1024), tr_read(vp + s * 1024 + 512)); \
                const bf16x8 v1 = cat8(tr_read(vp + 4096 + s * 1024), tr_read(vp + 4096 + s * 1024 + 512)); \
                o0 = MFMA(pw[s], v0, o0); o1 = MFMA(pw[s], v1, o1); ol = MFMA(pw[s], ones, ol); } \
        } \
        { const int o_ = sc; sc = s1; s1 = sn; sn = o_; } } while (0)
    f32x16 sa0, sa1, sb0, sb1;
    asm volatile("s_waitcnt vmcnt(0)\n\ts_barrier" ::: "memory");
    ATT_QK(sa0, sa1, 0);
    for (int t2 = 0; t2 < NTC; t2 += 2) {
        ATT_STEP(sa0, sa1, sb0, sb1, t2);
        ATT_STEP(sb0, sb1, sa0, sa1, t2 + 1);
    }
#undef ATT_STEP
#undef ATT_QK
#undef MX3_
#undef ATT_ISSUE
#pragma unroll
    for (int g = 0; g < 4; ++g)
#pragma unroll
        for (int j = 0; j < 4; ++j) { const float inv = 1.0f / ol[4 * g + j]; const int orow = 8 * g + 4 * hi + j;
            stg[orow * 64 + r32] = (bf16_t)(pk2(o0[4 * g + j] * inv, 0.f) & 0xffffu); stg[orow * 64 + 32 + r32] = (bf16_t)(pk2(o1[4 * g + j] * inv, 0.f) & 0xffffu); }
    asm volatile("s_waitcnt lgkmcnt(0)" ::: "memory");
    const int b = bh >> 3, h = bh & 7;
    bf16_t* yp = Y + ((size_t)b * SEQ + q0 + wid * 32) * 512 + h * 64;
#pragma unroll
    for (int i = 0; i < 4; ++i) { const int row = i * 8 + (lane >> 3), ch = lane & 7; *(u32x4*)(yp + (size_t)row * 512 + ch * 8) = *(const u32x4*)(stg + row * 64 + ch * 8); }
}

template <int CW, int N8, bool ACT> DI void conv_row(const bf16_t* __restrict__ U, int tok, int tin, int col, const float* __restrict__ cw, const float* __restrict__ cb, int ch, float (&o)[8 * N8]) {
#pragma unroll
    for (int q = 0; q < N8; ++q) {
        float a[8];
        const f32x4 b0 = *(const f32x4*)(cb + ch + 8 * q), b1 = *(const f32x4*)(cb + ch + 8 * q + 4);
#pragma unroll
        for (int j = 0; j < 4; ++j) { a[j] = b0[j]; a[4 + j] = b1[j]; }
#pragma unroll
        for (int k = 0; k < 4; ++k) {
            if (tin - 3 + k >= 0) {
                const u32x4 u = *(const u32x4*)(U + (size_t)(tok - 3 + k) * NIN + col + 8 * q);
                const f32x4 w0 = *(const f32x4*)(cw + (size_t)k * CW + ch + 8 * q), w1 = *(const f32x4*)(cw + (size_t)k * CW + ch + 8 * q + 4);
                a[0] += w0[0] * bflo(u[0]); a[1] += w0[1] * bfhi(u[0]); a[2] += w0[2] * bflo(u[1]); a[3] += w0[3] * bfhi(u[1]);
                a[4] += w1[0] * bflo(u[2]); a[5] += w1[1] * bfhi(u[2]); a[6] += w1[2] * bflo(u[3]); a[7] += w1[3] * bfhi(u[3]);
            }
        }
#pragma unroll
        for (int j = 0; j < 8; ++j) o[8 * q + j] = ACT ? siluf_(a[j]) : a[j];
    }
}
DI void ssd_local_item(const Ctx& P, int l, int item, char* smem) {
    int tid_ = threadIdx.x & 255; asm volatile("" : "+v"(tid_));
    const int tid = tid_, lane = tid & 63, wid = tid >> 6, r32 = lane & 31, hi = lane >> 5;
    const int h = item & 3, c = (item >> 2) & 63, b = item >> 8, g = h >> 1;
    const int tok0 = b * SEQ + c * 128, tin0 = c * 128;
    const bf16_t* U = (const bf16_t*)(P.ws + AR_U);
    const float* cw = P.in[10] + (size_t)l * 4 * 512; const float* cb = P.in[11] + l * 512;
    char* Btr = smem; char* Xtr = smem + 16384; float* acs = (float*)(smem + 32768); float* dts = acs + 128; float* wts = dts + 128; float* tot = wts + 128;
    __syncthreads();
    if (tid < 128) {
        const float dtr = ((const float*)(P.ws + WS_DTRAW))[(size_t)(tok0 + tid) * 4 + h];
        const float dt = softplus_fast(dtr + P.in[12][l * 4 + h]);
        float v = -__expf(P.in[13][l * 4 + h]) * dt;
#pragma unroll
        for (int d = 1; d < 64; d <<= 1) { const float u = __shfl_up(v, d); if (lane >= d) v += u; }
        dts[tid] = dt; acs[tid] = v;
        if (tid == 63) tot[0] = v;
    }
    __syncthreads();
    if (tid >= 64 && tid < 128) acs[tid] += tot[0];
    __syncthreads();
    if (tid < 128) {
        const float ac = acs[tid], ae = acs[127];
        wts[tid] = __expf(ae - ac);
        ((float*)(P.ws + WS_ACUM))[(size_t)(tok0 + tid) * 4 + h] = ac;
        if (tid == 127) ((float*)(P.ws + WS_ATOT))[(b * 4 + h) * 64 + c] = ae;
    }
    {
        const int row = tid >> 1, half = tid & 1; float o[32];
        conv_row<512, 4, true>(U, tok0 + row, tin0 + row, UC_BS + g * 64 + half * 32, cw, cb, 256 + g * 64 + half * 32, o);
#pragma unroll
        for (int q = 0; q < 4; ++q) *(u32x4*)(Btr + half * 8192 + row * 64 + q * 16) = (u32x4){pk2(o[8 * q], o[8 * q + 1]), pk2(o[8 * q + 2], o[8 * q + 3]), pk2(o[8 * q + 4], o[8 * q + 5]), pk2(o[8 * q + 6], o[8 * q + 7])};
        conv_row<512, 4, true>(U, tok0 + row, tin0 + row, UC_XS + h * 64 + half * 32, cw, cb, h * 64 + half * 32, o);
        const float dt = dts[row];
#pragma unroll
        for (int q = 0; q < 4; ++q) *(u32x4*)(Xtr + half * 8192 + row * 64 + q * 16) = (u32x4){pk2(o[8 * q] * dt, o[8 * q + 1] * dt), pk2(o[8 * q + 2] * dt, o[8 * q + 3] * dt), pk2(o[8 * q + 4] * dt, o[8 * q + 5] * dt), pk2(o[8 * q + 6] * dt, o[8 * q + 7] * dt)};
    }
    bf16x8 cf[4];
    {
        const int row = wid * 32 + r32;
#pragma unroll
        for (int d0 = 0; d0 < 4; ++d0) { float o[8];
            conv_row<512, 1, true>(U, tok0 + row, tin0 + row, UC_CS + g * 64 + 16 * d0 + 8 * hi, cw, cb, 384 + g * 64 + 16 * d0 + 8 * hi, o);
            const u32x4 w = (u32x4){pk2(o[0], o[1]), pk2(o[2], o[3]), pk2(o[4], o[5]), pk2(o[6], o[7])};
            cf[d0] = __builtin_bit_cast(bf16x8, w);
            if ((h & 1) == 0) *(u32x4*)((bf16_t*)(P.ws + AR_CC) + (size_t)(tok0 + row) * 128 + g * 64 + 16 * d0 + 8 * hi) = w; }
    }
    __syncthreads();
    f32x16 y0, y1;
#pragma unroll
    for (int r = 0; r < 16; ++r) { y0[r] = 0.f; y1[r] = 0.f; }
    const int lrow = wid * 32 + r32; const float acl = acs[lrow];
    const char* xrd = Xtr + ((lane >> 4) & 1) * 32 + (lane & 3) * 8 + (4 * hi + ((lane & 15) >> 2)) * 64;
    for (int sb = 0; sb <= wid; ++sb) {
        f32x16 gt;
#pragma unroll
        for (int r = 0; r < 16; ++r) gt[r] = 0.f;
#pragma unroll
        for (int d0 = 0; d0 < 4; ++d0) { const bf16x8 bfg = *(const bf16x8*)(Btr + (d0 >> 1) * 8192 + (sb * 32 + r32) * 64 + (d0 & 1) * 32 + hi * 16); gt = MFMA(bfg, cf[d0], gt); }
#pragma unroll
        for (int q = 0; q < 4; ++q) { const f32x4 av = *(const f32x4*)(acs + sb * 32 + 8 * q + 4 * hi);
#pragma unroll
            for (int j = 0; j < 4; ++j) { const int s = sb * 32 + 8 * q + 4 * hi + j; gt[4 * q + j] = (s <= lrow) ? gt[4 * q + j] * __expf(acl - av[j]) : 0.f; } }
        u32x4 w0 = (u32x4){pk2(gt[0], gt[1]), pk2(gt[2], gt[3]), pk2(gt[4], gt[5]), pk2(gt[6], gt[7])};
        u32x4 w1 = (u32x4){pk2(gt[8], gt[9]), pk2(gt[10], gt[11]), pk2(gt[12], gt[13]), pk2(gt[14], gt[15])};
        const bf16x8 p0 = __builtin_bit_cast(bf16x8, w0), p1 = __builtin_bit_cast(bf16x8, w1);
        const char* xp = xrd + sb * 2048;
        { const bf16x8 xa = cat8(tr_read(xp), tr_read(xp + 512)); y0 = MFMA(xa, p0, y0); }
        { const bf16x8 xa = cat8(tr_read(xp + 1024), tr_read(xp + 1024 + 512)); y0 = MFMA(xa, p1, y0); }
        { const bf16x8 xa = cat8(tr_read(xp + 8192), tr_read(xp + 8192 + 512)); y1 = MFMA(xa, p0, y1); }
        { const bf16x8 xa = cat8(tr_read(xp + 8192 + 1024), tr_read(xp + 8192 + 1024 + 512)); y1 = MFMA(xa, p1, y1); }
    }
    {
        const float dsk = P.in[14][l * 4 + h], idt = 1.0f / dts[lrow];
        bf16_t* yl = (bf16_t*)(P.ws + AR_YLOC) + (size_t)(tok0 + lrow) * 256 + h * 64;
#pragma unroll
        for (int pb = 0; pb < 2; ++pb)
#pragma unroll
            for (int q = 0; q < 4; ++q) { const u32x2 xv = *(const u32x2*)(Xtr + pb * 8192 + lrow * 64 + (8 * q + 4 * hi) * 2);
                const float f = dsk * idt; const f32x16& yy = pb ? y1 : y0;
                const float v0 = yy[4 * q] + f * bflo(xv[0]), v1 = yy[4 * q + 1] + f * bfhi(xv[0]), v2 = yy[4 * q + 2] + f * bflo(xv[1]), v3 = yy[4 * q + 3] + f * bfhi(xv[1]);
                *(u32x2*)(yl + pb * 32 + 8 * q + 4 * hi) = (u32x2){pk2(v0, v1), pk2(v2, v3)}; }
    }
    {
        const int pbk = wid >> 1, nbk = wid & 1;
        f32x16 st;
#pragma unroll
        for (int r = 0; r < 16; ++r) st[r] = 0.f;
        const int trow = 4 * hi + ((lane & 15) >> 2), tcol = ((lane >> 4) & 1) * 32 + (lane & 3) * 8;
#pragma unroll
        for (int ks = 0; ks < 8; ++ks) {
            const s16x4 xl = tr_read(Xtr + pbk * 8192 + (16 * ks + trow) * 64 + tcol), xh = tr_read(Xtr + pbk * 8192 + (16 * ks + 8 + trow) * 64 + tcol);
            const s16x4 bl = tr_read(Btr + nbk * 8192 + (16 * ks + trow) * 64 + tcol), bh2 = tr_read(Btr + nbk * 8192 + (16 * ks + 8 + trow) * 64 + tcol);
            const f32x4 wl = *(const f32x4*)(wts + 16 * ks + 4 * hi), wh = *(const f32x4*)(wts + 16 * ks + 8 + 4 * hi);
            float xf[8];
#pragma unroll
            for (int j = 0; j < 4; ++j) { xf[j] = __uint_as_float(((unsigned)(unsigned short)xl[j]) << 16) * wl[j]; xf[4 + j] = __uint_as_float(((unsigned)(unsigned short)xh[j]) << 16) * wh[j]; }
            const u32x4 xw = (u32x4){pk2(xf[0], xf[1]), pk2(xf[2], xf[3]), pk2(xf[4], xf[5]), pk2(xf[6], xf[7])};
            st = MFMA(__builtin_bit_cast(bf16x8, xw), cat8(bl, bh2), st);
        }
        float* sp = (float*)(P.ws + AR_STATES) + ((size_t)((b * 64 + c) * 4 + h) * 64 + pbk * 32) * 64 + nbk * 32 + r32;
#pragma unroll
        for (int r = 0; r < 16; ++r) sp[(size_t)crow(r, hi) * 64] = st[r];
    }
}

DI void lru_local_item(const Ctx& P, int l, int item, char* smem) {
    int tid_ = threadIdx.x & 255; asm volatile("" : "+v"(tid_));
    const int tid = tid_, lane = tid & 63, wid = tid >> 6, r32 = lane & 31, hi = lane >> 5;
    const int nb = item & 3, c = (item >> 2) & 63, b = item >> 8;
    const int tok0 = b * SEQ + c * 128, tin0 = c * 128;
    const bf16_t* U = (const bf16_t*)(P.ws + AR_U);
    const bf16_t* W = (const bf16_t*)(P.ws + ((l & 1) ? WS_WB1 : WS_WB0));
    float* xc = (float*)smem;
    float* totA = (float*)(smem + 34816); float* totH = totA + 256;
    __syncthreads();
    {
        const int row = tid >> 1, half = tid & 1; float o[32];
        conv_row<256, 4, false>(U, tok0 + row, tin0 + row, UC_XR + nb * 64 + half * 32, P.in[16] + (size_t)l * 4 * 256, P.in[17] + l * 256, nb * 64 + half * 32, o);
#pragma unroll
        for (int q = 0; q < 8; ++q) *(f32x4*)(xc + row * 68 + half * 32 + 4 * q) = (f32x4){o[4 * q], o[4 * q + 1], o[4 * q + 2], o[4 * q + 3]};
    }
    __syncthreads();
    const int row = wid * 32 + r32;
    bf16x8 xf[4];
#pragma unroll
    for (int d0 = 0; d0 < 4; ++d0) {
        const f32x4 a = *(const f32x4*)(xc + row * 68 + 16 * d0 + 8 * hi), bq = *(const f32x4*)(xc + row * 68 + 16 * d0 + 8 * hi + 4);
        const u32x4 xw = (u32x4){pk2(a[0], a[1]), pk2(a[2], a[3]), pk2(bq[0], bq[1]), pk2(bq[2], bq[3])};
        xf[d0] = __builtin_bit_cast(bf16x8, xw);
    }
    float Av[32], Hv[32];
    const float* ba = P.in[19] + l * 256 + nb * 64; const float* bi = P.in[21] + l * 256 + nb * 64; const float* lam = P.in[22] + l * 256 + nb * 64;
#pragma unroll
    for (int e = 0; e < 2; ++e) {
        f32x16 ar, ai;
#pragma unroll
        for (int r = 0; r < 16; ++r) { ar[r] = 0.f; ai[r] = 0.f; }
#pragma unroll
        for (int d0 = 0; d0 < 4; ++d0) {
            const bf16x8 wa = *(const bf16x8*)(W + WO_A + nb * 4096 + (e * 32 + r32) * 64 + 16 * d0 + 8 * hi);
            const bf16x8 wi = *(const bf16x8*)(W + WO_I + nb * 4096 + (e * 32 + r32) * 64 + 16 * d0 + 8 * hi);
            ar = MFMA(wa, xf[d0], ar); ai = MFMA(wi, xf[d0], ai);
        }
#pragma unroll
        for (int q = 0; q < 4; ++q) { const int ch = e * 32 + 8 * q + 4 * hi;
            const f32x4 bav = *(const f32x4*)(ba + ch), biv = *(const f32x4*)(bi + ch), lv = *(const f32x4*)(lam + ch), xv = *(const f32x4*)(xc + row * 68 + ch);
#pragma unroll
            for (int j = 0; j < 4; ++j) {
                const float rg = sigmoidf_(ar[4 * q + j] + bav[j]), ig = sigmoidf_(ai[4 * q + j] + biv[j]);
                const float la = -8.0f * rg * softplus_fast(-lv[j]);
                Av[e * 16 + 4 * q + j] = __expf(la);
                Hv[e * 16 + 4 * q + j] = __builtin_amdgcn_sqrtf(neg_expm1_fast(2.0f * la)) * (ig * xv[j]);
            } }
        asm volatile("" ::: "memory");
    }
#pragma unroll
    for (int d = 1; d < 32; d <<= 1) {
#pragma unroll
        for (int i = 0; i < 32; ++i) { const float ap = __shfl_up(Av[i], d, 32), hp = __shfl_up(Hv[i], d, 32); if (r32 >= d) { Hv[i] = Av[i] * hp + Hv[i]; Av[i] = Av[i] * ap; }
            if ((i & 7) == 7) __builtin_amdgcn_sched_barrier(0); }
    }
    if (r32 == 31) {
#pragma unroll
        for (int e = 0; e < 2; ++e)
#pragma unroll
            for (int q = 0; q < 4; ++q)
#pragma unroll
                for (int j = 0; j < 4; ++j) { const int ch = e * 32 + 8 * q + 4 * hi + j; totA[wid * 64 + ch] = Av[e * 16 + 4 * q + j]; totH[wid * 64 + ch] = Hv[e * 16 + 4 * q + j]; }
    }
    __syncthreads();
    float* carA = totH + 256 + wid * 64; float* carH = carA + 256;
    { float Ac = 1.f, Hc = 0.f;
      for (int w = 0; w < wid; ++w) { const float a2 = totA[w * 64 + lane], h2 = totH[w * 64 + lane]; Hc = a2 * Hc + h2; Ac = Ac * a2; }
      carA[lane] = Ac; carH[lane] = Hc; }
    asm volatile("s_waitcnt lgkmcnt(0)" ::: "memory");
    {
        bf16_t* hl = (bf16_t*)(P.ws + AR_HLOC) + (size_t)(tok0 + row) * 256 + nb * 64; bf16_t* ac = (bf16_t*)(P.ws + AR_ACP) + (size_t)(tok0 + row) * 256 + nb * 64;
#pragma unroll
        for (int e = 0; e < 2; ++e)
#pragma unroll
            for (int q = 0; q < 4; ++q) { const int ch = e * 32 + 8 * q + 4 * hi; float av[4], hv[4];
                const f32x4 ca = *(const f32x4*)(carA + ch), chv = *(const f32x4*)(carH + ch);
#pragma unroll
                for (int j = 0; j < 4; ++j) { const int i = e * 16 + 4 * q + j; hv[j] = Av[i] * chv[j] + Hv[i]; av[j] = Av[i] * ca[j]; }
                *(u32x2*)(hl + ch) = (u32x2){pk2(hv[0], hv[1]), pk2(hv[2], hv[3])};
                *(u32x2*)(ac + ch) = (u32x2){pk2(av[0], av[1]), pk2(av[2], av[3])};
                if (wid == 3 && r32 == 31) { float* he = (float*)(P.ws + WS_HEND) + (size_t)(b * 64 + c) * 256 + nb * 64 + ch; float* ae = (float*)(P.ws + WS_AEND) + (size_t)(b * 64 + c) * 256 + nb * 64 + ch;
                    *(f32x4*)he = (f32x4){hv[0], hv[1], hv[2], hv[3]}; *(f32x4*)ae = (f32x4){av[0], av[1], av[2], av[3]}; } }
    }
}

DI void carries(const Ctx& P, int bid) {
    int tid_ = threadIdx.x & 255; asm volatile("" : "+v"(tid_));
    const int tid = tid_;
    if (bid < 128) {
        const int idx = bid * 256 + tid;
        const int b = idx >> 14, h = (idx >> 12) & 3, e = idx & 4095;
        const float* st = (const float*)(P.ws + AR_STATES) + ((size_t)(b * 64) * 4 + h) * 4096 + e;
        bf16_t* so = (bf16_t*)(P.ws + AR_SIN) + ((size_t)(b * 64) * 4 + h) * 4096 + e;
        const float* at = (const float*)(P.ws + WS_ATOT) + (b * 4 + h) * 64;
        float S = 0.f;
        for (int c0 = 0; c0 < 64; c0 += 8) {
            float v[8], a[8];
#pragma unroll
            for (int j = 0; j < 8; ++j) { v[j] = st[(size_t)(c0 + j) * 16384]; a[j] = __expf(at[c0 + j]); }
#pragma unroll
            for (int j = 0; j < 8; ++j) { so[(size_t)(c0 + j) * 16384] = (bf16_t)(pk2(S, 0.f) & 0xffffu); S = a[j] * S + v[j]; }
        }
    } else if (bid < 130) {
        const int idx = (bid - 128) * 256 + tid;
        const int b = idx >> 8, ch = idx & 255;
        const float* he = (const float*)(P.ws + WS_HEND) + (size_t)b * 64 * 256 + ch; const float* ae = (const float*)(P.ws + WS_AEND) + (size_t)b * 64 * 256 + ch;
        float* hin = (float*)(P.ws + WS_HIN) + (size_t)b * 64 * 256 + ch;
        float Hc = 0.f;
        for (int c = 0; c < 64; ++c) { hin[c * 256] = Hc; Hc = ae[c * 256] * Hc + he[c * 256]; }
    }
}

DI void ssd_z_item(const Ctx& P, int item) {
    int tid_ = threadIdx.x & 255; asm volatile("" : "+v"(tid_));
    const int tid = tid_, lane = tid & 63, wid = tid >> 6, r32 = lane & 31, hi = lane >> 5;
    const int g = item & 1, c = (item >> 1) & 63, b = item >> 7;
    const int tok = b * SEQ + c * 128 + wid * 32 + r32;
    const bf16_t* Cc = (const bf16_t*)(P.ws + AR_CC) + (size_t)tok * 128 + g * 64 + 8 * hi;
    bf16x8 cf[4];
#pragma unroll
    for (int d0 = 0; d0 < 4; ++d0) cf[d0] = *(const bf16x8*)(Cc + 16 * d0);
    f32x16 acc[2][2];
#pragma unroll
    for (int hh = 0; hh < 2; ++hh)
#pragma unroll
        for (int pb = 0; pb < 2; ++pb) {
#pragma unroll
            for (int r = 0; r < 16; ++r) acc[hh][pb][r] = 0.f;
            const bf16_t* sp = (const bf16_t*)(P.ws + AR_SIN) + ((size_t)((b * 64 + c) * 4 + 2 * g + hh) * 64 + pb * 32 + r32) * 64 + 8 * hi;
#pragma unroll
            for (int d0 = 0; d0 < 4; ++d0) { const bf16x8 sf = *(const bf16x8*)(sp + 16 * d0); acc[hh][pb] = MFMA(sf, cf[d0], acc[hh][pb]); }
        }
    const f32x4 acv = *(const f32x4*)((const float*)(P.ws + WS_ACUM) + (size_t)tok * 4);
    const bf16_t* yl = (const bf16_t*)(P.ws + AR_YLOC) + (size_t)tok * 256 + g * 128;
    const bf16_t* zp = (const bf16_t*)(P.ws + AR_U) + (size_t)tok * NIN + UC_Z + g * 128;
    float ss = 0.f;
#pragma unroll
    for (int hh = 0; hh < 2; ++hh) { const float ea = __expf(acv[2 * g + hh]);
#pragma unroll
        for (int pb = 0; pb < 2; ++pb)
#pragma unroll
            for (int q = 0; q < 4; ++q) { const int col = hh * 64 + pb * 32 + 8 * q + 4 * hi;
                const u32x2 yv = *(const u32x2*)(yl + col), zv = *(const u32x2*)(zp + col);
                const float yy[4] = {bflo(yv[0]), bfhi(yv[0]), bflo(yv[1]), bfhi(yv[1])}, zz[4] = {bflo(zv[0]), bfhi(zv[0]), bflo(zv[1]), bfhi(zv[1])};
#pragma unroll
                for (int j = 0; j < 4; ++j) { const float v = (acc[hh][pb][4 * q + j] * ea + yy[j]) * siluf_(zz[j]); acc[hh][pb][4 * q + j] = v; ss += v * v; } } }
    ss += __shfl_xor(ss, 32);
    const float rs = rsqrtf(ss * (1.0f / 128.0f) + EPS);
    bf16_t* ym = (bf16_t*)(P.ws + AR_YMIX) + (size_t)tok * 1024 + 512 + g * 128;
#pragma unroll
    for (int hh = 0; hh < 2; ++hh)
#pragma unroll
        for (int pb = 0; pb < 2; ++pb)
#pragma unroll
            for (int q = 0; q < 4; ++q) { const int col = hh * 64 + pb * 32 + 8 * q + 4 * hi;
                *(u32x2*)(ym + col) = (u32x2){pk2(acc[hh][pb][4 * q] * rs, acc[hh][pb][4 * q + 1] * rs), pk2(acc[hh][pb][4 * q + 2] * rs, acc[hh][pb][4 * q + 3] * rs)}; }
}
DI void rowfin_item(const Ctx& P, int item) {
    int tid_ = threadIdx.x & 255; asm volatile("" : "+v"(tid_));
    const int lane = tid_ & 63, wid = tid_ >> 6;
#pragma unroll
    for (int u = 0; u < 4; ++u) {
    const int tok = item * 16 + wid * 4 + u;
    bf16_t* ym = (bf16_t*)(P.ws + AR_YMIX) + (size_t)tok * 1024;
    {
        const u32x4 v = *(const u32x4*)((const bf16_t*)(P.ws + AR_YMLA) + (size_t)tok * 512 + lane * 8);
        float f[8] = {bflo(v[0]), bfhi(v[0]), bflo(v[1]), bfhi(v[1]), bflo(v[2]), bfhi(v[2]), bflo(v[3]), bfhi(v[3])};
        float ss = 0.f;
#pragma unroll
        for (int j = 0; j < 8; ++j) ss += f[j] * f[j];
#pragma unroll
        for (int d = 1; d < 64; d <<= 1) ss += __shfl_xor(ss, d);
        const float rs = rsqrtf(ss * (1.0f / 512.0f) + EPS);
        *(u32x4*)(ym + lane * 8) = (u32x4){pk2(f[0] * rs, f[1] * rs), pk2(f[2] * rs, f[3] * rs), pk2(f[4] * rs, f[5] * rs), pk2(f[6] * rs, f[7] * rs)};
    }
    {
        const int b = tok >> 13, c = (tok & 8191) >> 7, ch = lane * 4;
        const u32x2 hv = *(const u32x2*)((const bf16_t*)(P.ws + AR_HLOC) + (size_t)tok * 256 + ch), av = *(const u32x2*)((const bf16_t*)(P.ws + AR_ACP) + (size_t)tok * 256 + ch);
        const u32x2 gv = *(const u32x2*)((const bf16_t*)(P.ws + AR_U) + (size_t)tok * NIN + UC_GATE + ch);
        const f32x4 hin = *(const f32x4*)((const float*)(P.ws + WS_HIN) + (size_t)(b * 64 + c) * 256 + ch);
        const float hl[4] = {bflo(hv[0]), bfhi(hv[0]), bflo(hv[1]), bfhi(hv[1])}, aa[4] = {bflo(av[0]), bfhi(av[0]), bflo(av[1]), bfhi(av[1])}, gg[4] = {bflo(gv[0]), bfhi(gv[0]), bflo(gv[1]), bfhi(gv[1])};
        float y[4], ss = 0.f;
#pragma unroll
        for (int j = 0; j < 4; ++j) { y[j] = (hl[j] + aa[j] * hin[j]) * gelu_tanh_(gg[j]); ss += y[j] * y[j]; }
#pragma unroll
        for (int d = 1; d < 64; d <<= 1) ss += __shfl_xor(ss, d);
        const float rs = rsqrtf(ss * (1.0f / 256.0f) + EPS);
        *(u32x2*)(ym + 768 + ch) = (u32x2){pk2(y[0] * rs, y[1] * rs), pk2(y[2] * rs, y[3] * rs)};
    }
    }
}

DI void run_phase(const Params& PP, int ph, char* smem, unsigned* sh_item, int rep = 0) {
    int z_; asm volatile("s_mov_b32 %0, 0" : "=s"(z_));
    Ctx P; P.in = PP.in + z_; P.out = PP.out + z_; P.ws = PP.ws + z_;
    const int vb = __builtin_amdgcn_readfirstlane((int)(threadIdx.x >> 8));
    const int bid = (int)blockIdx.x * 2 + vb + z_;
    const int G = (int)gridDim.x * 2;
    const int pb = (int)blockIdx.x + z_, PG = (int)gridDim.x;
    char* const smem_full = smem; smem = smem + vb * VB_LDS;
    unsigned char* ws = P.ws;
    bf16_t* XB = (bf16_t*)(ws + WS_XB);
#if !defined(ONLY) || ONLY == 9
    if (ph == 0) { phase_prologue(P, smem); return; }
#endif
    if (ph == NPHASE - 1) {
        int t_ = threadIdx.x & 255; asm volatile("" : "+v"(t_));
        const int lane = t_ & 63, wid = t_ >> 6; const float* g = P.in[34];
        for (int row = bid * 4 + wid; row < T; row += G * 4) {
            float* xr = P.out + (size_t)row * DM; f32x4 v[4]; float ss = 0.f;
#pragma unroll
            for (int i = 0; i < 4; ++i) { v[i] = *(const f32x4*)(xr + i * 256 + lane * 4); ss += v[i][0] * v[i][0] + v[i][1] * v[i][1] + v[i][2] * v[i][2] + v[i][3] * v[i][3]; }
#pragma unroll
            for (int d = 1; d < 64; d <<= 1) ss += __shfl_xor(ss, d);
            const float rs = rsqrtf(ss * (1.0f / 1024.0f) + EPS);
#pragma unroll
            for (int i = 0; i < 4; ++i) { const f32x4 gv = *(const f32x4*)(g + i * 256 + lane * 4); *(f32x4*)(xr + i * 256 + lane * 4) = (f32x4){v[i][0] * rs * gv[0], v[i][1] * rs * gv[1], v[i][2] * rs * gv[2], v[i][3] * rs * gv[3]}; }
        }
        return;
    }
    const int l = (ph - 1) / 9, st = (ph - 1) % 9;
    const bf16_t* W = (const bf16_t*)(ws + ((l & 1) ? WS_WB1 : WS_WB0));
    switch (st) {
#if !defined(ONLY) || ONLY == 0
    case 0: {
        { EpiP1KV e{EpiP1{(bf16_t*)(ws + AR_U), (float*)(ws + WS_DTRAW), (float*)(ws + WS_PQ), (float*)(ws + WS_PKV)}, (bf16_t*)(ws + WS_KMEM), (bf16_t*)(ws + WS_VMEM)};
          const bf16_t* Wi = W + WO_IN; const bf16_t* Wk = W + WO_MK; const bf16_t* Am = (const bf16_t*)(ws + WS_MEMB) - (size_t)T * 1024; const float* part = (const float*)(ws + WS_PART);
          auto tf = [=](int it) { const int xcd = it & 7, idx = it >> 3;
                                  if (idx < 56) return Tile256{XB, Wi, part, 1024, 1024, 1024, (xcd * 8 + idx / 7) * 256, (idx % 7) * 256, 16, 0, 1.0f / 1024.0f};
                                  const int j = xcd * 2 + (idx - 56); return Tile256{Am, Wk, part, 1024, 1024, 1024, T + ((j >> 2) & 1) * 256, (j >> 3) * 1024 + (j & 3) * 256, 16, 0, 1.0f / 1024.0f}; };
          gemm256_stream(tf, pb, PG, 464, smem_full, e); }
    } break;
#endif
#if !defined(ONLY) || ONLY == 1
    case 1: {
        {
            const int tv = (pb >> 1) * 2 + vb, tvn = (PG >> 1) * 2;
            for (int k = tv; k < 512; k += tvn) { if (pb & 1) lru_local_item(P, l, k, smem); else ssd_local_item(P, l, k, smem); }
        }
        __syncthreads();
        { EpiStage1 e{EpiKV{(bf16_t*)(ws + AR_K), (bf16_t*)(ws + AR_V), (const bf16_t*)(ws + AR_U), (const float*)(ws + WS_COS), (const float*)(ws + WS_SIN)},
                      EpiQ{(bf16_t*)(ws + AR_Q), (const float*)(ws + WS_COS), (const float*)(ws + WS_SIN)}, (bf16_t*)(ws + WS_WQKT), (bf16_t*)(ws + WS_VWOT)};
          const bf16_t* Uq = (const bf16_t*)(ws + AR_U) + UC_CQ; const bf16_t* Ukv = (const bf16_t*)(ws + AR_U) + UC_CKV; const bf16_t* Wq = W + WO_UQ; const bf16_t* Wkv = W + WO_UKV;
          const bf16_t* Km = (const bf16_t*)(ws + WS_KMEM); const bf16_t* Vm = (const bf16_t*)(ws + WS_VMEM); const bf16_t* Wmq = W + WO_MQ; const bf16_t* Wmo = W + WO_MO;
          const float* pq = (const float*)(ws + WS_PQ); const float* pkv = (const float*)(ws + WS_PKV);
          auto tf = [=](int it) {
              if (it < 256) return Tile256{Ukv, Wkv, pkv, NIN, 128, 128, (it >> 2) * 256, (it & 3) * 256, 2, 0, 1.0f / 128.0f};
              if (it < 448) { const int j = it - 256; return Tile256{Uq, Wq, pq, NIN, 256, 256, (j / 3) * 256, (j % 3) * 256, 4, 1, 1.0f / 256.0f}; }
              if (it < 480) { const int j = it - 448, b = j >> 4, h = (j >> 2) & 3, nt = j & 3; return Tile256{Km + h * 256, Wmq + h * 256, nullptr, 1024, 1024, 256, b * 256, nt * 256, 0, 2 | (b << 2) | (h << 3), 0.f}; }
              const int j = it - 480, b = j >> 4, h = (j >> 2) & 3, mt = j & 3; return Tile256{Wmo + h * 256, Vm + (size_t)b * 256 * 1024 + h * 256, nullptr, 1024, 1024, 256, mt * 256, 0, 0, 3 | (b << 2) | (h << 3), 0.f}; };
          gemm256_stream(tf, pb, PG, 512, smem_full, e); }
    } break;
#endif
#if !defined(ONLY) || ONLY == 2
    case 2: {
        carries(P, bid);
        unsigned* ctr = (unsigned*)ws + CW_QUEUE + (l * 8 + (pb & 7)) * 64 + rep * 16;
        for (;;) {
            __syncthreads();
            if (threadIdx.x == 0) *sh_item = atomicAdd(ctr, 1u);
            __syncthreads();
            const unsigned j2 = *sh_item;
            if (j2 >= 64u) break;
            const int pi = 31 - (int)(j2 & 31u), qb = 2 * pi + 1 - vb;
            attn_item((const bf16_t*)(ws + AR_Q), (const bf16_t*)(ws + AR_K), (const bf16_t*)(ws + AR_V), (bf16_t*)(ws + AR_YMLA), (pb & 7) * 2 + (int)(j2 >> 5), qb, 2 * (2 * pi + 2), smem_full, vb);
        }
    } break;
#endif
#if !defined(ONLY) || ONLY == 3
    case 3: {
        {
            if (G == 512) { if (bid < 256) { ssd_z_item(P, bid); rowfin_item(P, bid); } else { const int r0 = 256 + (bid - 256) * 3; rowfin_item(P, r0); rowfin_item(P, r0 + 1); rowfin_item(P, r0 + 2); } }
            else for (int it = bid; it < 256 + 1024; it += G) { if (it < 256) ssd_z_item(P, it); else rowfin_item(P, it - 256); } }
    } break;
#endif
#if !defined(ONLY) || ONLY == 4
    case 4: {
        EpiResid e{l == 0 ? P.in[0] : P.out, P.out, XB, (float*)(ws + WS_PART)};
        { const bf16_t* Ay = (const bf16_t*)(ws + AR_YMIX); const bf16_t* Wo = W + WO_OUT;
          auto tf = [=](int it) { const int xcd = it & 7, idx = it >> 3, mt = xcd * 8 + (idx >> 2), nt = idx & 3; return Tile256{Ay, Wo, nullptr, 1024, 1024, 1024, mt * 256, nt * 256, 0, 0, 0.f}; };
          gemm256_stream(tf, pb, PG, 256, smem_full, e); }
    } break;
#endif
#if !defined(ONLY) || ONLY == 5
    case 5: {
        { EpiSoftmax256 e{(bf16_t*)(ws + AR_P), (float*)(smem_full + 2 * 65536 + 1024)}; const bf16_t* Wq = (const bf16_t*)(ws + WS_WQKT); const float* part = (const float*)(ws + WS_PART);
          auto tf = [=](int it) { const int xcd = it & 7, idx = it >> 3, mt = xcd * 8 + (idx >> 2), hh = idx & 3; return Tile256{XB, Wq + (size_t)(mt >> 5) * 1048576, part, 1024, 1024, 1024, mt * 256, hh * 256, 16, 0, 1.0f / 1024.0f}; };
          gemm256_stream(tf, pb, PG, 256, smem_full, e); }
    } break;
#endif
#if !defined(ONLY) || ONLY == 6
    case 6: {
        EpiResid e{P.out, P.out, XB, (float*)(ws + WS_PART)};
        { const bf16_t* Ap = (const bf16_t*)(ws + AR_P); const bf16_t* Vw = (const bf16_t*)(ws + WS_VWOT);
          auto tf = [=](int it) { const int xcd = it & 7, idx = it >> 3, mt = xcd * 8 + (idx >> 2), nt = idx & 3; return Tile256{Ap, Vw + (size_t)(mt >> 5) * 1048576, nullptr, 1024, 1024, 1024, mt * 256, nt * 256, 0, 0, 0.f}; };
          gemm256_stream(tf, pb, PG, 256, smem_full, e); }
    } break;
#endif
#if !defined(ONLY) || ONLY == 7
    case 7: {
        EpiRelu2 e{(bf16_t*)(ws + AR_H)};
        { const bf16_t* W1 = W + WO_1; const float* part = (const float*)(ws + WS_PART);
          auto tf = [=](int it) { const int rnd = it >> 8, w = it & 255, xcd = w & 7, idx = w >> 3, mt = rnd * 16 + (xcd >> 1) * 4 + (idx >> 3), nt = (xcd & 1) * 8 + (idx & 7); return Tile256{XB, W1, part, 1024, 1024, 1024, mt * 256, nt * 256, 16, 0, 1.0f / 1024.0f}; };
          gemm256_stream(tf, pb, PG, 1024, smem_full, e); }
    } break;
#endif
#if !defined(ONLY) || ONLY == 8
    case 8: {
        EpiResid e{P.out, P.out, XB, (float*)(ws + WS_PART)};
        { const bf16_t* Ah = (const bf16_t*)(ws + AR_H); const bf16_t* W2 = W + WO_2;
          auto tf = [=](int it) { const int xcd = it & 7, idx = it >> 3, mt = xcd * 8 + (idx >> 2), nt = idx & 3; return Tile256{Ah, W2, nullptr, 4096, 4096, 4096, mt * 256, nt * 256, 0, 0, 0.f}; };
          gemm256_stream(tf, pb, PG, 256, smem_full, e); }
        if (l + 1 < NL) { __syncthreads(); convert_layer_weights(P, l + 1, (float*)smem); }
    } break;
#endif
    }
}

__global__ void __launch_bounds__(512, 2) hymba_mega(Params P, int ph_lo, int ph_hi, int coop) {
    extern __shared__ __attribute__((aligned(16))) char smem[];
    __shared__ unsigned sh_item;
    if (coop) {
        if (threadIdx.x == 0) *(uint4*)(smem + XB_LDS_OFF) = make_uint4(0u, 0u, 0u, 0u);
        __syncthreads();
        (void)xcd_barrier_post((unsigned*)P.ws, (volatile unsigned*)(smem + XB_LDS_OFF));
    }
    for (int ph = ph_lo; ph < ph_hi; ++ph) {
        run_phase(P, ph, smem, &sh_item);
#ifdef REP_ST
        if (ph >= 1 && ph < NPHASE - 1 && (ph - 1) % 9 == REP_ST) { xcd_barrier((unsigned*)P.ws); run_phase(P, ph, smem, &sh_item, 1); }
#endif
        if (coop && ph + 1 < ph_hi) {
            if (ph == ph_lo) cg::this_grid().sync();
            else { xcd_barrier((unsigned*)P.ws);
#ifdef DBL_BAR
                xcd_barrier((unsigned*)P.ws); xcd_barrier((unsigned*)P.ws);
#endif
            }
        }
    }
}

extern "C" void kernel_launch(void* const* d_in, const int* in_sizes, int n_in, void* d_out, int out_size, void* d_ws, size_t ws_size, hipStream_t stream) {
    static int grid = 0;
    if (grid == 0) {
        if (n_in != 35 || out_size != T * DM || ws_size < WS_END) { fprintf(stderr, "kernel_launch: unexpected shapes (n_in %d out %d ws %zu need %zu)\n", n_in, out_size, ws_size, (size_t)WS_END); grid = -1; return; }
        int dev = 0, cus = 0, per_cu = 0;
        hipGetDevice(&dev); hipDeviceGetAttribute(&cus, hipDeviceAttributeMultiprocessorCount, dev);
        if (hipFuncSetAttribute((const void*)hymba_mega, hipFuncAttributeMaxDynamicSharedMemorySize, LDS_BYTES) != hipSuccess) { fprintf(stderr, "kernel_launch: hipFuncSetAttribute failed\n"); grid = -1; return; }
        (void)hipOccupancyMaxActiveBlocksPerMultiprocessor(&per_cu, (const void*)hymba_mega, 512, LDS_BYTES);
        if (per_cu < 1) { fprintf(stderr, "kernel_launch: occupancy query failed\n"); grid = -1; return; }
        if (per_cu > 1) per_cu = 1;
        grid = cus * per_cu;
    }
    if (grid < 0) return;
    hipMemsetAsync((char*)d_ws + WS_CTL, 0, 65536, stream);
    Params p{};
    for (int i = 0; i < 35; ++i) p.in[i] = (const float*)d_in[i];
    p.out = (float*)d_out; p.ws = (unsigned char*)d_ws;
#if MK_MULTI
    for (int ph = 0; ph < NPHASE; ++ph) hipLaunchKernelGGL(hymba_mega, dim3(grid), dim3(512), LDS_BYTES, stream, p, ph, ph + 1, 0);
#else
    int lo = 0, hi = NPHASE, coop = 1;
    void* args[] = {&p, &lo, &hi, &coop};
    hipError_t e = hipLaunchCooperativeKernel((const void*)hymba_mega, dim3(grid), dim3(512), args, LDS_BYTES, stream);
    if (e != hipSuccess) fprintf(stderr, "cooperative launch failed: %s (grid %d)\n", hipGetErrorString(e), grid);
#endif
}
```
